# Optimizing an MI355X kernel written in HIP

```python
import math
import jax, jax.numpy as jnp
from jax import lax
import numpy as np

D_MODEL = 1024
BATCH = 4
SEQ = 4096
DEPTH = 1

CHUNK = 64
N_META = 16
POOL_WIDTH = D_MODEL // 2
POOL_WINDOWS = (2, 4, 8, 16)
POOL_GROUPS = len(POOL_WINDOWS)
POOL_GROUP_DIM = POOL_WIDTH // POOL_GROUPS
N_HEADS = 8
HEAD_DIM = 64
ATTN_WIDTH = N_HEADS * 2 * HEAD_DIM
N_BUCKETS = 32
MAX_DISTANCE = 128
D_FF = ((-(-8 * D_MODEL // 3)) + 255) // 256 * 256
IN_COLS = POOL_WIDTH + 3 * ATTN_WIDTH + 2 * D_MODEL
QBLK = 128
NORM_EPS = 1e-6
NEG_INF = -1e30
BIG_CHUNK = 2 ** 30

kernel_name = "gated_pool_diffattn_hybrid_block"


def rmsnorm(x, w):
    xf = x.astype(jnp.float32)
    var = jnp.mean(xf * xf, axis=-1, keepdims=True)
    return (xf * lax.rsqrt(var + NORM_EPS) * w.astype(jnp.float32)).astype(x.dtype)


def t5_bucket(rel):
    nb = N_BUCKETS // 2
    ret = jnp.where(rel > 0, nb, 0)
    n = jnp.abs(rel)
    max_exact = nb // 2
    nf = jnp.maximum(n, max_exact).astype(jnp.float32)
    large = max_exact + (jnp.log(nf / max_exact) / math.log(MAX_DISTANCE / max_exact)
                         * (nb - max_exact)).astype(jnp.int32)
    large = jnp.minimum(large, nb - 1)
    return ret + jnp.where(n < max_exact, n, large)


def chunk_ids(pos, n_valid):
    cid = jnp.where(pos < N_META, 0, 1 + (pos - N_META) // CHUNK)
    return jnp.where(pos < n_valid, cid, BIG_CHUNK)


def pool_mixer(u, group_w, scale):
    B, L, C = u.shape
    uf = u.astype(jnp.float32)
    cs = jnp.concatenate([jnp.zeros((B, 1, C), jnp.float32), jnp.cumsum(uf, axis=1)], axis=1)
    t = jnp.arange(L)
    outs = []
    for g, w in enumerate(POOL_WINDOWS):
        sl = slice(g * POOL_GROUP_DIM, (g + 1) * POOL_GROUP_DIM)
        csg = cs[..., sl]
        lo = jnp.maximum(t + 1 - w, 0)
        cnt = (t + 1 - lo).astype(jnp.float32)
        mean = (csg[:, 1:] - csg[:, lo]) / cnt[None, :, None]
        outs.append(mean - uf[..., sl])
    pooled = jnp.stack(outs, axis=2).astype(u.dtype)
    mixed = jnp.einsum('blgc,gcd->blgd', pooled, group_w)
    return mixed.reshape(B, L, C) * scale


def diff_attention(q, k, v, bias_table, lam):
    B, L = q.shape[0], q.shape[1]
    Lp = -(-L // QBLK) * QBLK
    pad = Lp - L

    def to_bhld(a):
        a = jnp.pad(a, [(0, 0), (0, pad)] + [(0, 0)] * (a.ndim - 2))
        return jnp.swapaxes(a, 1, 2)

    q1, q2 = to_bhld(q[..., 0, :]), to_bhld(q[..., 1, :])
    k1, k2 = to_bhld(k[..., 0, :]), to_bhld(k[..., 1, :])
    vp = to_bhld(v)
    pos = jnp.arange(Lp)
    cid = chunk_ids(pos, L)
    nblk = Lp // QBLK
    scale = HEAD_DIM ** -0.5

    def blockify(a):
        return a.reshape(B, N_HEADS, nblk, QBLK, a.shape[-1]).transpose(2, 0, 1, 3, 4)

    def one_block(args):
        qa, qb, qpos = args
        rel = pos[None, :] - qpos[:, None]
        bias = jnp.transpose(bias_table[t5_bucket(rel)], (2, 0, 1)).astype(jnp.float32)
        visible = cid[None, :] <= chunk_ids(qpos, L)[:, None]

        def probs(qx, kx):
            s = jnp.einsum('bhqd,bhkd->bhqk', qx, kx).astype(jnp.float32) * scale + bias[None]
            s = jnp.where(visible[None, None], s, NEG_INF)
            return jax.nn.softmax(s, axis=-1)

        w = probs(qa, k1) - lam * probs(qb, k2)
        return jnp.einsum('bhqk,bhkd->bhqd', w.astype(vp.dtype), vp)

    o = lax.map(one_block, (blockify(q1), blockify(q2), pos.reshape(nblk, QBLK)))
    o = o.transpose(1, 0, 3, 2, 4).reshape(B, Lp, N_HEADS, 2 * HEAD_DIM)
    return o[:, :L]


def hybrid_layer(h, layer_idx, bias_table, mix_norm_w, w_in, pool_group_w, pool_scale,
                 lambda_q1, lambda_k1, lambda_q2, lambda_k2, subln_w,
                 w_pool_out, w_attn_out, w_o, ffn_norm_w, w_gate, w_up, w_down):
    B, L, _ = h.shape
    xn = rmsnorm(h, mix_norm_w)
    proj = xn @ w_in
    offs = np.cumsum([POOL_WIDTH, ATTN_WIDTH, ATTN_WIDTH, ATTN_WIDTH, D_MODEL]).tolist()
    u_pool, q, k, v, g_pool, g_attn = jnp.split(proj, offs, axis=-1)

    pool_out = pool_mixer(u_pool, pool_group_w, pool_scale)

    lam_init = 0.8 - 0.6 * math.exp(-0.3 * layer_idx)
    lam = (jnp.exp(jnp.sum(lambda_q1.astype(jnp.float32) * lambda_k1.astype(jnp.float32)))
           - jnp.exp(jnp.sum(lambda_q2.astype(jnp.float32) * lambda_k2.astype(jnp.float32)))
           + lam_init)
    o = diff_attention(q.reshape(B, L, N_HEADS, 2, HEAD_DIM),
                       k.reshape(B, L, N_HEADS, 2, HEAD_DIM),
                       v.reshape(B, L, N_HEADS, 2 * HEAD_DIM), bias_table, lam)
    o = rmsnorm(o, subln_w) * (1.0 - lam_init)
    attn_out = o.reshape(B, L, ATTN_WIDTH)

    merged = (jax.nn.sigmoid(g_pool) * (pool_out @ w_pool_out)
              + jax.nn.sigmoid(g_attn) * (attn_out @ w_attn_out))
    h = h + merged @ w_o

    hn = rmsnorm(h, ffn_norm_w)
    h = h + (jax.nn.silu(hn @ w_gate) * (hn @ w_up)) @ w_down
    return h


def setup_inputs(seed: int = 0) -> dict:
    key = jax.random.key(seed)
    ks = jax.random.split(key, 24)
    f32 = jnp.float32

    def nrm(k, shape, scale):
        return jax.random.normal(k, shape, f32) * scale

    return {
        "x": nrm(ks[0], (BATCH, SEQ, D_MODEL), 1.0),
        "meta_tokens": nrm(ks[1], (N_META, D_MODEL), 1.0),
        "rel_bias_table": nrm(ks[2], (N_BUCKETS, N_HEADS), 0.5),
        "mix_norm_w": 1.0 + nrm(ks[3], (DEPTH, D_MODEL), 0.02),
        "w_in": nrm(ks[4], (DEPTH, D_MODEL, IN_COLS), D_MODEL ** -0.5),
        "pool_group_w": nrm(ks[5], (DEPTH, POOL_GROUPS, POOL_GROUP_DIM, POOL_GROUP_DIM), POOL_GROUP_DIM ** -0.5),
        "pool_scale": 1.0 + nrm(ks[6], (DEPTH, POOL_WIDTH), 0.02),
        "lambda_q1": nrm(ks[7], (DEPTH, HEAD_DIM), 0.1),
        "lambda_k1": nrm(ks[8], (DEPTH, HEAD_DIM), 0.1),
        "lambda_q2": nrm(ks[9], (DEPTH, HEAD_DIM), 0.1),
        "lambda_k2": nrm(ks[10], (DEPTH, HEAD_DIM), 0.1),
        "subln_w": 1.0 + nrm(ks[11], (DEPTH, 2 * HEAD_DIM), 0.02),
        "w_pool_out": nrm(ks[12], (DEPTH, POOL_WIDTH, D_MODEL), POOL_WIDTH ** -0.5),
        "w_attn_out": nrm(ks[13], (DEPTH, ATTN_WIDTH, D_MODEL), ATTN_WIDTH ** -0.5),
        "w_o": nrm(ks[14], (DEPTH, D_MODEL, D_MODEL), D_MODEL ** -0.5),
        "ffn_norm_w": 1.0 + nrm(ks[15], (DEPTH, D_MODEL), 0.02),
        "w_gate": nrm(ks[16], (DEPTH, D_MODEL, D_FF), D_MODEL ** -0.5),
        "w_up": nrm(ks[17], (DEPTH, D_MODEL, D_FF), D_MODEL ** -0.5),
        "w_down": nrm(ks[18], (DEPTH, D_FF, D_MODEL), D_FF ** -0.5),
        "final_norm_w": 1.0 + nrm(ks[19], (D_MODEL,), 0.02),
    }


def reference(x, meta_tokens, rel_bias_table, mix_norm_w, w_in, pool_group_w, pool_scale,
              lambda_q1, lambda_k1, lambda_q2, lambda_k2, subln_w, w_pool_out, w_attn_out,
              w_o, ffn_norm_w, w_gate, w_up, w_down, final_norm_w):
    B = x.shape[0]
    meta = jnp.broadcast_to(meta_tokens[None].astype(x.dtype), (B, N_META, x.shape[-1]))
    h = jnp.concatenate([meta, x], axis=1)
    for i in range(DEPTH):
        h = hybrid_layer(h, i, rel_bias_table, mix_norm_w[i], w_in[i], pool_group_w[i], pool_scale[i],
                         lambda_q1[i], lambda_k1[i], lambda_q2[i], lambda_k2[i], subln_w[i],
                         w_pool_out[i], w_attn_out[i], w_o[i], ffn_norm_w[i],
                         w_gate[i], w_up[i], w_down[i])
    h = rmsnorm(h, final_norm_w)
    return h[:, N_META:]
```

```cpp
#include <hip/hip_runtime.h>
#include <cstdio>
#include <cstdint>

#ifndef MK_N_LAUNCHES
#define MK_N_LAUNCHES 1
#endif

constexpr int BATCH = 4, SEQ = 4096, D = 1024, NMETA = 16, NH = 8, HD = 64, VD = 128;
constexpr int M = BATCH * SEQ;
constexpr int MP = M + 256;
constexpr int PW = 512, AW = 1024, FF = 2816, INC = 5632;
constexpr int KC = PW + AW;
constexpr float EPS = 1e-6f;
constexpr float LOG2E = 1.4426950408889634f;
constexpr float QSCALE = 0.125f * LOG2E;

typedef unsigned short bf16;
typedef float f32x4 __attribute__((ext_vector_type(4)));
typedef unsigned u32x4 __attribute__((ext_vector_type(4)));
typedef unsigned u32x2 __attribute__((ext_vector_type(2)));

constexpr size_t MiB = 1u << 20;
constexpr size_t WS_CTL = 0, CTL_ZERO_BYTES = 1 * MiB;
constexpr size_t WS_XSLOT = 512 * 1024;
constexpr int CW_CNT = 16384;
constexpr int CW_QUEUE = 2048;
constexpr int CW_BAR = 4096;
constexpr size_t WS_PART = 1 * MiB;
constexpr size_t WS_WIN = 2 * MiB;
constexpr size_t WS_WCAT = 13 * MiB;
constexpr size_t WS_WO = 16 * MiB;
constexpr size_t WS_WGU = 18 * MiB;
constexpr size_t WS_WD = 29 * MiB;
constexpr size_t WS_XN = 36 * MiB;
constexpr size_t WS_UP = WS_XN + (size_t)MP * D * 2;
constexpr size_t WS_K = WS_UP + (size_t)MP * PW * 2;
constexpr size_t WS_V = WS_K + (size_t)MP * AW * 2;
constexpr size_t WS_Q = WS_V + (size_t)MP * AW * 2;
constexpr size_t WS_GP = WS_Q + (size_t)M * AW * 2;
constexpr size_t WS_GA = WS_GP + (size_t)M * D * 2;
constexpr size_t WS_END = WS_GA + (size_t)M * D * 2;
constexpr size_t WS_MERGED = WS_Q, WS_HB = WS_GP;
constexpr size_t WS_ACT = WS_XN;
static_assert(WS_END <= 256 * MiB, "ws map");
static_assert(WS_ACT + (size_t)M * FF * 2 <= WS_Q, "ACT overlay must not reach MERGED / HB");

constexpr int RING_BYTES = 131072, MISC_OFF = RING_BYTES + 320, LDS_BYTES = 147456;
constexpr int NWAVES = 8, NTHR = 512;

#define GAS __attribute__((address_space(1)))
#define LAS __attribute__((address_space(3)))
#define LDS_WAIT() asm volatile("s_waitcnt lgkmcnt(0)" ::: "memory")
#define VM_WAIT() asm volatile("s_waitcnt vmcnt(0)" ::: "memory")

__device__ __forceinline__ unsigned f2bf(float f) { unsigned u = __builtin_bit_cast(unsigned, f); return (u + 0x7fffu + ((u >> 16) & 1u)) >> 16; }
typedef float f32x2_c __attribute__((ext_vector_type(2))); typedef __bf16 bf16x2_c __attribute__((ext_vector_type(2)));
__device__ __forceinline__ unsigned pk2(float lo, float hi) { f32x2_c v = {lo, hi}; bf16x2_c b = __builtin_convertvector(v, bf16x2_c); return __builtin_bit_cast(unsigned, b); }
__device__ __forceinline__ float bf2f(unsigned b) { return __builtin_bit_cast(float, b << 16); }
__device__ __forceinline__ float bflo(unsigned w) { return __builtin_bit_cast(float, w << 16); }
__device__ __forceinline__ float bfhi(unsigned w) { return __builtin_bit_cast(float, w & 0xffff0000u); }
__device__ __forceinline__ float wave_sum(float v) {
#pragma unroll
    for (int o = 1; o < 64; o <<= 1) v += __shfl_xor(v, o);
    return v;
}
__device__ __forceinline__ float sigmoidf_(float x) { return __builtin_amdgcn_rcpf(1.f + __builtin_amdgcn_exp2f(-LOG2E * x)); }

struct Frame {
    LAS unsigned char* lds;
    int tid, lane, wave, G, vcu;
    const float *x, *meta, *btab, *mixw, *win, *pgw, *pscale, *lq1, *lk1, *lq2, *lk2, *sublnw, *wpo, *wao, *wo, *ffnw, *wg, *wu, *wd, *finw;
    float* out;
    unsigned char* ws;
    bf16 *Win_t, *Wcat_t, *Wo_t, *Wgu_t, *Wd_t;
    bf16 *XN, *UP, *Kb, *Vb, *Qb, *GP, *GA, *MERGED, *HB, *ACT, *ACAT;
    float *PART;
};

struct TrDesc { const float* W; const float* kscale; bf16* WT; int K, N, mode, ldw, item; };
__device__ __forceinline__ void tr_load(const TrDesc& d, int lane, float (&v)[32]) {
    const int nblk = d.N / 32, kb = d.item / nblk, nb = d.item % nblk, k0 = 64 * kb, n0 = 32 * nb;
#pragma unroll
    for (int i = 0; i < 32; ++i) v[i] = __builtin_nontemporal_load(d.W + (size_t)(k0 + 2 * i + (lane >> 5)) * d.N + n0 + (lane & 31));
}
__device__ __forceinline__ void tr_to_lds(const TrDesc& d, int lane, float (&v)[32], LAS float* scr) {
    const int nblk = d.N / 32, kb = d.item / nblk, k0 = 64 * kb;
    if (d.kscale) {
#pragma unroll
        for (int i = 0; i < 32; ++i) v[i] *= d.kscale[k0 + 2 * i + (lane >> 5)]; }
#pragma unroll
    for (int i = 0; i < 32; ++i) scr[(2 * i + (lane >> 5)) * 33 + (lane & 31)] = v[i];
    LDS_WAIT(); asm volatile("" ::: "memory");
}
__device__ __forceinline__ void tr_store(const TrDesc& d, int lane, LAS float* scr) {
    const int nblk = d.N / 32, kb = d.item / nblk, nb = d.item % nblk, k0 = 64 * kb, n0 = 32 * nb;
    const int c = lane & 7;
    const int rbase = (d.mode == 0) ? n0 : ((n0 / 128) * 256 + (n0 % 128) + (d.mode == 2 ? 128 : 0));
#pragma unroll
    for (int j = 0; j < 4; ++j) { const int n = (lane >> 3) + 8 * j; const LAS float* s = scr + (8 * c) * 33 + n;
        u32x4 o; o.x = pk2(s[0 * 33], s[1 * 33]); o.y = pk2(s[2 * 33], s[3 * 33]); o.z = pk2(s[4 * 33], s[5 * 33]); o.w = pk2(s[6 * 33], s[7 * 33]);
        *(u32x4*)(d.WT + (size_t)(rbase + n) * d.ldw + k0 + 8 * c) = o; }
    LDS_WAIT(); asm volatile("" ::: "memory");
}
template <int NR> __device__ __forceinline__ void rms_rows_to_bf16(const float* const (&xrow)[NR], const float* w, bf16* const (&orow)[NR], int lane) {
    f32x4 v[NR][4]; float s[NR];
#pragma unroll
    for (int r = 0; r < NR; ++r) { const f32x4* xr = (const f32x4*)xrow[r] + lane;
#pragma unroll
        for (int j = 0; j < 4; ++j) v[r][j] = __builtin_nontemporal_load(xr + 64 * j); }
    const f32x4* wr = (const f32x4*)w + lane; f32x4 ww[4];
#pragma unroll
    for (int j = 0; j < 4; ++j) ww[j] = wr[64 * j];
#pragma unroll
    for (int r = 0; r < NR; ++r) { s[r] = 0.f;
#pragma unroll
        for (int j = 0; j < 4; ++j) s[r] += (v[r][j].x * v[r][j].x + v[r][j].y * v[r][j].y) + (v[r][j].z * v[r][j].z + v[r][j].w * v[r][j].w); }
#pragma unroll
    for (int r = 0; r < NR; ++r) { const float rstd = 1.f / sqrtf(wave_sum(s[r]) * (1.f / D) + EPS);
        unsigned long long* o8 = (unsigned long long*)orow[r] + lane;
#pragma unroll
        for (int j = 0; j < 4; ++j)
            o8[64 * j] = (unsigned long long)pk2(v[r][j].x * rstd * ww[j].x, v[r][j].y * rstd * ww[j].y) | ((unsigned long long)pk2(v[r][j].z * rstd * ww[j].z, v[r][j].w * rstd * ww[j].w) << 32); }
}
constexpr int I_IN = (D / 64) * (INC / 32), I_AO = (AW / 64) * (D / 32), I_O = (D / 64) * (D / 32), I_G = (D / 64) * (FF / 32), I_D = (FF / 64) * (D / 32);
constexpr int I_EFF = (PW / 4) * (D / 4) / 64;
__device__ __forceinline__ void weff_item(Frame& F, int o) {
    const int kb = o / (D / 4), n0 = (o % (D / 4)) * 4, k0 = kb * 4, g = k0 / 128;
    const float* gwr = F.pgw + (size_t)k0 * 128; const float* wr = F.wpo + (size_t)(g * 128) * D + n0; const float* sc = F.pscale + g * 128;
    f32x4 s0 = {0.f, 0.f, 0.f, 0.f}, s1 = s0, s2 = s0, s3 = s0;
#pragma unroll 16
    for (int d = 0; d < 128; ++d) { const f32x4 wv = *(const f32x4*)(wr + (size_t)d * D) * sc[d];
        s0 += wv * gwr[d]; s1 += wv * gwr[128 + d]; s2 += wv * gwr[256 + d]; s3 += wv * gwr[384 + d]; }
#pragma unroll
    for (int j = 0; j < 4; ++j) { u32x2 w; w.x = pk2(s0[j], s1[j]); w.y = pk2(s2[j], s3[j]); *(u32x2*)(F.Wcat_t + (size_t)(n0 + j) * KC + k0) = w; }
}
__device__ __forceinline__ TrDesc tr_desc(const Frame& F, int q, int r) {
    if (q == 2) return TrDesc{F.win, nullptr, F.Win_t, D, INC, 0, D, r};
    if (q == 1) return TrDesc{F.wd, nullptr, F.Wd_t, FF, D, 0, FF, r};
    if (r < I_AO) return TrDesc{F.wao, nullptr, F.Wcat_t + PW, AW, D, 0, KC, r};
    r -= I_AO; if (r < I_O) return TrDesc{F.wo, nullptr, F.Wo_t, D, D, 0, D, r};
    r -= I_O; if (r < I_G) return TrDesc{F.wg, F.ffnw, F.Wgu_t, D, FF, 1, D, r};
    r -= I_G; return TrDesc{F.wu, F.ffnw, F.Wgu_t, D, FF, 2, D, r};
}
__device__ __forceinline__ void tr_run(const Frame& F, int q, int first, int stride, int total, LAS float* scr) {
    if (first >= total) return;
    float va[32], vb[32];
    TrDesc da = tr_desc(F, q, first), db = da; tr_load(da, F.lane, va);
    for (int it = first; it < total; it += 2 * stride) {
        const bool hb = it + stride < total, ha = it + 2 * stride < total;
        tr_to_lds(da, F.lane, va, scr); if (hb) { db = tr_desc(F, q, it + stride); tr_load(db, F.lane, vb); } tr_store(da, F.lane, scr);
        if (!hb) break;
        tr_to_lds(db, F.lane, vb, scr); if (ha) { da = tr_desc(F, q, it + 2 * stride); tr_load(da, F.lane, va); } tr_store(db, F.lane, scr);
    }
}
__device__ __forceinline__ void p0_prologue(Frame& F) {
    LAS float* scr = (LAS float*)(F.lds + F.wave * 16384);
    const int gw = F.vcu * NWAVES + F.wave, NGW = F.G * NWAVES;
    tr_run(F, 2, gw, NGW, I_IN, scr);
    for (int gidx = gw; gidx < M / 4; gidx += NGW) {
        const float* xr[4]; bf16* orw[4];
#pragma unroll
        for (int r = 0; r < 4; ++r) { const size_t m = (size_t)gidx + (size_t)r * (M / 4); xr[r] = F.x + m * D; orw[r] = F.XN + m * D; }
        rms_rows_to_bf16<4>(xr, F.mixw, orw, F.lane);
    }
    for (int m = M + gw; m < MP; m += NGW) {
        if (m < M + NMETA) { const float* xr[1] = {F.meta + (size_t)(m - M) * D}; bf16* orw[1] = {F.XN + (size_t)m * D}; rms_rows_to_bf16<1>(xr, F.mixw, orw, F.lane); }
        else { unsigned long long* o8 = (unsigned long long*)(F.XN + (size_t)m * D) + F.lane;
#pragma unroll
            for (int j = 0; j < 4; ++j) o8[64 * j] = 0ull; }
    }
}
__device__ __forceinline__ void deferred_weights(Frame& F, int q, int ntiles) {
    LAS float* scr = (LAS float*)(F.lds + F.wave * 16384);
    const int busy = ntiles % F.G, c = (int)blockIdx.x;
    int rank, count; if (busy == 0) { rank = c; count = F.G; } else { if (c < busy) return; rank = c - busy; count = F.G - busy; }
    const int w0 = rank * NWAVES + F.wave, nw = count * NWAVES;
    if (q == 1) { tr_run(F, 1, w0, nw, I_D, scr); return; }
    constexpr int T0 = I_AO + I_O + 2 * I_G, QA = 3;
    if (nw > I_EFF && QA * I_EFF <= T0) {
        if (w0 < I_EFF) { tr_run(F, 0, QA * w0, 1, QA * w0 + QA, scr); weff_item(F, w0 * 64 + F.lane); }
        else tr_run(F, 0, QA * I_EFF + (w0 - I_EFF), nw - I_EFF, T0, scr);
    } else {
        tr_run(F, 0, w0, nw, T0, scr);
        for (int r = w0; r < I_EFF; r += nw) weff_item(F, r * 64 + F.lane);
    }
}

namespace pg8 {
#define PG8_LAS __attribute__((address_space(3)))
typedef unsigned short bf16_t;
typedef short bf16x8 __attribute__((ext_vector_type(8)));
typedef float f32x4 __attribute__((ext_vector_type(4)));
typedef unsigned u32x4 __attribute__((ext_vector_type(4)));
constexpr int BM = 256, BK = 64, HALF = 128, HTB = HALF * BK * 2  , STAGE_BYTES = 8 * HTB, NXCD = 8, WGM = 4;

__host__ __device__ __forceinline__ int lds_byte(int r, int c) { const int st = (r >> 4) * 2 + (c >> 5), rr = r & 15, cc = c & 31, ob = rr * 64 + cc * 2; return st * 1024 + (ob ^ (((ob >> 9) & 1) << 5)); }
__host__ __device__ __forceinline__ void stage_rc(int b, int& R, int& C) { const int st = b / 1024, sb = b % 1024, swz = sb ^ (((sb >> 9) & 1) << 5); R = (st >> 1) * 16 + swz / 64; C = (st & 1) * 32 + (swz % 64) / 2; }
__host__ __device__ __forceinline__ int perm32(int rho) { const int n = rho >> 4, i = rho & 15; return 8 * (i >> 2) + 4 * n + (i & 3); }

struct Unit { int pm, pn; };
struct Gemm { const bf16_t* A; const bf16_t* Bt; int M, N, K; };

struct StaticOrder {
    int nM, nN, nwg, G, c;
    __host__ __device__ void init(int M, int N, int G_, int c_) { nM = M / BM; nN = N / BM; nwg = nM * nN; G = G_; c = c_; }
    __host__ __device__ bool next(int i, Unit& u) const {
        const long L = (long)i * G + c; if (L >= nwg) return false;
        int wgid = (int)L; { const int q = nwg / NXCD, r = nwg % NXCD, xcd = wgid % NXCD, off = wgid / NXCD; wgid = (xcd < r ? xcd * (q + 1) : r * (q + 1) + (xcd - r) * q) + off; }
        const int nig = WGM * nN, gid = wgid / nig, fm = gid * WGM, gsz = (nM - fm) < WGM ? (nM - fm) : WGM;
        u.pm = fm + ((wgid % nig) % gsz); u.pn = (wgid % nig) / gsz; return true;
    }
    __device__ __forceinline__ void a_ready(const Unit&) const {}
    __device__ __forceinline__ void done(const Unit&) const {}
};

__device__ __forceinline__ unsigned cvt_pk_bf16(float lo, float hi) { unsigned r; asm volatile("v_cvt_pk_bf16_f32 %0, %1, %2" : "=v"(r) : "v"(lo), "v"(hi)); return r; }
template <class E, class = void> struct MidT { static constexpr int v = -1; };
template <class E> struct MidT<E, decltype((void)E::MID_T)> { static constexpr int v = E::MID_T; };
template <class Epi, class Sched, bool ALIGN_EPI = false, bool SP2 = false>
__device__ __forceinline__ void gemm_phase(PG8_LAS unsigned char* lds, const Gemm g, const Sched& S, const Epi& E, const int wid, const int lane) {
    const int tid = wid * 64 + lane, wr = wid >> 2, wc = wid & 3, fr = lane & 15, fq = lane >> 4;
    const int K = g.K, nt = K / BK;
    unsigned voffA[2], voffB[2];
#pragma unroll
    for (int i = 0; i < 2; ++i) { int R, C; stage_rc(tid * 16 + i * 8192, R, C); const int Rb = Epi::PERM ? ((R & ~31) + perm32(R & 31)) : R;
        voffA[i] = (unsigned)(R * K + C) * 2u; voffB[i] = (unsigned)(Rb * K + C) * 2u; }
    const size_t kstep = (size_t)(BK * 2);
    const size_t hstep = (size_t)HALF * K * 2;
    const size_t tstep = 2 * hstep;
    const unsigned ldsw = (unsigned)wid * 1024u;
    const int aoff = lds_byte(wr * 64 + fr, fq * 8), boff = lds_byte(wc * 32 + fr, fq * 8);
#define PG8_SA(b, h) (((b) * 2 + (h)) * HTB)
#define PG8_SB(b, h) ((4 + (b) * 2 + (h)) * HTB)
#define PG8_STAGE(bufoff, gbase, voff) do { _Pragma("unroll") for (int _i = 0; _i < 2; ++_i) \
        __builtin_amdgcn_global_load_lds((const unsigned*)((const char*)(gbase) + (voff)[_i]), (PG8_LAS unsigned*)(lds + (bufoff) + ldsw + _i * 8192), 16, 0, 0); } while (0)
#define PG8_LDA(dst, b, h) do { _Pragma("unroll") for (int m = 0; m < 4; ++m) _Pragma("unroll") for (int k = 0; k < 2; ++k) dst[m][k] = *(const PG8_LAS bf16x8*)(lds + PG8_SA(b, h) + aoff + m * 2048 + k * 1024); } while (0)
#define PG8_LDB(dst, b, h) do { _Pragma("unroll") for (int n = 0; n < 2; ++n) _Pragma("unroll") for (int k = 0; k < 2; ++k) dst[n][k] = *(const PG8_LAS bf16x8*)(lds + PG8_SB(b, h) + boff + n * 2048 + k * 1024); } while (0)
#define PG8_MMA(ai, bj, At, Bt) do { __builtin_amdgcn_s_setprio(1); _Pragma("unroll") for (int m = 0; m < 4; ++m) _Pragma("unroll") for (int n = 0; n < 2; ++n) _Pragma("unroll") for (int k = 0; k < 2; ++k) \
        acc[ai][bj][m][n] = __builtin_amdgcn_mfma_f32_16x16x32_bf16(Bt[n][k], At[m][k], acc[ai][bj][m][n], 0, 0, 0); __builtin_amdgcn_s_setprio(0); } while (0)
#define PG8_WAIT_V(n) asm volatile("s_waitcnt vmcnt(" #n ")" ::: "memory")
#define PG8_WAIT_L(n) asm volatile("s_waitcnt lgkmcnt(" #n ")" ::: "memory")
#define PG8_BAR __builtin_amdgcn_s_barrier()
#define PG8_SCHED __builtin_amdgcn_sched_barrier(0)
    Unit cur, nxt; int ui = 0;
    if (!S.next(0, cur)) return;
    f32x4 acc[2][2][4][2];
#pragma unroll
    for (int a = 0; a < 2; ++a)
#pragma unroll
        for (int b = 0; b < 2; ++b)
#pragma unroll
            for (int m = 0; m < 4; ++m)
#pragma unroll
                for (int n = 0; n < 2; ++n) acc[a][b][m][n] = (f32x4){0.f, 0.f, 0.f, 0.f};
    bf16x8 At[4][2], B0[2][2], B1[2][2];
    const char* cA = (const char*)g.A + (size_t)cur.pm * tstep; const char* cB = (const char*)g.Bt + (size_t)cur.pn * tstep;
    S.a_ready(cur);
    if constexpr (SP2) {
        PG8_STAGE(PG8_SB(0, 0), cB, voffB); PG8_STAGE(PG8_SB(0, 1), cB + hstep, voffB); PG8_STAGE(PG8_SA(0, 0), cA, voffA); PG8_STAGE(PG8_SA(0, 1), cA + hstep, voffA);
        if (wr == 1) PG8_BAR;
        PG8_WAIT_V(2); PG8_BAR;
        PG8_STAGE(PG8_SB(1, 0), cB + kstep, voffB); PG8_STAGE(PG8_SA(1, 0), cA + kstep, voffA); PG8_STAGE(PG8_SB(1, 1), cB + hstep + kstep, voffB);
        PG8_WAIT_V(6); PG8_BAR;
    } else {
        PG8_STAGE(PG8_SB(0, 0), cB, voffB); PG8_STAGE(PG8_SA(0, 0), cA, voffA); PG8_STAGE(PG8_SB(0, 1), cB + hstep, voffB); PG8_STAGE(PG8_SA(0, 1), cA + hstep, voffA);
        if (wr == 1) PG8_BAR;
        PG8_WAIT_V(4); PG8_BAR;
        PG8_STAGE(PG8_SB(1, 0), cB + kstep, voffB); PG8_STAGE(PG8_SA(1, 0), cA + kstep, voffA); PG8_STAGE(PG8_SB(1, 1), cB + hstep + kstep, voffB);
        PG8_WAIT_V(6); PG8_BAR;
    }
    for (;;) {
        const bool has_next = S.next(ui + 1, nxt);
        const char* nA = has_next ? (const char*)g.A + (size_t)nxt.pm * tstep : cA; const char* nB = has_next ? (const char*)g.Bt + (size_t)nxt.pn * tstep : cB;
        for (int t = 0; t < nt; t += 2) {
            if constexpr (MidT<Epi>::v >= 0) { if (t == MidT<Epi>::v) { PG8_SCHED; E.mid(acc, cur, wr, wc, fr, fq); PG8_SCHED; } }
            const bool last = (t == nt - 2);
            const char* a1 = cA + (size_t)(t + 1) * kstep;
            const char* a2 = last ? nA : cA + (size_t)(t + 2) * kstep; const char* b2 = last ? nB : cB + (size_t)(t + 2) * kstep;
            const char* a3 = a2 + kstep; const char* b3 = b2 + kstep;
            if (last && has_next) S.a_ready(nxt);
            if constexpr (SP2) {
            PG8_LDB(B0, 0, 0); PG8_LDB(B1, 0, 1); PG8_SCHED; PG8_LDA(At, 0, 0); PG8_STAGE(PG8_SA(1, 1), a1 + hstep, voffA);
            PG8_WAIT_V(8); PG8_WAIT_L(0); PG8_BAR; PG8_MMA(0, 0, At, B0); PG8_MMA(0, 1, At, B1); PG8_BAR; PG8_SCHED;
            PG8_LDA(At, 0, 1); PG8_STAGE(PG8_SB(0, 0), b2, voffB); PG8_STAGE(PG8_SB(0, 1), b2 + hstep, voffB); PG8_STAGE(PG8_SA(0, 0), a2, voffA);
            PG8_WAIT_V(8); PG8_WAIT_L(0); PG8_BAR; PG8_MMA(1, 0, At, B0); PG8_MMA(1, 1, At, B1); PG8_BAR; PG8_SCHED;
            PG8_LDB(B0, 1, 0); PG8_LDB(B1, 1, 1); PG8_SCHED; PG8_LDA(At, 1, 0); PG8_STAGE(PG8_SA(0, 1), a2 + hstep, voffA);
            PG8_WAIT_V(8); PG8_WAIT_L(0); PG8_BAR; PG8_MMA(0, 0, At, B0); PG8_MMA(0, 1, At, B1); PG8_BAR; PG8_SCHED;
            PG8_LDA(At, 1, 1); PG8_STAGE(PG8_SB(1, 0), b3, voffB); PG8_STAGE(PG8_SB(1, 1), b3 + hstep, voffB); PG8_STAGE(PG8_SA(1, 0), a3, voffA);
            PG8_WAIT_V(8); PG8_WAIT_L(0); PG8_BAR; PG8_MMA(1, 0, At, B0); PG8_MMA(1, 1, At, B1); PG8_BAR; PG8_SCHED;
            } else {
            PG8_LDB(B0, 0, 0); PG8_SCHED; PG8_LDA(At, 0, 0); PG8_STAGE(PG8_SA(1, 1), a1 + hstep, voffA);
            PG8_WAIT_L(8); PG8_BAR; PG8_WAIT_L(0); PG8_MMA(0, 0, At, B0); PG8_BAR; PG8_SCHED;
            PG8_LDB(B1, 0, 1); PG8_STAGE(PG8_SB(0, 0), b2, voffB);
            PG8_BAR; PG8_WAIT_L(0); PG8_MMA(0, 1, At, B1); PG8_BAR;
            PG8_LDA(At, 0, 1); PG8_STAGE(PG8_SA(0, 0), a2, voffA);
            PG8_BAR; PG8_WAIT_L(0); PG8_MMA(1, 0, At, B0); PG8_BAR; PG8_SCHED;
            PG8_STAGE(PG8_SB(0, 1), b2 + hstep, voffB);
            PG8_WAIT_V(6); PG8_BAR; PG8_MMA(1, 1, At, B1); PG8_BAR;
            PG8_LDB(B0, 1, 0); PG8_SCHED; PG8_LDA(At, 1, 0); PG8_STAGE(PG8_SA(0, 1), a2 + hstep, voffA);
            PG8_WAIT_L(8); PG8_BAR; PG8_WAIT_L(0); PG8_MMA(0, 0, At, B0); PG8_BAR; PG8_SCHED;
            PG8_LDB(B1, 1, 1); PG8_STAGE(PG8_SB(1, 0), b3, voffB);
            PG8_BAR; PG8_WAIT_L(0); PG8_MMA(0, 1, At, B1); PG8_BAR;
            PG8_LDA(At, 1, 1); PG8_STAGE(PG8_SA(1, 0), a3, voffA);
            PG8_BAR; PG8_WAIT_L(0); PG8_MMA(1, 0, At, B0); PG8_BAR; PG8_SCHED;
            PG8_STAGE(PG8_SB(1, 1), b3 + hstep, voffB);
            PG8_WAIT_V(6); PG8_BAR; PG8_MMA(1, 1, At, B1); PG8_BAR;
            }
        }
        if constexpr (ALIGN_EPI) { if (wr == 0) PG8_BAR; }
        if constexpr (!Epi::AFTER_DRAIN) { E(acc, cur, wr, wc, fr, fq); S.done(cur); }
        if (!has_next) break;
#pragma unroll
        for (int a = 0; a < 2; ++a)
#pragma unroll
            for (int b = 0; b < 2; ++b)
#pragma unroll
                for (int m = 0; m < 4; ++m)
#pragma unroll
                    for (int n = 0; n < 2; ++n) acc[a][b][m][n] = (f32x4){0.f, 0.f, 0.f, 0.f};
        cur = nxt; cA = nA; cB = nB; ++ui;
        if constexpr (ALIGN_EPI) { if (wr == 1) PG8_BAR; }
    }
    PG8_WAIT_V(0);
    if constexpr (!ALIGN_EPI) { if (wr == 0) PG8_BAR; }
    PG8_BAR;
    if constexpr (Epi::AFTER_DRAIN) { E.fused(acc, cur, wr, wc, fr, fq, lds, wid, lane); S.done(cur); }
#undef PG8_SA
#undef PG8_SB
#undef PG8_STAGE
#undef PG8_LDA
#undef PG8_LDB
#undef PG8_MMA
#undef PG8_WAIT_V
#undef PG8_WAIT_L
#undef PG8_BAR
#undef PG8_SCHED
}
}

struct EpiP1 {
    bf16 *UP, *Qb, *Kb, *Vb, *GP, *GA;
    __device__ __forceinline__ void store8(int row, int col, f32x4 a, f32x4 b) const {
        bf16* dst; int c;
        if (col < 512) { dst = UP + (size_t)row * PW; c = col; }
        else if (col < 1536) { if (row >= M) return; dst = Qb + (size_t)row * AW; c = col - 512; a = a * QSCALE; b = b * QSCALE; }
        else if (col < 2560) { dst = Kb + (size_t)row * AW; c = col - 1536; }
        else if (col < 3584) { dst = Vb + (size_t)row * AW; c = col - 2560; }
        else { if (row >= M) return; const bool ga = col >= 4608; dst = (ga ? GA : GP) + (size_t)row * D; c = col - (ga ? 4608 : 3584);
#pragma unroll
            for (int i = 0; i < 4; ++i) { a[i] = sigmoidf_(a[i]); b[i] = sigmoidf_(b[i]); } }
        u32x4 w; w.x = pk2(a[0], a[1]); w.y = pk2(a[2], a[3]); w.z = pk2(b[0], b[1]); w.w = pk2(b[2], b[3]);
        *(u32x4*)(dst + c) = w;
    }
};
struct EpiP3 {
    static constexpr bool PERM = true, AFTER_DRAIN = false; static constexpr int MID_T = PW / 64;
    const bf16 *GP, *GA; bf16* MERGED;
    __device__ __forceinline__ static float gsafe(float g) { return __builtin_fmaxf(g, 8.6736174e-19f); }
    __device__ __forceinline__ void mid(f32x4 (&acc)[2][2][4][2], const pg8::Unit& u, int wr, int wc, int fr, int fq) const {
        asm volatile("" : "+v"(fr), "+v"(fq));
        const int row0 = u.pm * 256 + wr * 64 + fr, col0 = u.pn * 256 + wc * 32 + 8 * fq;
#pragma unroll
        for (int ai = 0; ai < 2; ++ai)
#pragma unroll
            for (int m = 0; m < 4; ++m) { const size_t ro = (size_t)(row0 + ai * 128 + m * 16) * D + col0;
#pragma unroll
                for (int bj = 0; bj < 2; ++bj) { const u32x4 p = *(const u32x4*)(GP + ro + bj * 128), a = *(const u32x4*)(GA + ro + bj * 128);
                    f32x4& x = acc[ai][bj][m][0]; f32x4& y = acc[ai][bj][m][1];
                    x[0] *= bflo(p.x) * __builtin_amdgcn_rcpf(gsafe(bflo(a.x))); x[1] *= bfhi(p.x) * __builtin_amdgcn_rcpf(gsafe(bfhi(a.x)));
                    x[2] *= bflo(p.y) * __builtin_amdgcn_rcpf(gsafe(bflo(a.y))); x[3] *= bfhi(p.y) * __builtin_amdgcn_rcpf(gsafe(bfhi(a.y)));
                    y[0] *= bflo(p.z) * __builtin_amdgcn_rcpf(gsafe(bflo(a.z))); y[1] *= bfhi(p.z) * __builtin_amdgcn_rcpf(gsafe(bfhi(a.z)));
                    y[2] *= bflo(p.w) * __builtin_amdgcn_rcpf(gsafe(bflo(a.w))); y[3] *= bfhi(p.w) * __builtin_amdgcn_rcpf(gsafe(bfhi(a.w))); }
                asm volatile("" : "+v"(acc[ai][0][m][0]), "+v"(acc[ai][0][m][1]), "+v"(acc[ai][1][m][0]), "+v"(acc[ai][1][m][1]));
                asm volatile("" ::: "memory"); }
    }
    __device__ __forceinline__ void operator()(const f32x4 (&acc)[2][2][4][2], const pg8::Unit& u, int wr, int wc, int fr, int fq) const {
        const int row0 = u.pm * 256 + wr * 64 + fr, col0 = u.pn * 256 + wc * 32 + 8 * fq;
#pragma unroll
        for (int ai = 0; ai < 2; ++ai)
#pragma unroll
            for (int m = 0; m < 4; ++m) { const size_t ro = (size_t)(row0 + ai * 128 + m * 16) * D + col0;
#pragma unroll
                for (int bj = 0; bj < 2; ++bj) { const u32x4 a = *(const u32x4*)(GA + ro + bj * 128); const f32x4 x = acc[ai][bj][m][0], y = acc[ai][bj][m][1];
                    u32x4 w; w.x = pk2(x[0] * gsafe(bflo(a.x)), x[1] * gsafe(bfhi(a.x))); w.y = pk2(x[2] * gsafe(bflo(a.y)), x[3] * gsafe(bfhi(a.y)));
                    w.z = pk2(y[0] * gsafe(bflo(a.z)), y[1] * gsafe(bfhi(a.z))); w.w = pk2(y[2] * gsafe(bflo(a.w)), y[3] * gsafe(bfhi(a.w)));
                    *(u32x4*)(MERGED + ro + bj * 128) = w; } }
    }
};
struct EpiP4 {
    const float* x; bf16* HB;
    __device__ __forceinline__ float store8(int row, int col, f32x4 a, f32x4 b) const {
        const float* xr = x + (size_t)row * D + col; a = a + __builtin_nontemporal_load((const f32x4*)xr); b = b + __builtin_nontemporal_load((const f32x4*)(xr + 4));
        u32x4 w; w.x = pk2(a[0], a[1]); w.y = pk2(a[2], a[3]); w.z = pk2(b[0], b[1]); w.w = pk2(b[2], b[3]);
        *(u32x4*)(HB + (size_t)row * D + col) = w;
        return (a[0] * a[0] + a[1] * a[1]) + (a[2] * a[2] + a[3] * a[3]) + (b[0] * b[0] + b[1] * b[1]) + (b[2] * b[2] + b[3] * b[3]);
    }
};
struct EpiP5 {
    bf16* ACT;
    __device__ __forceinline__ void store8(int row, int ocol, float rstd, f32x4 g0, f32x4 g1, f32x4 u0, f32x4 u1) const {
        float r[8];
#pragma unroll
        for (int i = 0; i < 4; ++i) { const float ga = g0[i] * rstd, gb = g1[i] * rstd; r[i] = ga * sigmoidf_(ga) * (u0[i] * rstd); r[4 + i] = gb * sigmoidf_(gb) * (u1[i] * rstd); }
        u32x4 w; w.x = pk2(r[0], r[1]); w.y = pk2(r[2], r[3]); w.z = pk2(r[4], r[5]); w.w = pk2(r[6], r[7]);
        *(u32x4*)(ACT + (size_t)row * FF + ocol) = w;
    }
};
struct EpiP6 {
    const bf16* HB; float* H;
    __device__ __forceinline__ void store8(int row, int col, f32x4 a, f32x4 b) const {
        const u32x4 h = *(const u32x4*)(HB + (size_t)row * D + col); float* o = H + (size_t)row * D + col;
        a[0] += bflo(h.x); a[1] += bfhi(h.x); a[2] += bflo(h.y); a[3] += bfhi(h.y); b[0] += bflo(h.z); b[1] += bfhi(h.z); b[2] += bflo(h.w); b[3] += bfhi(h.w);
        *(f32x4*)o = a; *(f32x4*)(o + 4) = b;
    }
};

template <class Fn> struct Epi8 {
    static constexpr bool PERM = true, AFTER_DRAIN = false; Fn f;
    __device__ __forceinline__ void operator()(const f32x4 (&acc)[2][2][4][2], const pg8::Unit& u, int wr, int wc, int fr, int fq) const {
        const int row0 = u.pm * 256 + wr * 64 + fr, col0 = u.pn * 256 + wc * 32 + 8 * fq;
#pragma unroll
        for (int ai = 0; ai < 2; ++ai)
#pragma unroll
            for (int m = 0; m < 4; ++m) { const int row = row0 + ai * 128 + m * 16;
#pragma unroll
                for (int bj = 0; bj < 2; ++bj) f.store8(row, col0 + bj * 128, acc[ai][bj][m][0], acc[ai][bj][m][1]); }
    }
};
struct Epi8P1 {
    static constexpr bool PERM = true, AFTER_DRAIN = false; EpiP1 f;
    template <int CLS> __device__ __forceinline__ void half(const f32x4 (&acc)[2][2][4][2], int bj, int row0, int cb) const {
        bf16* base = CLS == 0 ? f.UP : CLS == 1 ? f.Qb : CLS == 2 ? f.Kb : CLS == 3 ? f.Vb : CLS == 4 ? f.GP : f.GA;
        constexpr int ldc = CLS == 0 ? PW : (CLS >= 4 ? D : AW);
#pragma unroll
        for (int ai = 0; ai < 2; ++ai)
#pragma unroll
            for (int m = 0; m < 4; ++m) { const int row = row0 + ai * 128 + m * 16; f32x4 a = bj ? acc[ai][1][m][0] : acc[ai][0][m][0], b = bj ? acc[ai][1][m][1] : acc[ai][0][m][1];
                if (CLS == 1) { a = a * QSCALE; b = b * QSCALE; }
                if (CLS >= 4) {
#pragma unroll
                    for (int i = 0; i < 4; ++i) { a[i] = sigmoidf_(a[i]); b[i] = sigmoidf_(b[i]); } }
                u32x4 w; w.x = pk2(a[0], a[1]); w.y = pk2(a[2], a[3]); w.z = pk2(b[0], b[1]); w.w = pk2(b[2], b[3]);
                *(u32x4*)(base + (size_t)row * ldc + cb) = w; }
    }
    __device__ __forceinline__ void operator()(const f32x4 (&acc)[2][2][4][2], const pg8::Unit& u, int wr, int wc, int fr, int fq) const {
        asm volatile("" : "+v"(fr), "+v"(fq));
        const int row0 = u.pm * 256 + wr * 64 + fr, lc = wc * 32 + 8 * fq;
        const bool meta_panel = u.pm >= M / 256;
#pragma unroll
        for (int bj = 0; bj < 2; ++bj) {
            const int colt = u.pn * 256 + bj * 128;
            if (colt < 512) half<0>(acc, bj, row0, colt + lc);
            else if (colt < 1536) { if (!meta_panel) half<1>(acc, bj, row0, colt - 512 + lc); }
            else if (colt < 2560) half<2>(acc, bj, row0, colt - 1536 + lc);
            else if (colt < 3584) half<3>(acc, bj, row0, colt - 2560 + lc);
            else if (colt < 4608) { if (!meta_panel) half<4>(acc, bj, row0, colt - 3584 + lc); }
            else { if (!meta_panel) half<5>(acc, bj, row0, colt - 4608 + lc); }
        }
    }
};
struct Epi8P4 {
    static constexpr bool PERM = true, AFTER_DRAIN = false; EpiP4 f; float* PART;
    __device__ __forceinline__ void operator()(const f32x4 (&acc)[2][2][4][2], const pg8::Unit& u, int wr, int wc, int fr, int fq) const {
        const int row0 = u.pm * 256 + wr * 64 + fr, col0 = u.pn * 256 + wc * 32 + 8 * fq;
#pragma unroll
        for (int ai = 0; ai < 2; ++ai)
#pragma unroll
            for (int m = 0; m < 4; ++m) { const int row = row0 + ai * 128 + m * 16;
                float s = f.store8(row, col0, acc[ai][0][m][0], acc[ai][0][m][1]) + f.store8(row, col0 + 128, acc[ai][1][m][0], acc[ai][1][m][1]);
                s += __shfl_xor(s, 16); s += __shfl_xor(s, 32);
                if (fq == 0) PART[(size_t)row * 16 + u.pn * 4 + wc] = s; }
    }
};
struct Epi8P5 {
    static constexpr bool PERM = true, AFTER_DRAIN = false; EpiP5 f; const float* PART;
    __device__ __forceinline__ void operator()(const f32x4 (&acc)[2][2][4][2], const pg8::Unit& u, int wr, int wc, int fr, int fq) const {
        const int row0 = u.pm * 256 + wr * 64 + fr, ocol = u.pn * 128 + wc * 32 + 8 * fq;
#pragma unroll
        for (int ai = 0; ai < 2; ++ai)
#pragma unroll
            for (int m = 0; m < 4; ++m) { const int row = row0 + ai * 128 + m * 16;
                const f32x4 p = *(const f32x4*)(PART + (size_t)row * 16 + 4 * fq); float s = (p.x + p.y) + (p.z + p.w);
                s += __shfl_xor(s, 16); s += __shfl_xor(s, 32);
                const float rstd = __builtin_amdgcn_rsqf(s * (1.f / D) + EPS);
                f.store8(row, ocol, rstd, acc[ai][0][m][0], acc[ai][0][m][1], acc[ai][1][m][0], acc[ai][1][m][1]); }
    }
};
struct EpiFinal {
    static constexpr bool PERM = true, AFTER_DRAIN = true;
    const bf16* HB; float* H; const float* finw; unsigned* xbuf; unsigned* cnt;
    __device__ __forceinline__ void fused(f32x4 (&acc)[2][2][4][2], const pg8::Unit& u, int wr, int wc, int fr, int fq, LAS unsigned char* lds, int wid, int lane) const {
        LAS float* P = (LAS float*)lds;
        LAS float* S = (LAS float*)(lds + 4096);
        const int row0 = u.pm * 256 + wr * 64 + fr, col0 = u.pn * 256 + wc * 32 + 8 * fq;
#pragma unroll
        for (int ai = 0; ai < 2; ++ai)
#pragma unroll
            for (int m = 0; m < 4; ++m) { const int row = row0 + ai * 128 + m * 16; float s = 0.f;
#pragma unroll
                for (int bj = 0; bj < 2; ++bj) { const u32x4 h = *(const u32x4*)(HB + (size_t)row * D + col0 + bj * 128);
                    const f32x4 a = acc[ai][bj][m][0] + (f32x4){bflo(h.x), bfhi(h.x), bflo(h.y), bfhi(h.y)}, b = acc[ai][bj][m][1] + (f32x4){bflo(h.z), bfhi(h.z), bflo(h.w), bfhi(h.w)}; acc[ai][bj][m][0] = a; acc[ai][bj][m][1] = b;
                    s += (a[0] * a[0] + a[1] * a[1]) + (a[2] * a[2] + a[3] * a[3]) + (b[0] * b[0] + b[1] * b[1]) + (b[2] * b[2] + b[3] * b[3]); }
                s += __shfl_xor(s, 16); s += __shfl_xor(s, 32);
                if (fq == 0) P[(ai * 128 + wr * 64 + m * 16 + fr) * 4 + wc] = s;
                if (m & 1) asm volatile("" ::: "memory"); }
        asm volatile("s_waitcnt lgkmcnt(0)" ::: "memory"); __builtin_amdgcn_s_barrier(); asm volatile("" ::: "memory");
        const int row = wid * 32 + (lane & 31);
        if (lane < 32) { const f32x4 p = *(const LAS f32x4*)(P + row * 4); const float t = (p.x + p.y) + (p.z + p.w);
            __hip_atomic_store(xbuf + ((size_t)(u.pm * 256 + row) * 4 + u.pn), __float_as_uint(t), __ATOMIC_RELAXED, __HIP_MEMORY_SCOPE_AGENT); }
        asm volatile("s_waitcnt vmcnt(0)" ::: "memory");
        if (lane == 0) __hip_atomic_fetch_add(cnt + 64 * u.pm, 1u, __ATOMIC_RELAXED, __HIP_MEMORY_SCOPE_AGENT);
        if (wid == 0) {
            for (unsigned sp = 0; sp < (1u << 22); ++sp) {
                if ((unsigned)__builtin_amdgcn_readfirstlane(__hip_atomic_load(cnt + 64 * u.pm, __ATOMIC_RELAXED, __HIP_MEMORY_SCOPE_AGENT)) >= 32u) break;
                __builtin_amdgcn_s_sleep(2); }
            __builtin_amdgcn_fence(__ATOMIC_ACQUIRE, "agent");
        }
        asm volatile("s_waitcnt vmcnt(0) lgkmcnt(0)" ::: "memory"); __builtin_amdgcn_s_barrier(); asm volatile("" ::: "memory");
        if (lane < 32) { const unsigned* slot = xbuf + (size_t)(u.pm * 256 + row) * 4; float t = 0.f;
#pragma unroll
            for (int k = 0; k < 4; ++k) t += __uint_as_float(__hip_atomic_load(slot + k, __ATOMIC_RELAXED, __HIP_MEMORY_SCOPE_AGENT));
            S[row] = 1.f / sqrtf(t * (1.f / D) + EPS); }
        asm volatile("s_waitcnt lgkmcnt(0)" ::: "memory"); __builtin_amdgcn_s_barrier(); asm volatile("" ::: "memory");
        f32x4 wv[2][2];
#pragma unroll
        for (int bj = 0; bj < 2; ++bj) { wv[bj][0] = *(const f32x4*)(finw + col0 + bj * 128); wv[bj][1] = *(const f32x4*)(finw + col0 + bj * 128 + 4); }
#pragma unroll
        for (int ai = 0; ai < 2; ++ai)
#pragma unroll
            for (int m = 0; m < 4; ++m) { const int r = ai * 128 + wr * 64 + m * 16 + fr; const float rs = S[r]; float* h = H + (size_t)(u.pm * 256 + r) * D + col0;
#pragma unroll
                for (int bj = 0; bj < 2; ++bj) { *(f32x4*)(h + bj * 128) = acc[ai][bj][m][0] * rs * wv[bj][0]; *(f32x4*)(h + bj * 128 + 4) = acc[ai][bj][m][1] * rs * wv[bj][1]; } }
    }
};
struct OrderP1 {
    pg8::StaticOrder so;
    __device__ void init(int G, int c) { so.init(M, INC, G, c); }
    __device__ bool next(int i, pg8::Unit& u) const {
        if (so.next(i, u)) return true;
        const long e = (long)i * so.G + so.c - so.nwg; if (e < 0 || e >= 10) return false;
        u.pm = M / 256; u.pn = (e < 2) ? (int)e : (int)e + 4; return true;
    }
    __device__ __forceinline__ void a_ready(const pg8::Unit&) const {}
    __device__ __forceinline__ void done(const pg8::Unit&) const {}
};

__device__ __forceinline__ void bf8_add(float (&s)[8], const u32x4 v, float sg) {
    s[0] += sg * bflo(v.x); s[1] += sg * bfhi(v.x); s[2] += sg * bflo(v.y); s[3] += sg * bfhi(v.y); s[4] += sg * bflo(v.z); s[5] += sg * bfhi(v.z); s[6] += sg * bflo(v.w); s[7] += sg * bfhi(v.w);
}
__device__ __forceinline__ void pool_phase(Frame& F) {
    constexpr int RUN = 8;
    const long total = (long)(M / RUN) * (PW / 8);
    for (long it = (long)blockIdx.x * NTHR + F.tid; it < total; it += (long)F.G * NTHR) {
        const int m0 = (int)(it / (PW / 8)) * RUN, c0 = (int)(it % (PW / 8)) * 8, b = m0 / SEQ, t0 = m0 % SEQ, g = c0 / 128, w = 2 << g;
        const float iw = 1.f / (float)w;
        auto urow = [&](int tt) -> const bf16* { return F.UP + ((tt >= 0) ? (size_t)(b * SEQ + tt) : (size_t)(M + NMETA + tt)) * PW + c0; };
        float s[8];
#pragma unroll
        for (int j = 0; j < 8; ++j) s[j] = 0.f;
        for (int i = 1; i < w; ++i) bf8_add(s, *(const u32x4*)urow(t0 - i), 1.f);
#pragma unroll
        for (int r = 0; r < RUN; ++r) { const int t = t0 + r;
            const u32x4 self = *(const u32x4*)urow(t); bf8_add(s, self, 1.f);
            u32x4 o; o.x = pk2(s[0] * iw - bflo(self.x), s[1] * iw - bfhi(self.x)); o.y = pk2(s[2] * iw - bflo(self.y), s[3] * iw - bfhi(self.y));
            o.z = pk2(s[4] * iw - bflo(self.z), s[5] * iw - bfhi(self.z)); o.w = pk2(s[6] * iw - bflo(self.w), s[7] * iw - bfhi(self.w));
            *(u32x4*)(F.ACAT + (size_t)(m0 + r) * KC + c0) = o;
            if (r + 1 < RUN) bf8_add(s, *(const u32x4*)urow(t - w + 1), -1.f); }
    }
}

__device__ __forceinline__ int t5_bucket(int rel) {
    const int n = rel < 0 ? -rel : rel; int r = rel > 0 ? 16 : 0;
    int v;
    if (n < 8) v = n; else if (n < 12) v = 8; else if (n < 16) v = 9; else if (n < 23) v = 10; else if (n < 32) v = 11; else if (n < 46) v = 12; else if (n < 64) v = 13; else if (n < 91) v = 14; else v = 15;
    return r + v;
}
__device__ __forceinline__ float compute_lambda(const Frame& F) {
    float a = 0.f, b = 0.f;
    for (int i = 0; i < HD; ++i) { a += F.lq1[i] * F.lk1[i]; b += F.lq2[i] * F.lk2[i]; }
    return __expf(a) - __expf(b) + 0.2f;
}
namespace attn {
typedef short bf16x8 __attribute__((ext_vector_type(8)));
typedef short s16x4 __attribute__((ext_vector_type(4)));
typedef float f32x16 __attribute__((ext_vector_type(16)));
typedef short v4i16_t __attribute__((ext_vector_type(4)));
typedef LAS const char* lds_cptr;
constexpr int RSLOT = 16384, LDS_KR = 0, LDS_VR = 3 * RSLOT;
constexpr int STG_PITCH = 132;
constexpr int LDS_WS = 6 * RSLOT, LDS_BIAS = LDS_WS + 2048, NBIAS = 320;
constexpr int THR = 8;
static_assert(128 * STG_PITCH * 4 <= LDS_WS && LDS_BIAS + NBIAS * 4 <= RING_BYTES, "attention LDS map");
__device__ __forceinline__ int crow(int r, int hi) { return (r & 3) + 8 * (r >> 2) + 4 * hi; }
__device__ __forceinline__ void glds16s(const void* sbase, unsigned voff, unsigned lds_dst) { unsigned keep;
    asm volatile("s_nop 4\n\ts_mov_b32 %0, m0\n\ts_mov_b32 m0, %3\n\ts_nop 0\n\tglobal_load_lds_dwordx4 %1, %2\n\ts_mov_b32 m0, %0" : "=&s"(keep) : "v"(voff), "s"(sbase), "s"(lds_dst) : "memory"); }
typedef float f32x2_t __attribute__((ext_vector_type(2))); typedef __bf16 bf16x2_t __attribute__((ext_vector_type(2)));
__device__ __forceinline__ unsigned cvtpk(float lo, float hi) { f32x2_t v = {lo, hi}; bf16x2_t b = __builtin_convertvector(v, bf16x2_t); return __builtin_bit_cast(unsigned, b); }
__device__ __forceinline__ s16x4 vtr(lds_cptr p) { return __builtin_bit_cast(s16x4, __builtin_amdgcn_ds_read_tr16_b64_v4i16((LAS v4i16_t*)p)); }
#define ATT_WAIT_BAR() asm volatile("s_waitcnt vmcnt(0) lgkmcnt(0)\n\ts_barrier" ::: "memory")
#define ATT_MX3(a, b, c) __builtin_fmaxf(__builtin_fmaxf((a), (b)), (c))
__device__ __forceinline__ float rowmax(const f32x16& p0, const f32x16& p1) {
    float a = ATT_MX3(p0[0], p0[1], p1[0]), b = ATT_MX3(p0[2], p0[3], p1[1]); a = ATT_MX3(a, p1[2], p1[3]);
#pragma unroll
    for (int r = 4; r < 16; r += 4) { a = ATT_MX3(a, p0[r], p0[r + 1]); b = ATT_MX3(b, p0[r + 2], p0[r + 3]); a = ATT_MX3(a, p1[r], p1[r + 1]); b = ATT_MX3(b, p1[r + 2], p1[r + 3]); }
    float m = __builtin_fmaxf(a, b); auto rr = __builtin_amdgcn_permlane32_swap(__float_as_uint(m), __float_as_uint(m), false, false);
    return __builtin_fmaxf(__uint_as_float(rr[0]), __uint_as_float(rr[1]));
}

__device__ __forceinline__ void pv_tile(f32x16 (&o)[4], const u32x4 (&pw)[4], const lds_cptr vp) {
#pragma unroll
    for (int db = 0; db < 4; ++db)
#pragma unroll
        for (int ks = 0; ks < 4; ++ks) {
            const s16x4 lo = vtr(vp + db * 4096 + ks * 1024), hh = vtr(vp + db * 4096 + ks * 1024 + 512);
            const bf16x8 vf = (bf16x8){lo[0], lo[1], lo[2], lo[3], hh[0], hh[1], hh[2], hh[3]};
            o[db] = __builtin_amdgcn_mfma_f32_32x32x16_bf16(__builtin_bit_cast(bf16x8, pw[ks]), vf, o[db], 0, 0, 0);
        }
}
#define ATT_SBAR() __builtin_amdgcn_sched_barrier(0)
#define ATT_PIN(x) asm volatile("" : "+v"(x))
#define ATT_MFMA(a, b, c) __builtin_amdgcn_mfma_f32_32x32x16_bf16(a, b, c, 0, 0, 0)

__device__ __forceinline__ void attn_unit(const Frame& F, int b, int h, int qb, float lam) {
    int lane = F.lane; asm volatile("" : "+v"(lane));
    const int r32 = lane & 31, hi = lane >> 5, wid = F.wave, rg = wid & 3, map = wid >> 2;
    const int q0w = qb * 128 + rg * 32;
    const size_t rowbase = (size_t)b * SEQ;
    const LAS unsigned char* lds = F.lds;
    const unsigned lds0 = (unsigned)(uintptr_t)lds;
    LAS float* wsf = (LAS float*)(lds + LDS_WS) + wid * 64;
    const LAS float* tb = (const LAS float*)(lds + LDS_BIAS);
    const int NT = 2 * qb + 3;
    const unsigned kvoff = (unsigned)((8 * wid + (lane >> 3)) * AW + (((lane & 7) ^ ((lane >> 3) & 7)) * 8)) * 2u;
    const unsigned vvoff = (unsigned)((16 * (wid & 3) + (lane >> 2)) * AW + (wid >> 2) * 32 + (lane & 3) * 8) * 2u;
    const unsigned pdst = lds0 + wid * 1024;
#define ATT_TROW(t) ((t) == 0 ? (size_t)M : rowbase + (size_t)64 * ((t) - 1))
#define ATT_DMA_K(t, slot) do { const bf16* kb_ = F.Kb + ATT_TROW(t) * AW + h * 128; const unsigned d_ = (unsigned)__builtin_amdgcn_readfirstlane(pdst + LDS_KR + (slot)); \
        glds16s(kb_, kvoff, d_); glds16s(kb_ + 64, kvoff, d_ + 8192); } while (0)
#define ATT_DMA_V(t, slot) do { const bf16* vb_ = F.Vb + ATT_TROW(t) * AW + h * 128; const unsigned d_ = (unsigned)__builtin_amdgcn_readfirstlane(pdst + LDS_VR + (slot)); \
        glds16s(vb_, vvoff, d_); glds16s(vb_ + 64, vvoff, d_ + 8192); } while (0)
    ATT_DMA_K(0, 0); ATT_DMA_V(0, 0); ATT_DMA_K(1, RSLOT);
    bf16x8 qr[4];
    { const bf16* Qw = F.Qb + (rowbase + q0w + r32) * AW + h * 128 + map * 64 + hi * 8;
#pragma unroll
      for (int d0 = 0; d0 < 4; ++d0) qr[d0] = *(const bf16x8*)(Qw + d0 * 16); }
    float mhat = 0.f, l_reg = 0.f; f32x16 o[4]; f32x16 negm = f32x16{};
#pragma unroll
    for (int i = 0; i < 4; ++i) o[i] = f32x16{};
    lds_cptr ka[4];
    { const int x_ = r32 & 7, lo_ = hi ^ (x_ & 1), y_ = x_ >> 1; const lds_cptr kb0_ = (lds_cptr)lds + LDS_KR + map * 8192 + r32 * 128 + lo_ * 16;
#pragma unroll
      for (int d0 = 0; d0 < 4; ++d0) ka[d0] = kb0_ + ((d0 ^ y_) << 5); }
    const lds_cptr vp0 = (lds_cptr)lds + LDS_VR + ((lane >> 4) & 1) * 32 + (lane & 3) * 8 + (4 * hi + ((lane & 15) >> 2)) * 64;
    const bool last_active = rg >= 2;
    bf16x8 kf[8];
#define ATT_KLOAD(so_, j) do { kf[2 * (j)] = *(const LAS bf16x8*)(ka[j] + (so_)); kf[2 * (j) + 1] = *(const LAS bf16x8*)(ka[j] + (so_) + 4096); } while (0)
    ATT_WAIT_BAR();
    f32x16 pA0, pA1, pB0, pB1;
    ATT_DMA_K(2, 2 * RSLOT); ATT_DMA_V(1, RSLOT);
    { ATT_KLOAD(0, 0); ATT_KLOAD(0, 1); ATT_KLOAD(0, 2); ATT_KLOAD(0, 3);
      pA0 = ATT_MFMA(kf[0], qr[0], f32x16{}); pA1 = ATT_MFMA(kf[1], qr[0], f32x16{});
#pragma unroll
      for (int d0 = 1; d0 < 4; ++d0) { pA0 = ATT_MFMA(kf[2 * d0], qr[d0], pA0); pA1 = ATT_MFMA(kf[2 * d0 + 1], qr[d0], pA1); }
      if ((NMETA + q0w) - 63 < 91) {
          const LAS float* tbl = tb + ((NMETA + q0w + r32) + 128 - 4 * hi - 12);
#pragma unroll
          for (int r = 0; r < 8; ++r) pA0[r] += tbl[12 - ((r & 3) + 8 * (r >> 2))];
      }
#pragma unroll
      for (int r = 0; r < 16; ++r) { if (r >= 8) pA0[r] = -1e30f; pA1[r] = -1e30f; }
      mhat = rowmax(pA0, pA1);
#pragma unroll
      for (int r = 0; r < 16; ++r) negm[r] = -mhat;
      asm volatile("" : "+v"(negm));
#pragma unroll
      for (int r = 0; r < 16; ++r) { pA0[r] = __builtin_amdgcn_exp2f(pA0[r] - mhat); pA1[r] = __builtin_amdgcn_exp2f(pA1[r] - mhat); }
      ATT_KLOAD(RSLOT, 0); ATT_KLOAD(RSLOT, 1); ATT_KLOAD(RSLOT, 2); ATT_KLOAD(RSLOT, 3); }
    asm volatile("s_waitcnt vmcnt(2) lgkmcnt(0)\n\ts_barrier" ::: "memory");
    s16x4 vlo[8], vhi[8]; u32x4 pw0, pw1, pw2, pw3; bool resc;
    int s_prev = 0, s_cur = RSLOT, s_next = 2 * RSLOT;
#define ATT_ROT() do { const int n_ = s_prev; s_prev = s_cur; s_cur = s_next; s_next = n_; } while (0)
#define ATT_VRD(i, f) do { vlo[i] = vtr(vp_ + (((f) >> 2) * 4096 + ((f) & 3) * 1024)); vhi[i] = vtr(vp_ + (((f) >> 2) * 4096 + ((f) & 3) * 1024 + 512)); } while (0)
#define ATT_VFR(i) (bf16x8){vlo[i][0], vlo[i][1], vlo[i][2], vlo[i][3], vhi[i][0], vhi[i][1], vhi[i][2], vhi[i][3]}
#define ATT_PAF(k) __builtin_bit_cast(bf16x8, pw##k)
#define ATT_GAPA(MF, A0, A1, A2, A3, W0, W1, PW) do { MF; sacc += A0; sacc += A1; sacc += A2; sacc += A3; ATT_PIN(sacc); W0; W1; ATT_PIN(PW); ATT_SBAR(); } while (0)
#define ATT_EX(v) __builtin_amdgcn_exp2f(v)
#define ATT_PV(i) o[(i) >> 2] = ATT_MFMA(__builtin_bit_cast(bf16x8, (((i) & 3) == 0) ? pw0 : (((i) & 3) == 1) ? pw1 : (((i) & 3) == 2) ? pw2 : pw3), ATT_VFR((i) & 7), o[(i) >> 2])
#define ATT_KRD(j) kf[j] = *(const LAS bf16x8*)(ka[(j) >> 1] + s_next + ((j) & 1) * 4096)
#define ATT_EXP1(C0, C1, e) do { if ((e) < 16) C0[(e) & 15] = ATT_EX(C0[(e) & 15]); else C1[(e) & 15] = ATT_EX(C1[(e) & 15]); } while (0)
#define ATT_STEP(C0, C1, P0, P1, t) do { \
        if ((t) + 2 < NT) ATT_DMA_K((t) + 2, s_prev); \
        if ((t) + 1 < NT) ATT_DMA_V((t) + 1, s_next); \
        const lds_cptr vp_ = vp0 + s_prev; \
        ATT_SBAR(); \
        float sacc = 0.f; \
        ATT_VRD(0, 0); ATT_VRD(1, 1); ATT_SBAR(); \
        ATT_GAPA(C0 = ATT_MFMA(kf[0], qr[0], negm), P0[0], P0[1], P0[2], P0[3],     pw0[0] = cvtpk(P0[0], P0[1]),   pw0[1] = cvtpk(P0[2], P0[3]),   pw0); \
        ATT_VRD(2, 2); ATT_SBAR(); \
        ATT_GAPA(C1 = ATT_MFMA(kf[1], qr[0], negm), P0[4], P0[5], P0[6], P0[7],     pw0[2] = cvtpk(P0[4], P0[5]),   pw0[3] = cvtpk(P0[6], P0[7]),   pw0); \
        ATT_VRD(3, 3); ATT_SBAR(); \
        ATT_GAPA(C0 = ATT_MFMA(kf[2], qr[1], C0),       P0[8], P0[9], P0[10], P0[11],   pw1[0] = cvtpk(P0[8], P0[9]),   pw1[1] = cvtpk(P0[10], P0[11]), pw1); \
        ATT_VRD(4, 4); ATT_SBAR(); \
        ATT_GAPA(C1 = ATT_MFMA(kf[3], qr[1], C1),       P0[12], P0[13], P0[14], P0[15], pw1[2] = cvtpk(P0[12], P0[13]), pw1[3] = cvtpk(P0[14], P0[15]), pw1); \
        ATT_VRD(5, 5); ATT_SBAR(); \
        ATT_GAPA(C0 = ATT_MFMA(kf[4], qr[2], C0),       P1[0], P1[1], P1[2], P1[3],     pw2[0] = cvtpk(P1[0], P1[1]),   pw2[1] = cvtpk(P1[2], P1[3]),   pw2); \
        ATT_VRD(6, 6); ATT_SBAR(); \
        ATT_GAPA(C1 = ATT_MFMA(kf[5], qr[2], C1),       P1[4], P1[5], P1[6], P1[7],     pw2[2] = cvtpk(P1[4], P1[5]),   pw2[3] = cvtpk(P1[6], P1[7]),   pw2); \
        ATT_VRD(7, 7); ATT_SBAR(); \
        ATT_GAPA(C0 = ATT_MFMA(kf[6], qr[3], C0),       P1[8], P1[9], P1[10], P1[11],   pw3[0] = cvtpk(P1[8], P1[9]),   pw3[1] = cvtpk(P1[10], P1[11]), pw3); \
        ATT_GAPA(C1 = ATT_MFMA(kf[7], qr[3], C1),       P1[12], P1[13], P1[14], P1[15], pw3[2] = cvtpk(P1[12], P1[13]), pw3[3] = cvtpk(P1[14], P1[15]), pw3); \
        l_reg += sacc; \
        { const int kpos0_ = NMETA + 64 * ((t) - 1); \
          if ((NMETA + q0w) - (kpos0_ + 63) < 91) {                                     \
              const LAS float* tbl_ = tb + ((NMETA + q0w + r32) - kpos0_ + 128 - 4 * hi - 60);     \
              _Pragma("unroll") for (int r = 0; r < 16; ++r) { const int c_ = (r & 3) + 8 * (r >> 2); C0[r] += tbl_[60 - c_]; C1[r] += tbl_[28 - c_]; } } \
          if ((t) == NT - 1 && !last_active) { _Pragma("unroll") for (int r = 0; r < 16; ++r) { C0[r] = -1e30f; C1[r] = -1e30f; } } } \
          \
        float ma_, mb_; resc = false; \
        ATT_SBAR(); \
        ATT_PV(0); ma_ = ATT_MX3(C0[0], C0[1], C1[0]); mb_ = ATT_MX3(C0[2], C0[3], C1[1]); ma_ = ATT_MX3(ma_, C1[2], C1[3]); ma_ = ATT_MX3(ma_, C0[4], C0[5]); ATT_PIN(ma_); ATT_PIN(mb_); ATT_VRD(0, 8); ATT_SBAR(); \
        ATT_PV(1); mb_ = ATT_MX3(mb_, C0[6], C0[7]); ma_ = ATT_MX3(ma_, C1[4], C1[5]); mb_ = ATT_MX3(mb_, C1[6], C1[7]); ma_ = ATT_MX3(ma_, C0[8], C0[9]); ATT_PIN(ma_); ATT_PIN(mb_); ATT_VRD(1, 9); ATT_SBAR(); \
        ATT_PV(2); mb_ = ATT_MX3(mb_, C0[10], C0[11]); ma_ = ATT_MX3(ma_, C1[8], C1[9]); mb_ = ATT_MX3(mb_, C1[10], C1[11]); ma_ = ATT_MX3(ma_, C0[12], C0[13]); ATT_PIN(ma_); ATT_PIN(mb_); ATT_VRD(2, 10); ATT_SBAR(); \
        ATT_PV(3); mb_ = ATT_MX3(mb_, C0[14], C0[15]); ma_ = ATT_MX3(ma_, C1[12], C1[13]); mb_ = ATT_MX3(mb_, C1[14], C1[15]); ATT_VRD(3, 11); \
        float rm_ = __builtin_fmaxf(ma_, mb_); { auto rr_ = __builtin_amdgcn_permlane32_swap(__float_as_uint(rm_), __float_as_uint(rm_), false, false); rm_ = __builtin_fmaxf(__uint_as_float(rr_[0]), __uint_as_float(rr_[1])); } \
        const bool grow_ = __any(rm_ > (float)THR); \
        ATT_SBAR(); \
          \
        ATT_PV(4); ATT_VRD(4, 12); ATT_KRD(0); ATT_SBAR(); \
        ATT_PV(5); ATT_VRD(5, 13); ATT_KRD(1); ATT_SBAR(); \
        if (grow_) {                                                                    \
            const float dl_ = __builtin_fmaxf(rm_, 0.f); mhat += dl_; const float f_ = __builtin_amdgcn_exp2f(-dl_); l_reg *= f_; if (hi == 0) wsf[r32] = f_; resc = true; \
            _Pragma("unroll") for (int r = 0; r < 16; ++r) { C0[r] -= dl_; C1[r] -= dl_; negm[r] = -mhat; } asm volatile("" : "+v"(negm)); } \
        ATT_SBAR(); \
          \
        ATT_PV(6);  ATT_EXP1(C0, C1, 0);  ATT_EXP1(C0, C1, 1);  ATT_EXP1(C0, C1, 2);  ATT_PIN(C0); ATT_VRD(6, 14); ATT_KRD(2); ATT_SBAR(); \
        ATT_PV(7);  ATT_EXP1(C0, C1, 3);  ATT_EXP1(C0, C1, 4);  ATT_EXP1(C0, C1, 5);  ATT_PIN(C0); ATT_VRD(7, 15); ATT_KRD(3); ATT_SBAR(); \
        ATT_PV(8);  ATT_EXP1(C0, C1, 6);  ATT_EXP1(C0, C1, 7);  ATT_EXP1(C0, C1, 8);  ATT_PIN(C0); ATT_KRD(4); ATT_SBAR(); \
        ATT_PV(9);  ATT_EXP1(C0, C1, 9);  ATT_EXP1(C0, C1, 10); ATT_EXP1(C0, C1, 11); ATT_PIN(C0); ATT_KRD(5); ATT_SBAR(); \
        ATT_PV(10); ATT_EXP1(C0, C1, 12); ATT_EXP1(C0, C1, 13); ATT_EXP1(C0, C1, 14); ATT_PIN(C0); ATT_KRD(6); ATT_SBAR(); \
        ATT_PV(11); ATT_EXP1(C0, C1, 15); ATT_EXP1(C0, C1, 16); ATT_EXP1(C0, C1, 17); ATT_PIN(C0); ATT_PIN(C1); ATT_KRD(7); ATT_SBAR(); \
        ATT_PV(12); ATT_EXP1(C0, C1, 18); ATT_EXP1(C0, C1, 19); ATT_EXP1(C0, C1, 20); ATT_EXP1(C0, C1, 21); ATT_PIN(C1); ATT_SBAR(); \
        ATT_PV(13); ATT_EXP1(C0, C1, 22); ATT_EXP1(C0, C1, 23); ATT_EXP1(C0, C1, 24); ATT_EXP1(C0, C1, 25); ATT_PIN(C1); ATT_SBAR(); \
        ATT_PV(14); ATT_EXP1(C0, C1, 26); ATT_EXP1(C0, C1, 27); ATT_EXP1(C0, C1, 28); ATT_PIN(C1); ATT_SBAR(); \
        ATT_PV(15); ATT_EXP1(C0, C1, 29); ATT_EXP1(C0, C1, 30); ATT_EXP1(C0, C1, 31); ATT_PIN(C1); ATT_SBAR(); \
        if (resc) { LDS_WAIT(); \
            _Pragma("unroll") for (int r = 0; r < 16; ++r) { const float fr_ = wsf[crow(r, hi)]; _Pragma("unroll") for (int i = 0; i < 4; ++i) o[i][r] *= fr_; } } \
        if ((t) + 1 < NT) asm volatile("s_waitcnt vmcnt(2) lgkmcnt(0)\n\ts_barrier" ::: "memory"); else asm volatile("s_waitcnt vmcnt(0) lgkmcnt(0)\n\ts_barrier" ::: "memory"); \
        ATT_ROT(); \
    } while (0)
#pragma unroll 1
    for (int t = 1; t < NT; t += 2) {
        ATT_STEP(pB0, pB1, pA0, pA1, t);
        ATT_STEP(pA0, pA1, pB0, pB1, t + 1);
    }
    { float sacc = 0.f;
#pragma unroll
      for (int r = 0; r < 16; ++r) sacc += pA0[r] + pA1[r];
      l_reg += sacc;
      u32x4 pw[4];
      pw[0] = (u32x4){cvtpk(pA0[0], pA0[1]), cvtpk(pA0[2], pA0[3]), cvtpk(pA0[4], pA0[5]), cvtpk(pA0[6], pA0[7])};
      pw[1] = (u32x4){cvtpk(pA0[8], pA0[9]), cvtpk(pA0[10], pA0[11]), cvtpk(pA0[12], pA0[13]), cvtpk(pA0[14], pA0[15])};
      pw[2] = (u32x4){cvtpk(pA1[0], pA1[1]), cvtpk(pA1[2], pA1[3]), cvtpk(pA1[4], pA1[5]), cvtpk(pA1[6], pA1[7])};
      pw[3] = (u32x4){cvtpk(pA1[8], pA1[9]), cvtpk(pA1[10], pA1[11]), cvtpk(pA1[12], pA1[13]), cvtpk(pA1[14], pA1[15])};
      pv_tile(o, pw, vp0 + s_prev); }
    ATT_WAIT_BAR();
#undef ATT_STEP
#undef ATT_GAPA
#undef ATT_PV
#undef ATT_KRD
#undef ATT_EXP1
#undef ATT_VRD
#undef ATT_KLOAD
    { auto rr = __builtin_amdgcn_permlane32_swap(__float_as_uint(l_reg), __float_as_uint(l_reg), false, false); l_reg = __uint_as_float(rr[0]) + __uint_as_float(rr[1]); }
    if (hi == 0) wsf[32 + r32] = l_reg;
    LDS_WAIT();
    float rli[16];
#pragma unroll
    for (int r = 0; r < 16; ++r) rli[r] = 1.f / wsf[32 + crow(r, hi)];
    LAS float* stg = (LAS float*)lds;
    if (map == 1) {
#pragma unroll
        for (int r = 0; r < 16; ++r) { LAS float* sp = stg + (32 * rg + crow(r, hi)) * STG_PITCH + r32;
#pragma unroll
            for (int i = 0; i < 4; ++i) sp[32 * i] = o[i][r] * rli[r]; }
    }
    ATT_WAIT_BAR();
    if (map == 0) {
#pragma unroll
        for (int r = 0; r < 16; ++r) { LAS float* sp = stg + (32 * rg + crow(r, hi)) * STG_PITCH + r32;
#pragma unroll
            for (int i = 0; i < 4; ++i) sp[32 * i] = o[i][r] * rli[r] - lam * sp[32 * i]; }
    }
    ATT_WAIT_BAR();
    { int lane2 = F.lane; asm volatile("" : "+v"(lane2)); const int row = wid * 16 + (lane2 >> 2), c0 = (lane2 & 3) * 32;
      const LAS float* sp = stg + row * STG_PITCH + c0; f32x4 v[8]; float ss = 0.f;
#pragma unroll
      for (int i = 0; i < 8; ++i) { v[i] = *(const LAS f32x4*)(sp + 4 * i); ss += (v[i].x * v[i].x + v[i].y * v[i].y) + (v[i].z * v[i].z + v[i].w * v[i].w); }
      ss += __shfl_xor(ss, 1); ss += __shfl_xor(ss, 2);
      const float rs = 0.8f / sqrtf(ss * (1.f / 128.f) + EPS);
      bf16* ao = F.ACAT + (rowbase + (size_t)qb * 128 + row) * KC + PW + h * 128 + c0; const f32x4* sw = (const f32x4*)(F.sublnw + c0);
#pragma unroll
      for (int i = 0; i < 4; ++i) { const f32x4 a = v[2 * i] * rs * sw[2 * i], c = v[2 * i + 1] * rs * sw[2 * i + 1];
          u32x4 w; w.x = pk2(a.x, a.y); w.y = pk2(a.z, a.w); w.z = pk2(c.x, c.y); w.w = pk2(c.z, c.w); *(u32x4*)(ao + 8 * i) = w; } }
    ATT_WAIT_BAR();
#undef ATT_TROW
#undef ATT_DMA_K
#undef ATT_DMA_V
#undef ATT_ROT
#undef ATT_VFR
#undef ATT_PAF
#undef ATT_EX
}
__device__ __forceinline__ void attn_phase(const Frame& F) {
    const float lam = compute_lambda(F);
    for (int v = F.vcu; v < 256; v += F.G) {
        const int xg = v >> 5, j = v & 31;
#pragma unroll 1
        for (int r = 0; r < 4; ++r) {
            const int bh = 4 * xg + r, b = bh / NH, h = bh % NH, j2 = (j + 16) & 31;
            const int qb = (r == 0) ? j : (r == 1) ? 31 - j : (r == 2) ? j2 : 31 - j2;
            __syncthreads();
            int tid_ = F.wave * 64 + (int)__builtin_amdgcn_mbcnt_hi(~0u, __builtin_amdgcn_mbcnt_lo(~0u, 0u)); asm volatile("" : "+v"(tid_));
            if (tid_ < NBIAS) { const int d = min(max(tid_ - 128, -127), 91);
                ((LAS float*)(F.lds + LDS_BIAS))[tid_] = (F.btab[t5_bucket(-d) * NH + h] - F.btab[15 * NH + h]) * LOG2E; }
            __syncthreads();
            attn_unit(F, b, h, qb, lam);
        }
    }
}
}

__device__ __forceinline__ void final_norm_phase(Frame& F) {
    const int gw = F.vcu * NWAVES + F.wave, NGW = F.G * NWAVES;
    for (int m = gw; m < M; m += NGW) {
        f32x4* xr = (f32x4*)(F.out + (size_t)m * D) + F.lane; const f32x4* wr = (const f32x4*)F.finw + F.lane;
        f32x4 v[4]; float s = 0.f;
#pragma unroll
        for (int j = 0; j < 4; ++j) { v[j] = xr[64 * j]; s += (v[j].x * v[j].x + v[j].y * v[j].y) + (v[j].z * v[j].z + v[j].w * v[j].w); }
        const float rstd = 1.f / sqrtf(wave_sum(s) * (1.f / D) + EPS);
#pragma unroll
        for (int j = 0; j < 4; ++j) xr[64 * j] = v[j] * rstd * wr[64 * j];
    }
}

typedef GAS unsigned gu32;
typedef GAS unsigned long long gu64;
#define RLX_AGENT __ATOMIC_RELAXED, __HIP_MEMORY_SCOPE_AGENT
#define XB_TMO      128
#define XB_XCNT(j)  (256  + 64 * (j))
#define XB_XSUB(j)  (1280 + 64 * (j))
#define XB_XGEN(j)  (2304 + 64 * (j))
#define XB_TOP      3328
#define XB_TOPGEN   3392
#define XCD_BAR_WORDS 3456
#define XB_SPIN_CAP (1u << 18)

__device__ __forceinline__ unsigned xb_ld(unsigned* p)              { return __hip_atomic_load(p, __ATOMIC_RELAXED, __HIP_MEMORY_SCOPE_AGENT); }
__device__ __forceinline__ unsigned xb_add(unsigned* p, unsigned v) { return __hip_atomic_fetch_add(p, v, __ATOMIC_RELAXED, __HIP_MEMORY_SCOPE_AGENT); }
__device__ __forceinline__ unsigned xb_xcc_id() { return (unsigned)__builtin_amdgcn_s_getreg((3 << 11) | 20) & 0xFu; }
#define XB_SPIN(cond, bar) do { unsigned _sp = 0; while (cond) { __builtin_amdgcn_s_sleep(1); \
    if ((++_sp & 255u) == 0u) { if (xb_ld(&(bar)[XB_TMO])) break; if (_sp > XB_SPIN_CAP) { atomicAdd(&(bar)[XB_TMO], 1u); break; } } } } while (0)

struct XcdBarrier {
    unsigned* bar; unsigned x;
    volatile LAS unsigned* st;
};

__device__ __forceinline__ XcdBarrier xcd_barrier_post(unsigned* bar, volatile LAS unsigned* st) {
    XcdBarrier b; b.bar = bar; b.x = xb_xcc_id(); b.st = st;
    if (threadIdx.x == 0) (void)xb_add(&bar[XB_XCNT(b.x)], 1u);
    return b;
}
__device__ __forceinline__ void xcd_barrier_complete(unsigned* bar, unsigned x, unsigned& nloc, unsigned& nx) {
    const unsigned G = gridDim.x * gridDim.y * gridDim.z;
    unsigned sum, cnt, mine, sp = 0u;
    for (;;) {
        sum = 0u; cnt = 0u; mine = 0u;
#pragma unroll
        for (unsigned j = 0; j < 16; ++j) { const unsigned c = xb_ld(&bar[XB_XCNT(j)]); sum += c; cnt += (c > 0u) ? 1u : 0u; mine = (j == x) ? c : mine; }
        if (sum == G) break;
        __builtin_amdgcn_s_sleep(1);
        if ((++sp & 255u) == 0u) { if (xb_ld(&bar[XB_TMO])) break; if (sp > XB_SPIN_CAP) { atomicAdd(&bar[XB_TMO], 1u); break; } }
    }
    nloc = mine > 0u ? mine : 1u; nx = cnt > 0u ? cnt : 1u;
}

__device__ __forceinline__ void xcd_barrier(const XcdBarrier& b) {
    asm volatile("s_waitcnt vmcnt(0)" ::: "memory");
    __syncthreads();
    if (threadIdx.x == 0) {
        unsigned* bar = b.bar;
        __builtin_amdgcn_s_waitcnt(0);
        unsigned nloc = b.st[0], nx = b.st[1];
        if (nloc == 0u) { xcd_barrier_complete(bar, b.x, nloc, nx); b.st[0] = nloc; b.st[1] = nx; }
        const unsigned old = xb_add(&bar[XB_XSUB(b.x)], 1u);
        const unsigned gen = old / nloc;
        if (old + 1u == (gen + 1u) * nloc) {
            __builtin_amdgcn_fence(__ATOMIC_RELEASE, "agent");
            asm volatile("s_waitcnt vmcnt(0)" ::: "memory");
            const unsigned og = xb_add(&bar[XB_TOP], 1u);
            const unsigned tg = og / nx;
            if (og + 1u == (tg + 1u) * nx) xb_add(&bar[XB_TOPGEN], 1u);
            else XB_SPIN(xb_ld(&bar[XB_TOPGEN]) == tg, bar);
            __builtin_amdgcn_fence(__ATOMIC_ACQUIRE, "agent");
            xb_add(&bar[XB_XGEN(b.x)], 1u);
            asm volatile("s_waitcnt vmcnt(0)" ::: "memory");
        } else {
            XB_SPIN(xb_ld(&bar[XB_XGEN(b.x)]) == gen, bar);
            __builtin_amdgcn_fence(__ATOMIC_ACQUIRE, "agent");
            asm volatile("s_waitcnt vmcnt(0)" ::: "memory");
        }
    }
    __syncthreads();
}

struct Args { const float* in[20]; float* out; unsigned char* ws; int ph_lo, ph_hi; };
constexpr int NPHASE = 8;

__global__ void __launch_bounds__(NTHR, 2) mk_fwd(Args args) {
    extern __shared__ __attribute__((aligned(16))) unsigned char lds[];
    Frame F;
    F.lds = (LAS unsigned char*)lds;
    F.wave = __builtin_amdgcn_readfirstlane((int)threadIdx.x >> 6); F.lane = (int)__builtin_amdgcn_mbcnt_hi(~0u, __builtin_amdgcn_mbcnt_lo(~0u, 0u)); F.tid = F.wave * 64 + F.lane;
    F.G = gridDim.x; { const int bx = blockIdx.x; F.vcu = (F.G % 8 == 0) ? (bx % 8) * (F.G / 8) + bx / 8 : bx; }
    F.x = args.in[0]; F.meta = args.in[1]; F.btab = args.in[2]; F.mixw = args.in[3]; F.win = args.in[4]; F.pgw = args.in[5]; F.pscale = args.in[6];
    F.lq1 = args.in[7]; F.lk1 = args.in[8]; F.lq2 = args.in[9]; F.lk2 = args.in[10]; F.sublnw = args.in[11]; F.wpo = args.in[12]; F.wao = args.in[13];
    F.wo = args.in[14]; F.ffnw = args.in[15]; F.wg = args.in[16]; F.wu = args.in[17]; F.wd = args.in[18]; F.finw = args.in[19];
    F.out = args.out; F.ws = args.ws; unsigned char* ws = args.ws;
    F.Win_t = (bf16*)(ws + WS_WIN); F.Wcat_t = (bf16*)(ws + WS_WCAT); F.Wo_t = (bf16*)(ws + WS_WO); F.Wgu_t = (bf16*)(ws + WS_WGU); F.Wd_t = (bf16*)(ws + WS_WD);
    F.XN = (bf16*)(ws + WS_XN); F.UP = (bf16*)(ws + WS_UP); F.Kb = (bf16*)(ws + WS_K); F.Vb = (bf16*)(ws + WS_V); F.Qb = (bf16*)(ws + WS_Q); F.GP = (bf16*)(ws + WS_GP); F.GA = (bf16*)(ws + WS_GA);
    F.MERGED = (bf16*)(ws + WS_MERGED); F.HB = (bf16*)(ws + WS_HB); F.ACT = (bf16*)(ws + WS_ACT); F.PART = (float*)(ws + WS_PART); F.ACAT = (bf16*)args.out;
    const int lo = args.ph_lo, hi = args.ph_hi;
    for (int u = F.tid; u < (LDS_BYTES - RING_BYTES) / 4; u += NTHR) ((LAS unsigned*)(F.lds + RING_BYTES))[u] = 0u;
    __syncthreads();
    XcdBarrier bar; bar.bar = (unsigned*)(ws + WS_CTL) + CW_BAR; bar.x = 0; bar.st = nullptr;
    if (hi - lo > 1) bar = xcd_barrier_post((unsigned*)(ws + WS_CTL) + CW_BAR, (volatile LAS unsigned*)(F.lds + MISC_OFF) + 8);
#define IN(k) (lo <= (k) && (k) < hi)
#define SEAM(k) do { if (IN(k) && IN((k) + 1)) xcd_barrier(bar); } while (0)
    if (IN(0)) { p0_prologue(F); }
    SEAM(0);
    if (IN(1)) {
        pg8::Gemm g{F.XN, F.Win_t, MP, INC, D}; OrderP1 S; S.init(F.G, (int)blockIdx.x);
        Epi8P1 E{{F.UP, F.Qb, F.Kb, F.Vb, F.GP, F.GA}};
        pg8::gemm_phase<Epi8P1, OrderP1, true, true>(F.lds, g, S, E, F.wave, F.lane);
        deferred_weights(F, 0, (M / 256) * (INC / 256) + 10);
    }
    SEAM(1);
    if (IN(2)) { pool_phase(F); __syncthreads(); attn::attn_phase(F); }
    SEAM(2);
    if (IN(3)) {
        pg8::Gemm g{F.ACAT, F.Wcat_t, M, D, KC}; pg8::StaticOrder S; S.init(M, D, F.G, (int)blockIdx.x);
        EpiP3 E{F.GP, F.GA, F.MERGED}; pg8::gemm_phase<EpiP3, pg8::StaticOrder, true, true>(F.lds, g, S, E, F.wave, F.lane);
    }
    SEAM(3);
    if (IN(4)) {
        pg8::Gemm g{F.MERGED, F.Wo_t, M, D, D}; pg8::StaticOrder S; S.init(M, D, F.G, (int)blockIdx.x);
        Epi8P4 E{{F.x, F.HB}, F.PART}; pg8::gemm_phase<Epi8P4, pg8::StaticOrder, true, true>(F.lds, g, S, E, F.wave, F.lane);
    }
    SEAM(4);
    if (IN(5)) {
        pg8::Gemm g{F.HB, F.Wgu_t, M, 2 * FF, D}; pg8::StaticOrder S; S.init(M, 2 * FF, F.G, (int)blockIdx.x);
        Epi8P5 E{{F.ACT}, F.PART}; pg8::gemm_phase<Epi8P5, pg8::StaticOrder, true, true>(F.lds, g, S, E, F.wave, F.lane);
        deferred_weights(F, 1, (M / 256) * (2 * FF / 256));
    }
    SEAM(5);
    if (IN(6)) {
        pg8::Gemm g{F.ACT, F.Wd_t, M, D, FF}; pg8::StaticOrder S; S.init(M, D, F.G, (int)blockIdx.x);
        if (F.G == 256) { EpiFinal E{F.HB, F.out, F.finw, (unsigned*)(ws + WS_XSLOT), (unsigned*)(ws + WS_CTL) + CW_CNT}; pg8::gemm_phase<EpiFinal, pg8::StaticOrder, false, true>(F.lds, g, S, E, F.wave, F.lane); }
        else { Epi8<EpiP6> E{{F.HB, F.out}}; pg8::gemm_phase<Epi8<EpiP6>, pg8::StaticOrder, true, true>(F.lds, g, S, E, F.wave, F.lane); }
    }
    if (F.G != 256) { SEAM(6); if (IN(7)) final_norm_phase(F); }
#undef IN
#undef SEAM
}

extern "C" void kernel_launch(void* const* d_in, const int* in_sizes, int n_in, void* d_out, int out_size, void* d_ws, size_t ws_size, hipStream_t stream) {
    static int grid = 0;
    if (grid == 0) {
        if (n_in != 20 || out_size != M * D || ws_size < WS_END) { fprintf(stderr, "kernel_launch: unexpected shapes (n_in %d out %d ws %zu)\n", n_in, out_size, ws_size); grid = -1; return; }
        int dev = 0, cus = 0, per_cu = 0;
        if (hipGetDevice(&dev) != hipSuccess || hipDeviceGetAttribute(&cus, hipDeviceAttributeMultiprocessorCount, dev) != hipSuccess) { grid = -1; return; }
        if (hipFuncSetAttribute((const void*)mk_fwd, hipFuncAttributeMaxDynamicSharedMemorySize, LDS_BYTES) != hipSuccess) { fprintf(stderr, "kernel_launch: hipFuncSetAttribute failed\n"); grid = -1; return; }
        if (hipOccupancyMaxActiveBlocksPerMultiprocessor(&per_cu, (const void*)mk_fwd, NTHR, LDS_BYTES) != hipSuccess || per_cu < 1) { fprintf(stderr, "kernel_launch: occupancy query says %d\n", per_cu); }
        (void)hipGetLastError();
        grid = cus;
    }
    if (grid < 0) return;
    (void)hipMemsetAsync((char*)d_ws + WS_CTL, 0, CTL_ZERO_BYTES, stream);
    Args a{};
    for (int i = 0; i < 20; ++i) a.in[i] = (const float*)d_in[i];
    a.out = (float*)d_out; a.ws = (unsigned char*)d_ws;
#ifdef PROBE_DUP
    if (true) { a.ph_lo = 0; a.ph_hi = PROBE_DUP + 1; hipLaunchKernelGGL(mk_fwd, dim3(grid), dim3(NTHR), LDS_BYTES, stream, a);
        (void)hipMemsetAsync((char*)d_ws + WS_CTL, 0, 65536, stream);
        a.ph_lo = PROBE_DUP; a.ph_hi = NPHASE; hipLaunchKernelGGL(mk_fwd, dim3(grid), dim3(NTHR), LDS_BYTES, stream, a); }
#else
    if (MK_N_LAUNCHES == 1) { a.ph_lo = 0; a.ph_hi = NPHASE; hipLaunchKernelGGL(mk_fwd, dim3(grid), dim3(NTHR), LDS_BYTES, stream, a); }
#endif
    else for (int p = 0; p < NPHASE; ++p) { a.ph_lo = p; a.ph_hi = p + 1; hipLaunchKernelGGL(mk_fwd, dim3(grid), dim3(NTHR), LDS_BYTES, stream, a); }
}
```

```cpp
#include <hip/hip_runtime.h>
#include <cstdio>
#include <cstdint>

#ifndef MK_N_LAUNCHES
#define MK_N_LAUNCHES 1
#endif

constexpr int BATCH = 4, SEQ = 4096, D = 1024, NMETA = 16, NH = 8, HD = 64, VD = 128;
constexpr int M = BATCH * SEQ;
constexpr int MP = M + 256;
constexpr int PW = 512, AW = 1024, FF = 2816, INC = 5632;
constexpr int KC = PW + AW;
constexpr float EPS = 1e-6f;
constexpr float LOG2E = 1.4426950408889634f;
constexpr float QSCALE = 0.125f * LOG2E;

typedef unsigned short bf16;
typedef float f32x4 __attribute__((ext_vector_type(4)));
typedef unsigned u32x4 __attribute__((ext_vector_type(4)));
typedef unsigned u32x2 __attribute__((ext_vector_type(2)));

constexpr size_t MiB = 1u << 20;
constexpr size_t WS_CTL = 0, CTL_ZERO_BYTES = 1 * MiB;
constexpr size_t WS_XSLOT = 512 * 1024;
constexpr int CW_CNT = 16384;
constexpr int CW_QUEUE = 2048;
constexpr int CW_BAR = 4096;
constexpr size_t WS_PART = 1 * MiB;
constexpr size_t WS_WIN = 2 * MiB;
constexpr size_t WS_WCAT = 13 * MiB;
constexpr size_t WS_WO = 16 * MiB;
constexpr size_t WS_WGU = 18 * MiB;
constexpr size_t WS_WD = 29 * MiB;
constexpr size_t WS_XN = 36 * MiB;
constexpr size_t WS_UP = WS_XN + (size_t)MP * D * 2;
constexpr size_t WS_K = WS_UP + (size_t)MP * PW * 2;
constexpr size_t WS_V = WS_K + (size_t)MP * AW * 2;
constexpr size_t WS_Q = WS_V + (size_t)MP * AW * 2;
constexpr size_t WS_GP = WS_Q + (size_t)M * AW * 2;
constexpr size_t WS_GA = WS_GP + (size_t)M * D * 2;
constexpr size_t WS_END = WS_GA + (size_t)M * D * 2;
constexpr size_t WS_MERGED = WS_Q, WS_HB = WS_GP;
constexpr size_t WS_ACT = WS_XN;
static_assert(WS_END <= 256 * MiB, "ws map");
static_assert(WS_ACT + (size_t)M * FF * 2 <= WS_Q, "ACT overlay must not reach MERGED / HB");

constexpr int RING_BYTES = 131072, MISC_OFF = RING_BYTES + 320, LDS_BYTES = 147456;
constexpr int NWAVES = 8, NTHR = 512;

#define GAS __attribute__((address_space(1)))
#define LAS __attribute__((address_space(3)))
#define LDS_WAIT() asm volatile("s_waitcnt lgkmcnt(0)" ::: "memory")
#define VM_WAIT() asm volatile("s_waitcnt vmcnt(0)" ::: "memory")

__device__ __forceinline__ unsigned f2bf(float f) { unsigned u = __builtin_bit_cast(unsigned, f); return (u + 0x7fffu + ((u >> 16) & 1u)) >> 16; }
typedef float f32x2_c __attribute__((ext_vector_type(2))); typedef __bf16 bf16x2_c __attribute__((ext_vector_type(2)));
__device__ __forceinline__ unsigned pk2(float lo, float hi) { f32x2_c v = {lo, hi}; bf16x2_c b = __builtin_convertvector(v, bf16x2_c); return __builtin_bit_cast(unsigned, b); }
__device__ __forceinline__ float bf2f(unsigned b) { return __builtin_bit_cast(float, b << 16); }
__device__ __forceinline__ float bflo(unsigned w) { return __builtin_bit_cast(float, w << 16); }
__device__ __forceinline__ float bfhi(unsigned w) { return __builtin_bit_cast(float, w & 0xffff0000u); }
__device__ __forceinline__ float wave_sum(float v) {
#pragma unroll
    for (int o = 1; o < 64; o <<= 1) v += __shfl_xor(v, o);
    return v;
}
__device__ __forceinline__ float sigmoidf_(float x) { return __builtin_amdgcn_rcpf(1.f + __builtin_amdgcn_exp2f(-LOG2E * x)); }

struct Frame {
    LAS unsigned char* lds;
    int tid, lane, wave, G, vcu;
    const float *x, *meta, *btab, *mixw, *win, *pgw, *pscale, *lq1, *lk1, *lq2, *lk2, *sublnw, *wpo, *wao, *wo, *ffnw, *wg, *wu, *wd, *finw;
    float* out;
    unsigned char* ws;
    bf16 *Win_t, *Wcat_t, *Wo_t, *Wgu_t, *Wd_t;
    bf16 *XN, *UP, *Kb, *Vb, *Qb, *GP, *GA, *MERGED, *HB, *ACT, *ACAT;
    float *PART;
};

struct TrDesc { const float* W; const float* kscale; bf16* WT; int K, N, mode, ldw, item; };
__device__ __forceinline__ void tr_load(const TrDesc& d, int lane, float (&v)[32]) {
    const int nblk = d.N / 32, kb = d.item / nblk, nb = d.item % nblk, k0 = 64 * kb, n0 = 32 * nb;
#pragma unroll
    for (int i = 0; i < 32; ++i) v[i] = __builtin_nontemporal_load(d.W + (size_t)(k0 + 2 * i + (lane >> 5)) * d.N + n0 + (lane & 31));
}
__device__ __forceinline__ void tr_to_lds(const TrDesc& d, int lane, float (&v)[32], LAS float* scr) {
    const int nblk = d.N / 32, kb = d.item / nblk, k0 = 64 * kb;
    if (d.kscale) {
#pragma unroll
        for (int i = 0; i < 32; ++i) v[i] *= d.kscale[k0 + 2 * i + (lane >> 5)]; }
#pragma unroll
    for (int i = 0; i < 32; ++i) scr[(2 * i + (lane >> 5)) * 33 + (lane & 31)] = v[i];
    LDS_WAIT(); asm volatile("" ::: "memory");
}
__device__ __forceinline__ void tr_store(const TrDesc& d, int lane, LAS float* scr) {
    const int nblk = d.N / 32, kb = d.item / nblk, nb = d.item % nblk, k0 = 64 * kb, n0 = 32 * nb;
    const int c = lane & 7;
    const int rbase = (d.mode == 0) ? n0 : ((n0 / 128) * 256 + (n0 % 128) + (d.mode == 2 ? 128 : 0));
#pragma unroll
    for (int j = 0; j < 4; ++j) { const int n = (lane >> 3) + 8 * j; const LAS float* s = scr + (8 * c) * 33 + n;
        u32x4 o; o.x = pk2(s[0 * 33], s[1 * 33]); o.y = pk2(s[2 * 33], s[3 * 33]); o.z = pk2(s[4 * 33], s[5 * 33]); o.w = pk2(s[6 * 33], s[7 * 33]);
        *(u32x4*)(d.WT + (size_t)(rbase + n) * d.ldw + k0 + 8 * c) = o; }
    LDS_WAIT(); asm volatile("" ::: "memory");
}
template <int NR> __device__ __forceinline__ void rms_rows_to_bf16(const float* const (&xrow)[NR], const float* w, bf16* const (&orow)[NR], int lane) {
    f32x4 v[NR][4]; float s[NR];
#pragma unroll
    for (int r = 0; r < NR; ++r) { const f32x4* xr = (const f32x4*)xrow[r] + lane;
#pragma unroll
        for (int j = 0; j < 4; ++j) v[r][j] = __builtin_nontemporal_load(xr + 64 * j); }
    const f32x4* wr = (const f32x4*)w + lane; f32x4 ww[4];
#pragma unroll
    for (int j = 0; j < 4; ++j) ww[j] = wr[64 * j];
#pragma unroll
    for (int r = 0; r < NR; ++r) { s[r] = 0.f;
#pragma unroll
        for (int j = 0; j < 4; ++j) s[r] += (v[r][j].x * v[r][j].x + v[r][j].y * v[r][j].y) + (v[r][j].z * v[r][j].z + v[r][j].w * v[r][j].w); }
#pragma unroll
    for (int r = 0; r < NR; ++r) { const float rstd = 1.f / sqrtf(wave_sum(s[r]) * (1.f / D) + EPS);
        unsigned long long* o8 = (unsigned long long*)orow[r] + lane;
#pragma unroll
        for (int j = 0; j < 4; ++j)
            o8[64 * j] = (unsigned long long)pk2(v[r][j].x * rstd * ww[j].x, v[r][j].y * rstd * ww[j].y) | ((unsigned long long)pk2(v[r][j].z * rstd * ww[j].z, v[r][j].w * rstd * ww[j].w) << 32); }
}
constexpr int I_IN = (D / 64) * (INC / 32), I_AO = (AW / 64) * (D / 32), I_O = (D / 64) * (D / 32), I_G = (D / 64) * (FF / 32), I_D = (FF / 64) * (D / 32);
constexpr int I_EFF = (PW / 4) * (D / 4) / 64;
__device__ __forceinline__ void weff_item(Frame& F, int o) {
    const int kb = o / (D / 4), n0 = (o % (D / 4)) * 4, k0 = kb * 4, g = k0 / 128;
    const float* gwr = F.pgw + (size_t)k0 * 128; const float* wr = F.wpo + (size_t)(g * 128) * D + n0; const float* sc = F.pscale + g * 128;
    f32x4 s0 = {0.f, 0.f, 0.f, 0.f}, s1 = s0, s2 = s0, s3 = s0;
#pragma unroll 16
    for (int d = 0; d < 128; ++d) { const f32x4 wv = *(const f32x4*)(wr + (size_t)d * D) * sc[d];
        s0 += wv * gwr[d]; s1 += wv * gwr[128 + d]; s2 += wv * gwr[256 + d]; s3 += wv * gwr[384 + d]; }
#pragma unroll
    for (int j = 0; j < 4; ++j) { u32x2 w; w.x = pk2(s0[j], s1[j]); w.y = pk2(s2[j], s3[j]); *(u32x2*)(F.Wcat_t + (size_t)(n0 + j) * KC + k0) = w; }
}
__device__ __forceinline__ TrDesc tr_desc(const Frame& F, int q, int r) {
    if (q == 2) return TrDesc{F.win, nullptr, F.Win_t, D, INC, 0, D, r};
    if (q == 1) return TrDesc{F.wd, nullptr, F.Wd_t, FF, D, 0, FF, r};
    if (r < I_AO) return TrDesc{F.wao, nullptr, F.Wcat_t + PW, AW, D, 0, KC, r};
    r -= I_AO; if (r < I_O) return TrDesc{F.wo, nullptr, F.Wo_t, D, D, 0, D, r};
    r -= I_O; if (r < I_G) return TrDesc{F.wg, F.ffnw, F.Wgu_t, D, FF, 1, D, r};
    r -= I_G; return TrDesc{F.wu, F.ffnw, F.Wgu_t, D, FF, 2, D, r};
}
__device__ __forceinline__ void tr_run(const Frame& F, int q, int first, int stride, int total, LAS float* scr) {
    if (first >= total) return;
    float va[32], vb[32];
    TrDesc da = tr_desc(F, q, first), db = da; tr_load(da, F.lane, va);
    for (int it = first; it < total; it += 2 * stride) {
        const bool hb = it + stride < total, ha = it + 2 * stride < total;
        tr_to_lds(da, F.lane, va, scr); if (hb) { db = tr_desc(F, q, it + stride); tr_load(db, F.lane, vb); } tr_store(da, F.lane, scr);
        if (!hb) break;
        tr_to_lds(db, F.lane, vb, scr); if (ha) { da = tr_desc(F, q, it + 2 * stride); tr_load(da, F.lane, va); } tr_store(db, F.lane, scr);
    }
}
__device__ __forceinline__ void p0_prologue(Frame& F) {
    LAS float* scr = (LAS float*)(F.lds + F.wave * 16384);
    const int gw = F.vcu * NWAVES + F.wave, NGW = F.G * NWAVES;
    tr_run(F, 2, gw, NGW, I_IN, scr);
    for (int gidx = gw; gidx < M / 4; gidx += NGW) {
        const float* xr[4]; bf16* orw[4];
#pragma unroll
        for (int r = 0; r < 4; ++r) { const size_t m = (size_t)gidx + (size_t)r * (M / 4); xr[r] = F.x + m * D; orw[r] = F.XN + m * D; }
        rms_rows_to_bf16<4>(xr, F.mixw, orw, F.lane);
    }
    for (int m = M + gw; m < MP; m += NGW) {
        if (m < M + NMETA) { const float* xr[1] = {F.meta + (size_t)(m - M) * D}; bf16* orw[1] = {F.XN + (size_t)m * D}; rms_rows_to_bf16<1>(xr, F.mixw, orw, F.lane); }
        else { unsigned long long* o8 = (unsigned long long*)(F.XN + (size_t)m * D) + F.lane;
#pragma unroll
            for (int j = 0; j < 4; ++j) o8[64 * j] = 0ull; }
    }
}
__device__ __forceinline__ void deferred_weights(Frame& F, int q, int ntiles) {
    LAS float* scr = (LAS float*)(F.lds + F.wave * 16384);
    const int busy = ntiles % F.G, c = (int)blockIdx.x;
    int rank, count; if (busy == 0) { rank = c; count = F.G; } else { if (c < busy) return; rank = c - busy; count = F.G - busy; }
    const int w0 = rank * NWAVES + F.wave, nw = count * NWAVES;
    if (q == 1) { tr_run(F, 1, w0, nw, I_D, scr); return; }
    constexpr int T0 = I_AO + I_O + 2 * I_G, QA = 2;
    if (nw > I_EFF && QA * I_EFF <= T0) {
        if (w0 < I_EFF) { tr_run(F, 0, QA * w0, 1, QA * w0 + QA, scr); weff_item(F, w0 * 64 + F.lane); }
        else tr_run(F, 0, QA * I_EFF + (w0 - I_EFF), nw - I_EFF, T0, scr);
    } else {
        tr_run(F, 0, w0, nw, T0, scr);
        for (int r = w0; r < I_EFF; r += nw) weff_item(F, r * 64 + F.lane);
    }
}

namespace pg8 {
#define PG8_LAS __attribute__((address_space(3)))
typedef unsigned short bf16_t;
typedef short bf16x8 __attribute__((ext_vector_type(8)));
typedef float f32x4 __attribute__((ext_vector_type(4)));
typedef unsigned u32x4 __attribute__((ext_vector_type(4)));
constexpr int BM = 256, BK = 64, HALF = 128, HTB = HALF * BK * 2  , STAGE_BYTES = 8 * HTB, NXCD = 8, WGM = 4;

__host__ __device__ __forceinline__ int lds_byte(int r, int c) { const int st = (r >> 4) * 2 + (c >> 5), rr = r & 15, cc = c & 31, ob = rr * 64 + cc * 2; return st * 1024 + (ob ^ (((ob >> 9) & 1) << 5)); }
__host__ __device__ __forceinline__ void stage_rc(int b, int& R, int& C) { const int st = b / 1024, sb = b % 1024, swz = sb ^ (((sb >> 9) & 1) << 5); R = (st >> 1) * 16 + swz / 64; C = (st & 1) * 32 + (swz % 64) / 2; }
__host__ __device__ __forceinline__ int perm32(int rho) { const int n = rho >> 4, i = rho & 15; return 8 * (i >> 2) + 4 * n + (i & 3); }

struct Unit { int pm, pn; };
struct Gemm { const bf16_t* A; const bf16_t* Bt; int M, N, K; };

struct StaticOrder {
    int nM, nN, nwg, G, c;
    __host__ __device__ void init(int M, int N, int G_, int c_) { nM = M / BM; nN = N / BM; nwg = nM * nN; G = G_; c = c_; }
    __host__ __device__ bool next(int i, Unit& u) const {
        const long L = (long)i * G + c; if (L >= nwg) return false;
        int wgid = (int)L; { const int q = nwg / NXCD, r = nwg % NXCD, xcd = wgid % NXCD, off = wgid / NXCD; wgid = (xcd < r ? xcd * (q + 1) : r * (q + 1) + (xcd - r) * q) + off; }
        const int nig = WGM * nN, gid = wgid / nig, fm = gid * WGM, gsz = (nM - fm) < WGM ? (nM - fm) : WGM;
        u.pm = fm + ((wgid % nig) % gsz); u.pn = (wgid % nig) / gsz; return true;
    }
    __device__ __forceinline__ void a_ready(const Unit&) const {}
    __device__ __forceinline__ void done(const Unit&) const {}
};

__device__ __forceinline__ unsigned cvt_pk_bf16(float lo, float hi) { unsigned r; asm volatile("v_cvt_pk_bf16_f32 %0, %1, %2" : "=v"(r) : "v"(lo), "v"(hi)); return r; }
template <class E, class = void> struct MidT { static constexpr int v = -1; };
template <class E> struct MidT<E, decltype((void)E::MID_T)> { static constexpr int v = E::MID_T; };
template <class Epi, class Sched, bool ALIGN_EPI = false, bool SP2 = false>
__device__ __forceinline__ void gemm_phase(PG8_LAS unsigned char* lds, const Gemm g, const Sched& S, const Epi& E, const int wid, const int lane) {
    const int tid = wid * 64 + lane, wr = wid >> 2, wc = wid & 3, fr = lane & 15, fq = lane >> 4;
    const int K = g.K, nt = K / BK;
    unsigned voffA[2], voffB[2];
#pragma unroll
    for (int i = 0; i < 2; ++i) { int R, C; stage_rc(tid * 16 + i * 8192, R, C); const int Rb = Epi::PERM ? ((R & ~31) + perm32(R & 31)) : R;
        voffA[i] = (unsigned)(R * K + C) * 2u; voffB[i] = (unsigned)(Rb * K + C) * 2u; }
    const size_t kstep = (size_t)(BK * 2);
    const size_t hstep = (size_t)HALF * K * 2;
    const size_t tstep = 2 * hstep;
    const unsigned ldsw = (unsigned)wid * 1024u;
    const int aoff = lds_byte(wr * 64 + fr, fq * 8), boff = lds_byte(wc * 32 + fr, fq * 8);
#define PG8_SA(b, h) (((b) * 2 + (h)) * HTB)
#define PG8_SB(b, h) ((4 + (b) * 2 + (h)) * HTB)
#define PG8_STAGE(bufoff, gbase, voff) do { _Pragma("unroll") for (int _i = 0; _i < 2; ++_i) \
        __builtin_amdgcn_global_load_lds((const unsigned*)((const char*)(gbase) + (voff)[_i]), (PG8_LAS unsigned*)(lds + (bufoff) + ldsw + _i * 8192), 16, 0, 0); } while (0)
#define PG8_LDA(dst, b, h) do { _Pragma("unroll") for (int m = 0; m < 4; ++m) _Pragma("unroll") for (int k = 0; k < 2; ++k) dst[m][k] = *(const PG8_LAS bf16x8*)(lds + PG8_SA(b, h) + aoff + m * 2048 + k * 1024); } while (0)
#define PG8_LDB(dst, b, h) do { _Pragma("unroll") for (int n = 0; n < 2; ++n) _Pragma("unroll") for (int k = 0; k < 2; ++k) dst[n][k] = *(const PG8_LAS bf16x8*)(lds + PG8_SB(b, h) + boff + n * 2048 + k * 1024); } while (0)
#define PG8_MMA(ai, bj, At, Bt) do { __builtin_amdgcn_s_setprio(1); _Pragma("unroll") for (int m = 0; m < 4; ++m) _Pragma("unroll") for (int n = 0; n < 2; ++n) _Pragma("unroll") for (int k = 0; k < 2; ++k) \
        acc[ai][bj][m][n] = __builtin_amdgcn_mfma_f32_16x16x32_bf16(Bt[n][k], At[m][k], acc[ai][bj][m][n], 0, 0, 0); __builtin_amdgcn_s_setprio(0); } while (0)
#define PG8_WAIT_V(n) asm volatile("s_waitcnt vmcnt(" #n ")" ::: "memory")
#define PG8_WAIT_L(n) asm volatile("s_waitcnt lgkmcnt(" #n ")" ::: "memory")
#define PG8_BAR __builtin_amdgcn_s_barrier()
#define PG8_SCHED __builtin_amdgcn_sched_barrier(0)
    Unit cur, nxt; int ui = 0;
    if (!S.next(0, cur)) return;
    f32x4 acc[2][2][4][2];
#pragma unroll
    for (int a = 0; a < 2; ++a)
#pragma unroll
        for (int b = 0; b < 2; ++b)
#pragma unroll
            for (int m = 0; m < 4; ++m)
#pragma unroll
                for (int n = 0; n < 2; ++n) acc[a][b][m][n] = (f32x4){0.f, 0.f, 0.f, 0.f};
    bf16x8 At[4][2], B0[2][2], B1[2][2];
    const char* cA = (const char*)g.A + (size_t)cur.pm * tstep; const char* cB = (const char*)g.Bt + (size_t)cur.pn * tstep;
    S.a_ready(cur);
    if constexpr (SP2) {
        PG8_STAGE(PG8_SB(0, 0), cB, voffB); PG8_STAGE(PG8_SB(0, 1), cB + hstep, voffB); PG8_STAGE(PG8_SA(0, 0), cA, voffA); PG8_STAGE(PG8_SA(0, 1), cA + hstep, voffA);
        if (wr == 1) PG8_BAR;
        PG8_WAIT_V(2); PG8_BAR;
        PG8_STAGE(PG8_SB(1, 0), cB + kstep, voffB); PG8_STAGE(PG8_SA(1, 0), cA + kstep, voffA); PG8_STAGE(PG8_SB(1, 1), cB + hstep + kstep, voffB);
        PG8_WAIT_V(6); PG8_BAR;
    } else {
        PG8_STAGE(PG8_SB(0, 0), cB, voffB); PG8_STAGE(PG8_SA(0, 0), cA, voffA); PG8_STAGE(PG8_SB(0, 1), cB + hstep, voffB); PG8_STAGE(PG8_SA(0, 1), cA + hstep, voffA);
        if (wr == 1) PG8_BAR;
        PG8_WAIT_V(4); PG8_BAR;
        PG8_STAGE(PG8_SB(1, 0), cB + kstep, voffB); PG8_STAGE(PG8_SA(1, 0), cA + kstep, voffA); PG8_STAGE(PG8_SB(1, 1), cB + hstep + kstep, voffB);
        PG8_WAIT_V(6); PG8_BAR;
    }
    for (;;) {
        const bool has_next = S.next(ui + 1, nxt);
        const char* nA = has_next ? (const char*)g.A + (size_t)nxt.pm * tstep : cA; const char* nB = has_next ? (const char*)g.Bt + (size_t)nxt.pn * tstep : cB;
        for (int t = 0; t < nt; t += 2) {
            if constexpr (MidT<Epi>::v >= 0) { if (t == MidT<Epi>::v) { PG8_SCHED; E.mid(acc, cur, wr, wc, fr, fq); PG8_SCHED; } }
            const bool last = (t == nt - 2);
            const char* a1 = cA + (size_t)(t + 1) * kstep;
            const char* a2 = last ? nA : cA + (size_t)(t + 2) * kstep; const char* b2 = last ? nB : cB + (size_t)(t + 2) * kstep;
            const char* a3 = a2 + kstep; const char* b3 = b2 + kstep;
            if (last && has_next) S.a_ready(nxt);
            if constexpr (SP2) {
            PG8_LDB(B0, 0, 0); PG8_LDB(B1, 0, 1); PG8_SCHED; PG8_LDA(At, 0, 0); PG8_STAGE(PG8_SA(1, 1), a1 + hstep, voffA);
            PG8_WAIT_V(8); PG8_WAIT_L(0); PG8_BAR; PG8_MMA(0, 0, At, B0); PG8_MMA(0, 1, At, B1); PG8_BAR; PG8_SCHED;
            PG8_LDA(At, 0, 1); PG8_STAGE(PG8_SB(0, 0), b2, voffB); PG8_STAGE(PG8_SB(0, 1), b2 + hstep, voffB); PG8_STAGE(PG8_SA(0, 0), a2, voffA);
            PG8_WAIT_V(8); PG8_WAIT_L(0); PG8_BAR; PG8_MMA(1, 0, At, B0); PG8_MMA(1, 1, At, B1); PG8_BAR; PG8_SCHED;
            PG8_LDB(B0, 1, 0); PG8_LDB(B1, 1, 1); PG8_SCHED; PG8_LDA(At, 1, 0); PG8_STAGE(PG8_SA(0, 1), a2 + hstep, voffA);
            PG8_WAIT_V(8); PG8_WAIT_L(0); PG8_BAR; PG8_MMA(0, 0, At, B0); PG8_MMA(0, 1, At, B1); PG8_BAR; PG8_SCHED;
            PG8_LDA(At, 1, 1); PG8_STAGE(PG8_SB(1, 0), b3, voffB); PG8_STAGE(PG8_SB(1, 1), b3 + hstep, voffB); PG8_STAGE(PG8_SA(1, 0), a3, voffA);
            PG8_WAIT_V(8); PG8_WAIT_L(0); PG8_BAR; PG8_MMA(1, 0, At, B0); PG8_MMA(1, 1, At, B1); PG8_BAR; PG8_SCHED;
            } else {
            PG8_LDB(B0, 0, 0); PG8_SCHED; PG8_LDA(At, 0, 0); PG8_STAGE(PG8_SA(1, 1), a1 + hstep, voffA);
            PG8_WAIT_L(8); PG8_BAR; PG8_WAIT_L(0); PG8_MMA(0, 0, At, B0); PG8_BAR; PG8_SCHED;
            PG8_LDB(B1, 0, 1); PG8_STAGE(PG8_SB(0, 0), b2, voffB);
            PG8_BAR; PG8_WAIT_L(0); PG8_MMA(0, 1, At, B1); PG8_BAR;
            PG8_LDA(At, 0, 1); PG8_STAGE(PG8_SA(0, 0), a2, voffA);
            PG8_BAR; PG8_WAIT_L(0); PG8_MMA(1, 0, At, B0); PG8_BAR; PG8_SCHED;
            PG8_STAGE(PG8_SB(0, 1), b2 + hstep, voffB);
            PG8_WAIT_V(6); PG8_BAR; PG8_MMA(1, 1, At, B1); PG8_BAR;
            PG8_LDB(B0, 1, 0); PG8_SCHED; PG8_LDA(At, 1, 0); PG8_STAGE(PG8_SA(0, 1), a2 + hstep, voffA);
            PG8_WAIT_L(8); PG8_BAR; PG8_WAIT_L(0); PG8_MMA(0, 0, At, B0); PG8_BAR; PG8_SCHED;
            PG8_LDB(B1, 1, 1); PG8_STAGE(PG8_SB(1, 0), b3, voffB);
            PG8_BAR; PG8_WAIT_L(0); PG8_MMA(0, 1, At, B1); PG8_BAR;
            PG8_LDA(At, 1, 1); PG8_STAGE(PG8_SA(1, 0), a3, voffA);
            PG8_BAR; PG8_WAIT_L(0); PG8_MMA(1, 0, At, B0); PG8_BAR; PG8_SCHED;
            PG8_STAGE(PG8_SB(1, 1), b3 + hstep, voffB);
            PG8_WAIT_V(6); PG8_BAR; PG8_MMA(1, 1, At, B1); PG8_BAR;
            }
        }
        if constexpr (ALIGN_EPI) { if (wr == 0) PG8_BAR; }
        if constexpr (!Epi::AFTER_DRAIN) { E(acc, cur, wr, wc, fr, fq); S.done(cur); }
        if (!has_next) break;
#pragma unroll
        for (int a = 0; a < 2; ++a)
#pragma unroll
            for (int b = 0; b < 2; ++b)
#pragma unroll
                for (int m = 0; m < 4; ++m)
#pragma unroll
                    for (int n = 0; n < 2; ++n) acc[a][b][m][n] = (f32x4){0.f, 0.f, 0.f, 0.f};
        cur = nxt; cA = nA; cB = nB; ++ui;
        if constexpr (ALIGN_EPI) { if (wr == 1) PG8_BAR; }
    }
    PG8_WAIT_V(0);
    if constexpr (!ALIGN_EPI) { if (wr == 0) PG8_BAR; }
    PG8_BAR;
    if constexpr (Epi::AFTER_DRAIN) { E.fused(acc, cur, wr, wc, fr, fq, lds, wid, lane); S.done(cur); }
#undef PG8_SA
#undef PG8_SB
#undef PG8_STAGE
#undef PG8_LDA
#undef PG8_LDB
#undef PG8_MMA
#undef PG8_WAIT_V
#undef PG8_WAIT_L
#undef PG8_BAR
#undef PG8_SCHED
}
}

struct EpiP1 {
    bf16 *UP, *Qb, *Kb, *Vb, *GP, *GA;
    __device__ __forceinline__ void store8(int row, int col, f32x4 a, f32x4 b) const {
        bf16* dst; int c;
        if (col < 512) { dst = UP + (size_t)row * PW; c = col; }
        else if (col < 1536) { if (row >= M) return; dst = Qb + (size_t)row * AW; c = col - 512; a = a * QSCALE; b = b * QSCALE; }
        else if (col < 2560) { dst = Kb + (size_t)row * AW; c = col - 1536; }
        else if (col < 3584) { dst = Vb + (size_t)row * AW; c = col - 2560; }
        else { if (row >= M) return; const bool ga = col >= 4608; dst = (ga ? GA : GP) + (size_t)row * D; c = col - (ga ? 4608 : 3584);
#pragma unroll
            for (int i = 0; i < 4; ++i) { a[i] = sigmoidf_(a[i]); b[i] = sigmoidf_(b[i]); } }
        u32x4 w; w.x = pk2(a[0], a[1]); w.y = pk2(a[2], a[3]); w.z = pk2(b[0], b[1]); w.w = pk2(b[2], b[3]);
        *(u32x4*)(dst + c) = w;
    }
};
struct EpiP3 {
    static constexpr bool PERM = true, AFTER_DRAIN = false; static constexpr int MID_T = PW / 64;
    const bf16 *GP, *GA; bf16* MERGED;
    __device__ __forceinline__ static float gsafe(float g) { return __builtin_fmaxf(g, 8.6736174e-19f); }
    __device__ __forceinline__ void mid(f32x4 (&acc)[2][2][4][2], const pg8::Unit& u, int wr, int wc, int fr, int fq) const {
        asm volatile("" : "+v"(fr), "+v"(fq));
        const int row0 = u.pm * 256 + wr * 64 + fr, col0 = u.pn * 256 + wc * 32 + 8 * fq;
#pragma unroll
        for (int ai = 0; ai < 2; ++ai)
#pragma unroll
            for (int m = 0; m < 4; ++m) { const size_t ro = (size_t)(row0 + ai * 128 + m * 16) * D + col0;
#pragma unroll
                for (int bj = 0; bj < 2; ++bj) { const u32x4 p = *(const u32x4*)(GP + ro + bj * 128), a = *(const u32x4*)(GA + ro + bj * 128);
                    f32x4& x = acc[ai][bj][m][0]; f32x4& y = acc[ai][bj][m][1];
                    x[0] *= bflo(p.x) * __builtin_amdgcn_rcpf(gsafe(bflo(a.x))); x[1] *= bfhi(p.x) * __builtin_amdgcn_rcpf(gsafe(bfhi(a.x)));
                    x[2] *= bflo(p.y) * __builtin_amdgcn_rcpf(gsafe(bflo(a.y))); x[3] *= bfhi(p.y) * __builtin_amdgcn_rcpf(gsafe(bfhi(a.y)));
                    y[0] *= bflo(p.z) * __builtin_amdgcn_rcpf(gsafe(bflo(a.z))); y[1] *= bfhi(p.z) * __builtin_amdgcn_rcpf(gsafe(bfhi(a.z)));
                    y[2] *= bflo(p.w) * __builtin_amdgcn_rcpf(gsafe(bflo(a.w))); y[3] *= bfhi(p.w) * __builtin_amdgcn_rcpf(gsafe(bfhi(a.w))); }
                asm volatile("" : "+v"(acc[ai][0][m][0]), "+v"(acc[ai][0][m][1]), "+v"(acc[ai][1][m][0]), "+v"(acc[ai][1][m][1]));
                asm volatile("" ::: "memory"); }
    }
    __device__ __forceinline__ void operator()(const f32x4 (&acc)[2][2][4][2], const pg8::Unit& u, int wr, int wc, int fr, int fq) const {
        const int row0 = u.pm * 256 + wr * 64 + fr, col0 = u.pn * 256 + wc * 32 + 8 * fq;
#pragma unroll
        for (int ai = 0; ai < 2; ++ai)
#pragma unroll
            for (int m = 0; m < 4; ++m) { const size_t ro = (size_t)(row0 + ai * 128 + m * 16) * D + col0;
#pragma unroll
                for (int bj = 0; bj < 2; ++bj) { const u32x4 a = *(const u32x4*)(GA + ro + bj * 128); const f32x4 x = acc[ai][bj][m][0], y = acc[ai][bj][m][1];
                    u32x4 w; w.x = pk2(x[0] * gsafe(bflo(a.x)), x[1] * gsafe(bfhi(a.x))); w.y = pk2(x[2] * gsafe(bflo(a.y)), x[3] * gsafe(bfhi(a.y)));
                    w.z = pk2(y[0] * gsafe(bflo(a.z)), y[1] * gsafe(bfhi(a.z))); w.w = pk2(y[2] * gsafe(bflo(a.w)), y[3] * gsafe(bfhi(a.w)));
                    *(u32x4*)(MERGED + ro + bj * 128) = w; } }
    }
};
struct EpiP4 {
    const float* x; bf16* HB;
    __device__ __forceinline__ float store8(int row, int col, f32x4 a, f32x4 b) const {
        const float* xr = x + (size_t)row * D + col; a = a + __builtin_nontemporal_load((const f32x4*)xr); b = b + __builtin_nontemporal_load((const f32x4*)(xr + 4));
        u32x4 w; w.x = pk2(a[0], a[1]); w.y = pk2(a[2], a[3]); w.z = pk2(b[0], b[1]); w.w = pk2(b[2], b[3]);
        *(u32x4*)(HB + (size_t)row * D + col) = w;
        return (a[0] * a[0] + a[1] * a[1]) + (a[2] * a[2] + a[3] * a[3]) + (b[0] * b[0] + b[1] * b[1]) + (b[2] * b[2] + b[3] * b[3]);
    }
};
struct EpiP5 {
    bf16* ACT;
    __device__ __forceinline__ void store8(int row, int ocol, float rstd, f32x4 g0, f32x4 g1, f32x4 u0, f32x4 u1) const {
        float r[8];
#pragma unroll
        for (int i = 0; i < 4; ++i) { const float ga = g0[i] * rstd, gb = g1[i] * rstd; r[i] = ga * sigmoidf_(ga) * (u0[i] * rstd); r[4 + i] = gb * sigmoidf_(gb) * (u1[i] * rstd); }
        u32x4 w; w.x = pk2(r[0], r[1]); w.y = pk2(r[2], r[3]); w.z = pk2(r[4], r[5]); w.w = pk2(r[6], r[7]);
        *(u32x4*)(ACT + (size_t)row * FF + ocol) = w;
    }
};
struct EpiP6 {
    const bf16* HB; float* H;
    __device__ __forceinline__ void store8(int row, int col, f32x4 a, f32x4 b) const {
        const u32x4 h = *(const u32x4*)(HB + (size_t)row * D + col); float* o = H + (size_t)row * D + col;
        a[0] += bflo(h.x); a[1] += bfhi(h.x); a[2] += bflo(h.y); a[3] += bfhi(h.y); b[0] += bflo(h.z); b[1] += bfhi(h.z); b[2] += bflo(h.w); b[3] += bfhi(h.w);
        *(f32x4*)o = a; *(f32x4*)(o + 4) = b;
    }
};

template <class Fn> struct Epi8 {
    static constexpr bool PERM = true, AFTER_DRAIN = false; Fn f;
    __device__ __forceinline__ void operator()(const f32x4 (&acc)[2][2][4][2], const pg8::Unit& u, int wr, int wc, int fr, int fq) const {
        const int row0 = u.pm * 256 + wr * 64 + fr, col0 = u.pn * 256 + wc * 32 + 8 * fq;
#pragma unroll
        for (int ai = 0; ai < 2; ++ai)
#pragma unroll
            for (int m = 0; m < 4; ++m) { const int row = row0 + ai * 128 + m * 16;
#pragma unroll
                for (int bj = 0; bj < 2; ++bj) f.store8(row, col0 + bj * 128, acc[ai][bj][m][0], acc[ai][bj][m][1]); }
    }
};
struct Epi8P1 {
    static constexpr bool PERM = true, AFTER_DRAIN = false; EpiP1 f;
    template <int CLS> __device__ __forceinline__ void half(const f32x4 (&acc)[2][2][4][2], int bj, int row0, int cb) const {
        bf16* base = CLS == 0 ? f.UP : CLS == 1 ? f.Qb : CLS == 2 ? f.Kb : CLS == 3 ? f.Vb : CLS == 4 ? f.GP : f.GA;
        constexpr int ldc = CLS == 0 ? PW : (CLS >= 4 ? D : AW);
#pragma unroll
        for (int ai = 0; ai < 2; ++ai)
#pragma unroll
            for (int m = 0; m < 4; ++m) { const int row = row0 + ai * 128 + m * 16; f32x4 a = bj ? acc[ai][1][m][0] : acc[ai][0][m][0], b = bj ? acc[ai][1][m][1] : acc[ai][0][m][1];
                if (CLS == 1) { a = a * QSCALE; b = b * QSCALE; }
                if (CLS >= 4) {
#pragma unroll
                    for (int i = 0; i < 4; ++i) { a[i] = sigmoidf_(a[i]); b[i] = sigmoidf_(b[i]); } }
                u32x4 w; w.x = pk2(a[0], a[1]); w.y = pk2(a[2], a[3]); w.z = pk2(b[0], b[1]); w.w = pk2(b[2], b[3]);
                *(u32x4*)(base + (size_t)row * ldc + cb) = w; }
    }
    __device__ __forceinline__ void operator()(const f32x4 (&acc)[2][2][4][2], const pg8::Unit& u, int wr, int wc, int fr, int fq) const {
        asm volatile("" : "+v"(fr), "+v"(fq));
        const int row0 = u.pm * 256 + wr * 64 + fr, lc = wc * 32 + 8 * fq;
        const bool meta_panel = u.pm >= M / 256;
#pragma unroll
        for (int bj = 0; bj < 2; ++bj) {
            const int colt = u.pn * 256 + bj * 128;
            if (colt < 512) half<0>(acc, bj, row0, colt + lc);
            else if (colt < 1536) { if (!meta_panel) half<1>(acc, bj, row0, colt - 512 + lc); }
            else if (colt < 2560) half<2>(acc, bj, row0, colt - 1536 + lc);
            else if (colt < 3584) half<3>(acc, bj, row0, colt - 2560 + lc);
            else if (colt < 4608) { if (!meta_panel) half<4>(acc, bj, row0, colt - 3584 + lc); }
            else { if (!meta_panel) half<5>(acc, bj, row0, colt - 4608 + lc); }
        }
    }
};
struct Epi8P4 {
    static constexpr bool PERM = true, AFTER_DRAIN = false; EpiP4 f; float* PART;
    __device__ __forceinline__ void operator()(const f32x4 (&acc)[2][2][4][2], const pg8::Unit& u, int wr, int wc, int fr, int fq) const {
        const int row0 = u.pm * 256 + wr * 64 + fr, col0 = u.pn * 256 + wc * 32 + 8 * fq;
#pragma unroll
        for (int ai = 0; ai < 2; ++ai)
#pragma unroll
            for (int m = 0; m < 4; ++m) { const int row = row0 + ai * 128 + m * 16;
                float s = f.store8(row, col0, acc[ai][0][m][0], acc[ai][0][m][1]) + f.store8(row, col0 + 128, acc[ai][1][m][0], acc[ai][1][m][1]);
                s += __shfl_xor(s, 16); s += __shfl_xor(s, 32);
                if (fq == 0) PART[(size_t)row * 16 + u.pn * 4 + wc] = s; }
    }
};
struct Epi8P5 {
    static constexpr bool PERM = true, AFTER_DRAIN = false; EpiP5 f; const float* PART;
    __device__ __forceinline__ void operator()(const f32x4 (&acc)[2][2][4][2], const pg8::Unit& u, int wr, int wc, int fr, int fq) const {
        const int row0 = u.pm * 256 + wr * 64 + fr, ocol = u.pn * 128 + wc * 32 + 8 * fq;
#pragma unroll
        for (int ai = 0; ai < 2; ++ai)
#pragma unroll
            for (int m = 0; m < 4; ++m) { const int row = row0 + ai * 128 + m * 16;
                const f32x4 p = *(const f32x4*)(PART + (size_t)row * 16 + 4 * fq); float s = (p.x + p.y) + (p.z + p.w);
                s += __shfl_xor(s, 16); s += __shfl_xor(s, 32);
                const float rstd = __builtin_amdgcn_rsqf(s * (1.f / D) + EPS);
                f.store8(row, ocol, rstd, acc[ai][0][m][0], acc[ai][0][m][1], acc[ai][1][m][0], acc[ai][1][m][1]); }
    }
};
struct EpiFinal {
    static constexpr bool PERM = true, AFTER_DRAIN = true;
    const bf16* HB; float* H; const float* finw; unsigned* xbuf; unsigned* cnt;
    __device__ __forceinline__ void fused(f32x4 (&acc)[2][2][4][2], const pg8::Unit& u, int wr, int wc, int fr, int fq, LAS unsigned char* lds, int wid, int lane) const {
        LAS float* P = (LAS float*)lds;
        LAS float* S = (LAS float*)(lds + 4096);
        const int row0 = u.pm * 256 + wr * 64 + fr, col0 = u.pn * 256 + wc * 32 + 8 * fq;
#pragma unroll
        for (int ai = 0; ai < 2; ++ai)
#pragma unroll
            for (int m = 0; m < 4; ++m) { const int row = row0 + ai * 128 + m * 16; float s = 0.f;
#pragma unroll
                for (int bj = 0; bj < 2; ++bj) { const u32x4 h = *(const u32x4*)(HB + (size_t)row * D + col0 + bj * 128);
                    const f32x4 a = acc[ai][bj][m][0] + (f32x4){bflo(h.x), bfhi(h.x), bflo(h.y), bfhi(h.y)}, b = acc[ai][bj][m][1] + (f32x4){bflo(h.z), bfhi(h.z), bflo(h.w), bfhi(h.w)}; acc[ai][bj][m][0] = a; acc[ai][bj][m][1] = b;
                    s += (a[0] * a[0] + a[1] * a[1]) + (a[2] * a[2] + a[3] * a[3]) + (b[0] * b[0] + b[1] * b[1]) + (b[2] * b[2] + b[3] * b[3]); }
                s += __shfl_xor(s, 16); s += __shfl_xor(s, 32);
                if (fq == 0) P[(ai * 128 + wr * 64 + m * 16 + fr) * 4 + wc] = s;
                if (m & 1) asm volatile("" ::: "memory"); }
        asm volatile("s_waitcnt lgkmcnt(0)" ::: "memory"); __builtin_amdgcn_s_barrier(); asm volatile("" ::: "memory");
        const int row = wid * 32 + (lane & 31);
        if (lane < 32) { const f32x4 p = *(const LAS f32x4*)(P + row * 4); const float t = (p.x + p.y) + (p.z + p.w);
            __hip_atomic_store(xbuf + ((size_t)(u.pm * 256 + row) * 4 + u.pn), __float_as_uint(t), __ATOMIC_RELAXED, __HIP_MEMORY_SCOPE_AGENT); }
        asm volatile("s_waitcnt vmcnt(0)" ::: "memory");
        if (lane == 0) __hip_atomic_fetch_add(cnt + 64 * u.pm, 1u, __ATOMIC_RELAXED, __HIP_MEMORY_SCOPE_AGENT);
        if (wid == 0) {
            for (unsigned sp = 0; sp < (1u << 22); ++sp) {
                if ((unsigned)__builtin_amdgcn_readfirstlane(__hip_atomic_load(cnt + 64 * u.pm, __ATOMIC_RELAXED, __HIP_MEMORY_SCOPE_AGENT)) >= 32u) break;
                __builtin_amdgcn_s_sleep(2); }
            __builtin_amdgcn_fence(__ATOMIC_ACQUIRE, "agent");
        }
        asm volatile("s_waitcnt vmcnt(0) lgkmcnt(0)" ::: "memory"); __builtin_amdgcn_s_barrier(); asm volatile("" ::: "memory");
        if (lane < 32) { const unsigned* slot = xbuf + (size_t)(u.pm * 256 + row) * 4; float t = 0.f;
#pragma unroll
            for (int k = 0; k < 4; ++k) t += __uint_as_float(__hip_atomic_load(slot + k, __ATOMIC_RELAXED, __HIP_MEMORY_SCOPE_AGENT));
            S[row] = 1.f / sqrtf(t * (1.f / D) + EPS); }
        asm volatile("s_waitcnt lgkmcnt(0)" ::: "memory"); __builtin_amdgcn_s_barrier(); asm volatile("" ::: "memory");
        f32x4 wv[2][2];
#pragma unroll
        for (int bj = 0; bj < 2; ++bj) { wv[bj][0] = *(const f32x4*)(finw + col0 + bj * 128); wv[bj][1] = *(const f32x4*)(finw + col0 + bj * 128 + 4); }
#pragma unroll
        for (int ai = 0; ai < 2; ++ai)
#pragma unroll
            for (int m = 0; m < 4; ++m) { const int r = ai * 128 + wr * 64 + m * 16 + fr; const float rs = S[r]; float* h = H + (size_t)(u.pm * 256 + r) * D + col0;
#pragma unroll
                for (int bj = 0; bj < 2; ++bj) { *(f32x4*)(h + bj * 128) = acc[ai][bj][m][0] * rs * wv[bj][0]; *(f32x4*)(h + bj * 128 + 4) = acc[ai][bj][m][1] * rs * wv[bj][1]; } }
    }
};
struct OrderP1 {
    pg8::StaticOrder so;
    __device__ void init(int G, int c) { so.init(M, INC, G, c); }
    __device__ bool next(int i, pg8::Unit& u) const {
        if (so.next(i, u)) return true;
        const long e = (long)i * so.G + so.c - so.nwg; if (e < 0 || e >= 10) return false;
        u.pm = M / 256; u.pn = (e < 2) ? (int)e : (int)e + 4; return true;
    }
    __device__ __forceinline__ void a_ready(const pg8::Unit&) const {}
    __device__ __forceinline__ void done(const pg8::Unit&) const {}
};

__device__ __forceinline__ void bf8_add(float (&s)[8], const u32x4 v, float sg) {
    s[0] += sg * bflo(v.x); s[1] += sg * bfhi(v.x); s[2] += sg * bflo(v.y); s[3] += sg * bfhi(v.y); s[4] += sg * bflo(v.z); s[5] += sg * bfhi(v.z); s[6] += sg * bflo(v.w); s[7] += sg * bfhi(v.w);
}
__device__ __forceinline__ void pool_phase(Frame& F) {
    constexpr int RUN = 8;
    const long total = (long)(M / RUN) * (PW / 8);
    for (long it = (long)blockIdx.x * NTHR + F.tid; it < total; it += (long)F.G * NTHR) {
        const int m0 = (int)(it / (PW / 8)) * RUN, c0 = (int)(it % (PW / 8)) * 8, b = m0 / SEQ, t0 = m0 % SEQ, g = c0 / 128, w = 2 << g;
        const float iw = 1.f / (float)w;
        auto urow = [&](int tt) -> const bf16* { return F.UP + ((tt >= 0) ? (size_t)(b * SEQ + tt) : (size_t)(M + NMETA + tt)) * PW + c0; };
        float s[8];
#pragma unroll
        for (int j = 0; j < 8; ++j) s[j] = 0.f;
        for (int i = 1; i < w; ++i) bf8_add(s, *(const u32x4*)urow(t0 - i), 1.f);
#pragma unroll
        for (int r = 0; r < RUN; ++r) { const int t = t0 + r;
            const u32x4 self = *(const u32x4*)urow(t); bf8_add(s, self, 1.f);
            u32x4 o; o.x = pk2(s[0] * iw - bflo(self.x), s[1] * iw - bfhi(self.x)); o.y = pk2(s[2] * iw - bflo(self.y), s[3] * iw - bfhi(self.y));
            o.z = pk2(s[4] * iw - bflo(self.z), s[5] * iw - bfhi(self.z)); o.w = pk2(s[6] * iw - bflo(self.w), s[7] * iw - bfhi(self.w));
            *(u32x4*)(F.ACAT + (size_t)(m0 + r) * KC + c0) = o;
            if (r + 1 < RUN) bf8_add(s, *(const u32x4*)urow(t - w + 1), -1.f); }
    }
}

__device__ __forceinline__ int t5_bucket(int rel) {
    const int n = rel < 0 ? -rel : rel; int r = rel > 0 ? 16 : 0;
    int v;
    if (n < 8) v = n; else if (n < 12) v = 8; else if (n < 16) v = 9; else if (n < 23) v = 10; else if (n < 32) v = 11; else if (n < 46) v = 12; else if (n < 64) v = 13; else if (n < 91) v = 14; else v = 15;
    return r + v;
}
__device__ __forceinline__ float compute_lambda(const Frame& F) {
    float a = 0.f, b = 0.f;
    for (int i = 0; i < HD; ++i) { a += F.lq1[i] * F.lk1[i]; b += F.lq2[i] * F.lk2[i]; }
    return __expf(a) - __expf(b) + 0.2f;
}
namespace attn {
typedef short bf16x8 __attribute__((ext_vector_type(8)));
typedef short s16x4 __attribute__((ext_vector_type(4)));
typedef float f32x16 __attribute__((ext_vector_type(16)));
typedef short v4i16_t __attribute__((ext_vector_type(4)));
typedef LAS const char* lds_cptr;
constexpr int RSLOT = 16384, LDS_KR = 0, LDS_VR = 3 * RSLOT;
constexpr int STG_PITCH = 132;
constexpr int LDS_WS = 6 * RSLOT, LDS_BIAS = LDS_WS + 2048, NBIAS = 320;
constexpr int THR = 8;
static_assert(128 * STG_PITCH * 4 <= LDS_WS && LDS_BIAS + NBIAS * 4 <= RING_BYTES, "attention LDS map");
__device__ __forceinline__ int crow(int r, int hi) { return (r & 3) + 8 * (r >> 2) + 4 * hi; }
__device__ __forceinline__ void glds16s(const void* sbase, unsigned voff, unsigned lds_dst) { unsigned keep;
    asm volatile("s_nop 4\n\ts_mov_b32 %0, m0\n\ts_mov_b32 m0, %3\n\ts_nop 0\n\tglobal_load_lds_dwordx4 %1, %2\n\ts_mov_b32 m0, %0" : "=&s"(keep) : "v"(voff), "s"(sbase), "s"(lds_dst) : "memory"); }
typedef float f32x2_t __attribute__((ext_vector_type(2))); typedef __bf16 bf16x2_t __attribute__((ext_vector_type(2)));
__device__ __forceinline__ unsigned cvtpk(float lo, float hi) { f32x2_t v = {lo, hi}; bf16x2_t b = __builtin_convertvector(v, bf16x2_t); return __builtin_bit_cast(unsigned, b); }
__device__ __forceinline__ s16x4 vtr(lds_cptr p) { return __builtin_bit_cast(s16x4, __builtin_amdgcn_ds_read_tr16_b64_v4i16((LAS v4i16_t*)p)); }
#define ATT_WAIT_BAR() asm volatile("s_waitcnt vmcnt(0) lgkmcnt(0)\n\ts_barrier" ::: "memory")
#define ATT_MX3(a, b, c) __builtin_fmaxf(__builtin_fmaxf((a), (b)), (c))
__device__ __forceinline__ float rowmax(const f32x16& p0, const f32x16& p1) {
    float a = ATT_MX3(p0[0], p0[1], p1[0]), b = ATT_MX3(p0[2], p0[3], p1[1]); a = ATT_MX3(a, p1[2], p1[3]);
#pragma unroll
    for (int r = 4; r < 16; r += 4) { a = ATT_MX3(a, p0[r], p0[r + 1]); b = ATT_MX3(b, p0[r + 2], p0[r + 3]); a = ATT_MX3(a, p1[r], p1[r + 1]); b = ATT_MX3(b, p1[r + 2], p1[r + 3]); }
    float m = __builtin_fmaxf(a, b); auto rr = __builtin_amdgcn_permlane32_swap(__float_as_uint(m), __float_as_uint(m), false, false);
    return __builtin_fmaxf(__uint_as_float(rr[0]), __uint_as_float(rr[1]));
}

__device__ __forceinline__ void pv_tile(f32x16 (&o)[4], const u32x4 (&pw)[4], const lds_cptr vp) {
#pragma unroll
    for (int db = 0; db < 4; ++db)
#pragma unroll
        for (int ks = 0; ks < 4; ++ks) {
            const s16x4 lo = vtr(vp + db * 4096 + ks * 1024), hh = vtr(vp + db * 4096 + ks * 1024 + 512);
            const bf16x8 vf = (bf16x8){lo[0], lo[1], lo[2], lo[3], hh[0], hh[1], hh[2], hh[3]};
            o[db] = __builtin_amdgcn_mfma_f32_32x32x16_bf16(__builtin_bit_cast(bf16x8, pw[ks]), vf, o[db], 0, 0, 0);
        }
}
#define ATT_SBAR() __builtin_amdgcn_sched_barrier(0)
#define ATT_PIN(x) asm volatile("" : "+v"(x))
#define ATT_MFMA(a, b, c) __builtin_amdgcn_mfma_f32_32x32x16_bf16(a, b, c, 0, 0, 0)

__device__ __forceinline__ void attn_unit(const Frame& F, int b, int h, int qb, float lam) {
    int lane = F.lane; asm volatile("" : "+v"(lane));
    const int r32 = lane & 31, hi = lane >> 5, wid = F.wave, rg = wid & 3, map = wid >> 2;
    const int q0w = qb * 128 + rg * 32;
    const size_t rowbase = (size_t)b * SEQ;
    const LAS unsigned char* lds = F.lds;
    const unsigned lds0 = (unsigned)(uintptr_t)lds;
    LAS float* wsf = (LAS float*)(lds + LDS_WS) + wid * 64;
    const LAS float* tb = (const LAS float*)(lds + LDS_BIAS);
    const int NT = 2 * qb + 3;
    const unsigned kvoff = (unsigned)(lane * AW + wid * 8) * 2u;
    const unsigned vvoff = (unsigned)((16 * (wid & 3) + (lane >> 2)) * AW + (wid >> 2) * 32 + (lane & 3) * 8) * 2u;
    const unsigned pdst = lds0 + wid * 1024;
#define ATT_TROW(t) ((t) == 0 ? (size_t)M : rowbase + (size_t)64 * ((t) - 1))
#define ATT_DMA_K(t, slot) do { const bf16* kb_ = F.Kb + ATT_TROW(t) * AW + h * 128; const unsigned d_ = (unsigned)__builtin_amdgcn_readfirstlane(pdst + LDS_KR + (slot)); \
        glds16s(kb_, kvoff, d_); glds16s(kb_ + 64, kvoff, d_ + 8192); } while (0)
#define ATT_DMA_V(t, slot) do { const bf16* vb_ = F.Vb + ATT_TROW(t) * AW + h * 128; const unsigned d_ = (unsigned)__builtin_amdgcn_readfirstlane(pdst + LDS_VR + (slot)); \
        glds16s(vb_, vvoff, d_); glds16s(vb_ + 64, vvoff, d_ + 8192); } while (0)
    ATT_DMA_K(0, 0); ATT_DMA_V(0, 0); ATT_DMA_K(1, RSLOT);
    bf16x8 qr[4];
    { const bf16* Qw = F.Qb + (rowbase + q0w + r32) * AW + h * 128 + map * 64 + hi * 8;
#pragma unroll
      for (int d0 = 0; d0 < 4; ++d0) qr[d0] = *(const bf16x8*)(Qw + d0 * 16); }
    float mhat = 0.f, l_reg = 0.f; f32x16 o[4]; f32x16 negm = f32x16{};
#pragma unroll
    for (int i = 0; i < 4; ++i) o[i] = f32x16{};
    const lds_cptr kp0 = (lds_cptr)lds + LDS_KR + map * 8192 + hi * 1024 + r32 * 16;
    const lds_cptr vp0 = (lds_cptr)lds + LDS_VR + ((lane >> 4) & 1) * 32 + (lane & 3) * 8 + (4 * hi + ((lane & 15) >> 2)) * 64;
    const bool last_active = rg >= 2;
    bf16x8 kf[8];
#define ATT_KLOAD(kp_, j) do { kf[2 * (j)] = *(const LAS bf16x8*)((kp_) + (j) * 2048); kf[2 * (j) + 1] = *(const LAS bf16x8*)((kp_) + (j) * 2048 + 512); } while (0)
    ATT_WAIT_BAR();
    f32x16 pA0, pA1, pB0, pB1;
    ATT_DMA_K(2, 2 * RSLOT); ATT_DMA_V(1, RSLOT);
    { ATT_KLOAD(kp0, 0); ATT_KLOAD(kp0, 1); ATT_KLOAD(kp0, 2); ATT_KLOAD(kp0, 3);
      pA0 = ATT_MFMA(kf[0], qr[0], f32x16{}); pA1 = ATT_MFMA(kf[1], qr[0], f32x16{});
#pragma unroll
      for (int d0 = 1; d0 < 4; ++d0) { pA0 = ATT_MFMA(kf[2 * d0], qr[d0], pA0); pA1 = ATT_MFMA(kf[2 * d0 + 1], qr[d0], pA1); }
      if ((NMETA + q0w) - 63 < 91) {
          const LAS float* tbl = tb + ((NMETA + q0w + r32) + 128 - 4 * hi - 12);
#pragma unroll
          for (int r = 0; r < 8; ++r) pA0[r] += tbl[12 - ((r & 3) + 8 * (r >> 2))];
      }
#pragma unroll
      for (int r = 0; r < 16; ++r) { if (r >= 8) pA0[r] = -1e30f; pA1[r] = -1e30f; }
      mhat = rowmax(pA0, pA1);
#pragma unroll
      for (int r = 0; r < 16; ++r) negm[r] = -mhat;
      asm volatile("" : "+v"(negm));
#pragma unroll
      for (int r = 0; r < 16; ++r) { pA0[r] = __builtin_amdgcn_exp2f(pA0[r] - mhat); pA1[r] = __builtin_amdgcn_exp2f(pA1[r] - mhat); }
      const lds_cptr kn = kp0 + RSLOT; ATT_KLOAD(kn, 0); ATT_KLOAD(kn, 1); ATT_KLOAD(kn, 2); ATT_KLOAD(kn, 3); }
    asm volatile("s_waitcnt vmcnt(2) lgkmcnt(0)\n\ts_barrier" ::: "memory");
    s16x4 vlo[8], vhi[8]; u32x4 pw0, pw1, pw2, pw3; bool resc;
    int s_prev = 0, s_cur = RSLOT, s_next = 2 * RSLOT;
#define ATT_ROT() do { const int n_ = s_prev; s_prev = s_cur; s_cur = s_next; s_next = n_; } while (0)
#define ATT_VRD(i, f) do { vlo[i] = vtr(vp_ + (((f) >> 2) * 4096 + ((f) & 3) * 1024)); vhi[i] = vtr(vp_ + (((f) >> 2) * 4096 + ((f) & 3) * 1024 + 512)); } while (0)
#define ATT_VFR(i) (bf16x8){vlo[i][0], vlo[i][1], vlo[i][2], vlo[i][3], vhi[i][0], vhi[i][1], vhi[i][2], vhi[i][3]}
#define ATT_PAF(k) __builtin_bit_cast(bf16x8, pw##k)
#define ATT_GAPA(MF, A0, A1, A2, A3, W0, W1, PW) do { MF; sacc += A0; sacc += A1; sacc += A2; sacc += A3; ATT_PIN(sacc); W0; W1; ATT_PIN(PW); ATT_SBAR(); } while (0)
#define ATT_EX(v) __builtin_amdgcn_exp2f(v)
#define ATT_PV(i) o[(i) >> 2] = ATT_MFMA(__builtin_bit_cast(bf16x8, (((i) & 3) == 0) ? pw0 : (((i) & 3) == 1) ? pw1 : (((i) & 3) == 2) ? pw2 : pw3), ATT_VFR((i) & 7), o[(i) >> 2])
#define ATT_KRD(j) kf[j] = *(const LAS bf16x8*)(kn_ + ((j) >> 1) * 2048 + ((j) & 1) * 512)
#define ATT_EXP1(C0, C1, e) do { if ((e) < 16) C0[(e) & 15] = ATT_EX(C0[(e) & 15]); else C1[(e) & 15] = ATT_EX(C1[(e) & 15]); } while (0)
#define ATT_STEP(C0, C1, P0, P1, t) do { \
        if ((t) + 2 < NT) ATT_DMA_K((t) + 2, s_prev); \
        if ((t) + 1 < NT) ATT_DMA_V((t) + 1, s_next); \
        const lds_cptr vp_ = vp0 + s_prev; const lds_cptr kn_ = kp0 + s_next; \
        ATT_SBAR(); \
        float sacc = 0.f; \
        ATT_VRD(0, 0); ATT_VRD(1, 1); ATT_SBAR(); \
        ATT_GAPA(C0 = ATT_MFMA(kf[0], qr[0], negm), P0[0], P0[1], P0[2], P0[3],     pw0[0] = cvtpk(P0[0], P0[1]),   pw0[1] = cvtpk(P0[2], P0[3]),   pw0); \
        ATT_VRD(2, 2); ATT_SBAR(); \
        ATT_GAPA(C1 = ATT_MFMA(kf[1], qr[0], negm), P0[4], P0[5], P0[6], P0[7],     pw0[2] = cvtpk(P0[4], P0[5]),   pw0[3] = cvtpk(P0[6], P0[7]),   pw0); \
        ATT_VRD(3, 3); ATT_SBAR(); \
        ATT_GAPA(C0 = ATT_MFMA(kf[2], qr[1], C0),       P0[8], P0[9], P0[10], P0[11],   pw1[0] = cvtpk(P0[8], P0[9]),   pw1[1] = cvtpk(P0[10], P0[11]), pw1); \
        ATT_VRD(4, 4); ATT_SBAR(); \
        ATT_GAPA(C1 = ATT_MFMA(kf[3], qr[1], C1),       P0[12], P0[13], P0[14], P0[15], pw1[2] = cvtpk(P0[12], P0[13]), pw1[3] = cvtpk(P0[14], P0[15]), pw1); \
        ATT_VRD(5, 5); ATT_SBAR(); \
        ATT_GAPA(C0 = ATT_MFMA(kf[4], qr[2], C0),       P1[0], P1[1], P1[2], P1[3],     pw2[0] = cvtpk(P1[0], P1[1]),   pw2[1] = cvtpk(P1[2], P1[3]),   pw2); \
        ATT_VRD(6, 6); ATT_SBAR(); \
        ATT_GAPA(C1 = ATT_MFMA(kf[5], qr[2], C1),       P1[4], P1[5], P1[6], P1[7],     pw2[2] = cvtpk(P1[4], P1[5]),   pw2[3] = cvtpk(P1[6], P1[7]),   pw2); \
        ATT_VRD(7, 7); ATT_SBAR(); \
        ATT_GAPA(C0 = ATT_MFMA(kf[6], qr[3], C0),       P1[8], P1[9], P1[10], P1[11],   pw3[0] = cvtpk(P1[8], P1[9]),   pw3[1] = cvtpk(P1[10], P1[11]), pw3); \
        ATT_GAPA(C1 = ATT_MFMA(kf[7], qr[3], C1),       P1[12], P1[13], P1[14], P1[15], pw3[2] = cvtpk(P1[12], P1[13]), pw3[3] = cvtpk(P1[14], P1[15]), pw3); \
        l_reg += sacc; \
        { const int kpos0_ = NMETA + 64 * ((t) - 1); \
          if ((NMETA + q0w) - (kpos0_ + 63) < 91) {                                     \
              const LAS float* tbl_ = tb + ((NMETA + q0w + r32) - kpos0_ + 128 - 4 * hi - 60);     \
              _Pragma("unroll") for (int r = 0; r < 16; ++r) { const int c_ = (r & 3) + 8 * (r >> 2); C0[r] += tbl_[60 - c_]; C1[r] += tbl_[28 - c_]; } } \
          if ((t) == NT - 1 && !last_active) { _Pragma("unroll") for (int r = 0; r < 16; ++r) { C0[r] = -1e30f; C1[r] = -1e30f; } } } \
          \
        float ma_, mb_; resc = false; \
        ATT_SBAR(); \
        ATT_PV(0); ma_ = ATT_MX3(C0[0], C0[1], C1[0]); mb_ = ATT_MX3(C0[2], C0[3], C1[1]); ma_ = ATT_MX3(ma_, C1[2], C1[3]); ma_ = ATT_MX3(ma_, C0[4], C0[5]); ATT_PIN(ma_); ATT_PIN(mb_); ATT_VRD(0, 8); ATT_SBAR(); \
        ATT_PV(1); mb_ = ATT_MX3(mb_, C0[6], C0[7]); ma_ = ATT_MX3(ma_, C1[4], C1[5]); mb_ = ATT_MX3(mb_, C1[6], C1[7]); ma_ = ATT_MX3(ma_, C0[8], C0[9]); ATT_PIN(ma_); ATT_PIN(mb_); ATT_VRD(1, 9); ATT_SBAR(); \
        ATT_PV(2); mb_ = ATT_MX3(mb_, C0[10], C0[11]); ma_ = ATT_MX3(ma_, C1[8], C1[9]); mb_ = ATT_MX3(mb_, C1[10], C1[11]); ma_ = ATT_MX3(ma_, C0[12], C0[13]); ATT_PIN(ma_); ATT_PIN(mb_); ATT_VRD(2, 10); ATT_SBAR(); \
        ATT_PV(3); mb_ = ATT_MX3(mb_, C0[14], C0[15]); ma_ = ATT_MX3(ma_, C1[12], C1[13]); mb_ = ATT_MX3(mb_, C1[14], C1[15]); ATT_VRD(3, 11); \
        float rm_ = __builtin_fmaxf(ma_, mb_); { auto rr_ = __builtin_amdgcn_permlane32_swap(__float_as_uint(rm_), __float_as_uint(rm_), false, false); rm_ = __builtin_fmaxf(__uint_as_float(rr_[0]), __uint_as_float(rr_[1])); } \
        const bool grow_ = __any(rm_ > (float)THR); \
        ATT_SBAR(); \
          \
        ATT_PV(4); ATT_VRD(4, 12); ATT_KRD(0); ATT_SBAR(); \
        ATT_PV(5); ATT_VRD(5, 13); ATT_KRD(1); ATT_SBAR(); \
        if (grow_) {                                                                    \
            const float dl_ = __builtin_fmaxf(rm_, 0.f); mhat += dl_; const float f_ = __builtin_amdgcn_exp2f(-dl_); l_reg *= f_; if (hi == 0) wsf[r32] = f_; resc = true; \
            _Pragma("unroll") for (int r = 0; r < 16; ++r) { C0[r] -= dl_; C1[r] -= dl_; negm[r] = -mhat; } asm volatile("" : "+v"(negm)); } \
        ATT_SBAR(); \
          \
        ATT_PV(6);  ATT_EXP1(C0, C1, 0);  ATT_EXP1(C0, C1, 1);  ATT_EXP1(C0, C1, 2);  ATT_PIN(C0); ATT_VRD(6, 14); ATT_KRD(2); ATT_SBAR(); \
        ATT_PV(7);  ATT_EXP1(C0, C1, 3);  ATT_EXP1(C0, C1, 4);  ATT_EXP1(C0, C1, 5);  ATT_PIN(C0); ATT_VRD(7, 15); ATT_KRD(3); ATT_SBAR(); \
        ATT_PV(8);  ATT_EXP1(C0, C1, 6);  ATT_EXP1(C0, C1, 7);  ATT_EXP1(C0, C1, 8);  ATT_PIN(C0); ATT_KRD(4); ATT_SBAR(); \
        ATT_PV(9);  ATT_EXP1(C0, C1, 9);  ATT_EXP1(C0, C1, 10); ATT_EXP1(C0, C1, 11); ATT_PIN(C0); ATT_KRD(5); ATT_SBAR(); \
        ATT_PV(10); ATT_EXP1(C0, C1, 12); ATT_EXP1(C0, C1, 13); ATT_EXP1(C0, C1, 14); ATT_PIN(C0); ATT_KRD(6); ATT_SBAR(); \
        ATT_PV(11); ATT_EXP1(C0, C1, 15); ATT_EXP1(C0, C1, 16); ATT_EXP1(C0, C1, 17); ATT_PIN(C0); ATT_PIN(C1); ATT_KRD(7); ATT_SBAR(); \
        ATT_PV(12); ATT_EXP1(C0, C1, 18); ATT_EXP1(C0, C1, 19); ATT_EXP1(C0, C1, 20); ATT_EXP1(C0, C1, 21); ATT_PIN(C1); ATT_SBAR(); \
        ATT_PV(13); ATT_EXP1(C0, C1, 22); ATT_EXP1(C0, C1, 23); ATT_EXP1(C0, C1, 24); ATT_EXP1(C0, C1, 25); ATT_PIN(C1); ATT_SBAR(); \
        ATT_PV(14); ATT_EXP1(C0, C1, 26); ATT_EXP1(C0, C1, 27); ATT_EXP1(C0, C1, 28); ATT_PIN(C1); ATT_SBAR(); \
        ATT_PV(15); ATT_EXP1(C0, C1, 29); ATT_EXP1(C0, C1, 30); ATT_EXP1(C0, C1, 31); ATT_PIN(C1); ATT_SBAR(); \
        if (resc) { LDS_WAIT(); \
            _Pragma("unroll") for (int r = 0; r < 16; ++r) { const float fr_ = wsf[crow(r, hi)]; _Pragma("unroll") for (int i = 0; i < 4; ++i) o[i][r] *= fr_; } } \
        if ((t) + 1 < NT) asm volatile("s_waitcnt vmcnt(2) lgkmcnt(0)\n\ts_barrier" ::: "memory"); else asm volatile("s_waitcnt vmcnt(0) lgkmcnt(0)\n\ts_barrier" ::: "memory"); \
        ATT_ROT(); \
    } while (0)
#pragma unroll 1
    for (int t = 1; t < NT; t += 2) {
        ATT_STEP(pB0, pB1, pA0, pA1, t);
        ATT_STEP(pA0, pA1, pB0, pB1, t + 1);
    }
    { float sacc = 0.f;
#pragma unroll
      for (int r = 0; r < 16; ++r) sacc += pA0[r] + pA1[r];
      l_reg += sacc;
      u32x4 pw[4];
      pw[0] = (u32x4){cvtpk(pA0[0], pA0[1]), cvtpk(pA0[2], pA0[3]), cvtpk(pA0[4], pA0[5]), cvtpk(pA0[6], pA0[7])};
      pw[1] = (u32x4){cvtpk(pA0[8], pA0[9]), cvtpk(pA0[10], pA0[11]), cvtpk(pA0[12], pA0[13]), cvtpk(pA0[14], pA0[15])};
      pw[2] = (u32x4){cvtpk(pA1[0], pA1[1]), cvtpk(pA1[2], pA1[3]), cvtpk(pA1[4], pA1[5]), cvtpk(pA1[6], pA1[7])};
      pw[3] = (u32x4){cvtpk(pA1[8], pA1[9]), cvtpk(pA1[10], pA1[11]), cvtpk(pA1[12], pA1[13]), cvtpk(pA1[14], pA1[15])};
      pv_tile(o, pw, vp0 + s_prev); }
    ATT_WAIT_BAR();
#undef ATT_STEP
#undef ATT_GAPA
#undef ATT_PV
#undef ATT_KRD
#undef ATT_EXP1
#undef ATT_VRD
#undef ATT_KLOAD
    { auto rr = __builtin_amdgcn_permlane32_swap(__float_as_uint(l_reg), __float_as_uint(l_reg), false, false); l_reg = __uint_as_float(rr[0]) + __uint_as_float(rr[1]); }
    if (hi == 0) wsf[32 + r32] = l_reg;
    LDS_WAIT();
    float rli[16];
#pragma unroll
    for (int r = 0; r < 16; ++r) rli[r] = 1.f / wsf[32 + crow(r, hi)];
    LAS float* stg = (LAS float*)lds;
    if (map == 1) {
#pragma unroll
        for (int r = 0; r < 16; ++r) { LAS float* sp = stg + (32 * rg + crow(r, hi)) * STG_PITCH + r32;
#pragma unroll
            for (int i = 0; i < 4; ++i) sp[32 * i] = o[i][r] * rli[r]; }
    }
    ATT_WAIT_BAR();
    if (map == 0) {
#pragma unroll
        for (int r = 0; r < 16; ++r) { LAS float* sp = stg + (32 * rg + crow(r, hi)) * STG_PITCH + r32;
#pragma unroll
            for (int i = 0; i < 4; ++i) sp[32 * i] = o[i][r] * rli[r] - lam * sp[32 * i]; }
    }
    ATT_WAIT_BAR();
    { int lane2 = F.lane; asm volatile("" : "+v"(lane2)); const int row = wid * 16 + (lane2 >> 2), c0 = (lane2 & 3) * 32;
      const LAS float* sp = stg + row * STG_PITCH + c0; f32x4 v[8]; float ss = 0.f;
#pragma unroll
      for (int i = 0; i < 8; ++i) { v[i] = *(const LAS f32x4*)(sp + 4 * i); ss += (v[i].x * v[i].x + v[i].y * v[i].y) + (v[i].z * v[i].z + v[i].w * v[i].w); }
      ss += __shfl_xor(ss, 1); ss += __shfl_xor(ss, 2);
      const float rs = 0.8f / sqrtf(ss * (1.f / 128.f) + EPS);
      bf16* ao = F.ACAT + (rowbase + (size_t)qb * 128 + row) * KC + PW + h * 128 + c0; const f32x4* sw = (const f32x4*)(F.sublnw + c0);
#pragma unroll
      for (int i = 0; i < 4; ++i) { const f32x4 a = v[2 * i] * rs * sw[2 * i], c = v[2 * i + 1] * rs * sw[2 * i + 1];
          u32x4 w; w.x = pk2(a.x, a.y); w.y = pk2(a.z, a.w); w.z = pk2(c.x, c.y); w.w = pk2(c.z, c.w); *(u32x4*)(ao + 8 * i) = w; } }
    ATT_WAIT_BAR();
#undef ATT_TROW
#undef ATT_DMA_K
#undef ATT_DMA_V
#undef ATT_ROT
#undef ATT_VFR
#undef ATT_PAF
#undef ATT_EX
}
__device__ __forceinline__ void attn_phase(const Frame& F) {
    const float lam = compute_lambda(F);
    for (int v = F.vcu; v < 256; v += F.G) {
        const int xg = v >> 5, j = v & 31;
#pragma unroll 1
        for (int r = 0; r < 4; ++r) {
            const int bh = 4 * xg + r, b = bh / NH, h = bh % NH, j2 = (j + 16) & 31;
            const int qb = (r == 0) ? j : (r == 1) ? 31 - j : (r == 2) ? j2 : 31 - j2;
            __syncthreads();
            int tid_ = F.wave * 64 + (int)__builtin_amdgcn_mbcnt_hi(~0u, __builtin_amdgcn_mbcnt_lo(~0u, 0u)); asm volatile("" : "+v"(tid_));
            if (tid_ < NBIAS) { const int d = min(max(tid_ - 128, -127), 91);
                ((LAS float*)(F.lds + LDS_BIAS))[tid_] = (F.btab[t5_bucket(-d) * NH + h] - F.btab[15 * NH + h]) * LOG2E; }
            __syncthreads();
            attn_unit(F, b, h, qb, lam);
        }
    }
}
}

__device__ __forceinline__ void final_norm_phase(Frame& F) {
    const int gw = F.vcu * NWAVES + F.wave, NGW = F.G * NWAVES;
    for (int m = gw; m < M; m += NGW) {
        f32x4* xr = (f32x4*)(F.out + (size_t)m * D) + F.lane; const f32x4* wr = (const f32x4*)F.finw + F.lane;
        f32x4 v[4]; float s = 0.f;
#pragma unroll
        for (int j = 0; j < 4; ++j) { v[j] = xr[64 * j]; s += (v[j].x * v[j].x + v[j].y * v[j].y) + (v[j].z * v[j].z + v[j].w * v[j].w); }
        const float rstd = 1.f / sqrtf(wave_sum(s) * (1.f / D) + EPS);
#pragma unroll
        for (int j = 0; j < 4; ++j) xr[64 * j] = v[j] * rstd * wr[64 * j];
    }
}

typedef GAS unsigned gu32;
typedef GAS unsigned long long gu64;
#define RLX_AGENT __ATOMIC_RELAXED, __HIP_MEMORY_SCOPE_AGENT
#define XB_TMO      128
#define XB_XCNT(j)  (256  + 64 * (j))
#define XB_XSUB(j)  (1280 + 64 * (j))
#define XB_XGEN(j)  (2304 + 64 * (j))
#define XB_TOP      3328
#define XB_TOPGEN   3392
#define XCD_BAR_WORDS 3456
#define XB_SPIN_CAP (1u << 18)

__device__ __forceinline__ unsigned xb_ld(unsigned* p)              { return __hip_atomic_load(p, __ATOMIC_RELAXED, __HIP_MEMORY_SCOPE_AGENT); }
__device__ __forceinline__ unsigned xb_add(unsigned* p, unsigned v) { return __hip_atomic_fetch_add(p, v, __ATOMIC_RELAXED, __HIP_MEMORY_SCOPE_AGENT); }
__device__ __forceinline__ unsigned xb_xcc_id() { return (unsigned)__builtin_amdgcn_s_getreg((3 << 11) | 20) & 0xFu; }
#define XB_SPIN(cond, bar) do { unsigned _sp = 0; while (cond) { __builtin_amdgcn_s_sleep(1); \
    if ((++_sp & 255u) == 0u) { if (xb_ld(&(bar)[XB_TMO])) break; if (_sp > XB_SPIN_CAP) { atomicAdd(&(bar)[XB_TMO], 1u); break; } } } } while (0)

struct XcdBarrier {
    unsigned* bar; unsigned x;
    volatile LAS unsigned* st;
};

__device__ __forceinline__ XcdBarrier xcd_barrier_post(unsigned* bar, volatile LAS unsigned* st) {
    XcdBarrier b; b.bar = bar; b.x = xb_xcc_id(); b.st = st;
    if (threadIdx.x == 0) (void)xb_add(&bar[XB_XCNT(b.x)], 1u);
    return b;
}
__device__ __forceinline__ void xcd_barrier_complete(unsigned* bar, unsigned x, unsigned& nloc, unsigned& nx) {
    const unsigned G = gridDim.x * gridDim.y * gridDim.z;
    unsigned sum, cnt, mine, sp = 0u;
    for (;;) {
        sum = 0u; cnt = 0u; mine = 0u;
#pragma unroll
        for (unsigned j = 0; j < 16; ++j) { const unsigned c = xb_ld(&bar[XB_XCNT(j)]); sum += c; cnt += (c > 0u) ? 1u : 0u; mine = (j == x) ? c : mine; }
        if (sum == G) break;
        __builtin_amdgcn_s_sleep(1);
        if ((++sp & 255u) == 0u) { if (xb_ld(&bar[XB_TMO])) break; if (sp > XB_SPIN_CAP) { atomicAdd(&bar[XB_TMO], 1u); break; } }
    }
    nloc = mine > 0u ? mine : 1u; nx = cnt > 0u ? cnt : 1u;
}

__device__ __forceinline__ void xcd_barrier(const XcdBarrier& b) {
    asm volatile("s_waitcnt vmcnt(0)" ::: "memory");
    __syncthreads();
    if (threadIdx.x == 0) {
        unsigned* bar = b.bar;
        __builtin_amdgcn_s_waitcnt(0);
        unsigned nloc = b.st[0], nx = b.st[1];
        if (nloc == 0u) { xcd_barrier_complete(bar, b.x, nloc, nx); b.st[0] = nloc; b.st[1] = nx; }
        const unsigned old = xb_add(&bar[XB_XSUB(b.x)], 1u);
        const unsigned gen = old / nloc;
        if (old + 1u == (gen + 1u) * nloc) {
            __builtin_amdgcn_fence(__ATOMIC_RELEASE, "agent");
            asm volatile("s_waitcnt vmcnt(0)" ::: "memory");
            const unsigned og = xb_add(&bar[XB_TOP], 1u);
            const unsigned tg = og / nx;
            if (og + 1u == (tg + 1u) * nx) xb_add(&bar[XB_TOPGEN], 1u);
            else XB_SPIN(xb_ld(&bar[XB_TOPGEN]) == tg, bar);
            __builtin_amdgcn_fence(__ATOMIC_ACQUIRE, "agent");
            xb_add(&bar[XB_XGEN(b.x)], 1u);
            asm volatile("s_waitcnt vmcnt(0)" ::: "memory");
        } else {
            XB_SPIN(xb_ld(&bar[XB_XGEN(b.x)]) == gen, bar);
            __builtin_amdgcn_fence(__ATOMIC_ACQUIRE, "agent");
            asm volatile("s_waitcnt vmcnt(0)" ::: "memory");
        }
    }
    __syncthreads();
}

struct Args { const float* in[20]; float* out; unsigned char* ws; int ph_lo, ph_hi; };
constexpr int NPHASE = 8;

__global__ void __launch_bounds__(NTHR, 2) mk_fwd(Args args) {
    extern __shared__ __attribute__((aligned(16))) unsigned char lds[];
    Frame F;
    F.lds = (LAS unsigned char*)lds;
    F.wave = __builtin_amdgcn_readfirstlane((int)threadIdx.x >> 6); F.lane = (int)__builtin_amdgcn_mbcnt_hi(~0u, __builtin_amdgcn_mbcnt_lo(~0u, 0u)); F.tid = F.wave * 64 + F.lane;
    F.G = gridDim.x; { const int bx = blockIdx.x; F.vcu = (F.G % 8 == 0) ? (bx % 8) * (F.G / 8) + bx / 8 : bx; }
    F.x = args.in[0]; F.meta = args.in[1]; F.btab = args.in[2]; F.mixw = args.in[3]; F.win = args.in[4]; F.pgw = args.in[5]; F.pscale = args.in[6];
    F.lq1 = args.in[7]; F.lk1 = args.in[8]; F.lq2 = args.in[9]; F.lk2 = args.in[10]; F.sublnw = args.in[11]; F.wpo = args.in[12]; F.wao = args.in[13];
    F.wo = args.in[14]; F.ffnw = args.in[15]; F.wg = args.in[16]; F.wu = args.in[17]; F.wd = args.in[18]; F.finw = args.in[19];
    F.out = args.out; F.ws = args.ws; unsigned char* ws = args.ws;
    F.Win_t = (bf16*)(ws + WS_WIN); F.Wcat_t = (bf16*)(ws + WS_WCAT); F.Wo_t = (bf16*)(ws + WS_WO); F.Wgu_t = (bf16*)(ws + WS_WGU); F.Wd_t = (bf16*)(ws + WS_WD);
    F.XN = (bf16*)(ws + WS_XN); F.UP = (bf16*)(ws + WS_UP); F.Kb = (bf16*)(ws + WS_K); F.Vb = (bf16*)(ws + WS_V); F.Qb = (bf16*)(ws + WS_Q); F.GP = (bf16*)(ws + WS_GP); F.GA = (bf16*)(ws + WS_GA);
    F.MERGED = (bf16*)(ws + WS_MERGED); F.HB = (bf16*)(ws + WS_HB); F.ACT = (bf16*)(ws + WS_ACT); F.PART = (float*)(ws + WS_PART); F.ACAT = (bf16*)args.out;
    const int lo = args.ph_lo, hi = args.ph_hi;
    for (int u = F.tid; u < (LDS_BYTES - RING_BYTES) / 4; u += NTHR) ((LAS unsigned*)(F.lds + RING_BYTES))[u] = 0u;
    __syncthreads();
    XcdBarrier bar; bar.bar = (unsigned*)(ws + WS_CTL) + CW_BAR; bar.x = 0; bar.st = nullptr;
    if (hi - lo > 1) bar = xcd_barrier_post((unsigned*)(ws + WS_CTL) + CW_BAR, (volatile LAS unsigned*)(F.lds + MISC_OFF) + 8);
#define IN(k) (lo <= (k) && (k) < hi)
#define SEAM(k) do { if (IN(k) && IN((k) + 1)) xcd_barrier(bar); } while (0)
    if (IN(0)) { p0_prologue(F); }
    SEAM(0);
    if (IN(1)) {
        pg8::Gemm g{F.XN, F.Win_t, MP, INC, D}; OrderP1 S; S.init(F.G, (int)blockIdx.x);
        Epi8P1 E{{F.UP, F.Qb, F.Kb, F.Vb, F.GP, F.GA}};
        pg8::gemm_phase<Epi8P1, OrderP1, true, true>(F.lds, g, S, E, F.wave, F.lane);
        deferred_weights(F, 0, (M / 256) * (INC / 256) + 10);
    }
    SEAM(1);
    if (IN(2)) { pool_phase(F); __syncthreads(); attn::attn_phase(F); }
    SEAM(2);
    if (IN(3)) {
        pg8::Gemm g{F.ACAT, F.Wcat_t, M, D, KC}; pg8::StaticOrder S; S.init(M, D, F.G, (int)blockIdx.x);
        EpiP3 E{F.GP, F.GA, F.MERGED}; pg8::gemm_phase<EpiP3, pg8::StaticOrder, true, true>(F.lds, g, S, E, F.wave, F.lane);
    }
    SEAM(3);
    if (IN(4)) {
        pg8::Gemm g{F.MERGED, F.Wo_t, M, D, D}; pg8::StaticOrder S; S.init(M, D, F.G, (int)blockIdx.x);
        Epi8P4 E{{F.x, F.HB}, F.PART}; pg8::gemm_phase<Epi8P4, pg8::StaticOrder, true, true>(F.lds, g, S, E, F.wave, F.lane);
    }
    SEAM(4);
    if (IN(5)) {
        pg8::Gemm g{F.HB, F.Wgu_t, M, 2 * FF, D}; pg8::StaticOrder S; S.init(M, 2 * FF, F.G, (int)blockIdx.x);
        Epi8P5 E{{F.ACT}, F.PART}; pg8::gemm_phase<Epi8P5, pg8::StaticOrder, true, true>(F.lds, g, S, E, F.wave, F.lane);
        deferred_weights(F, 1, (M / 256) * (2 * FF / 256));
    }
    SEAM(5);
    if (IN(6)) {
        pg8::Gemm g{F.ACT, F.Wd_t, M, D, FF}; pg8::StaticOrder S; S.init(M, D, F.G, (int)blockIdx.x);
        if (F.G == 256) { EpiFinal E{F.HB, F.out, F.finw, (unsigned*)(ws + WS_XSLOT), (unsigned*)(ws + WS_CTL) + CW_CNT}; pg8::gemm_phase<EpiFinal, pg8::StaticOrder, false, true>(F.lds, g, S, E, F.wave, F.lane); }
        else { Epi8<EpiP6> E{{F.HB, F.out}}; pg8::gemm_phase<Epi8<EpiP6>, pg8::StaticOrder, true, true>(F.lds, g, S, E, F.wave, F.lane); }
    }
    if (F.G != 256) { SEAM(6); if (IN(7)) final_norm_phase(F); }
#undef IN
#undef SEAM
}

extern "C" void kernel_launch(void* const* d_in, const int* in_sizes, int n_in, void* d_out, int out_size, void* d_ws, size_t ws_size, hipStream_t stream) {
    static int grid = 0;
    if (grid == 0) {
        if (n_in != 20 || out_size != M * D || ws_size < WS_END) { fprintf(stderr, "kernel_launch: unexpected shapes (n_in %d out %d ws %zu)\n", n_in, out_size, ws_size); grid = -1; return; }
        int dev = 0, cus = 0, per_cu = 0;
        if (hipGetDevice(&dev) != hipSuccess || hipDeviceGetAttribute(&cus, hipDeviceAttributeMultiprocessorCount, dev) != hipSuccess) { grid = -1; return; }
        if (hipFuncSetAttribute((const void*)mk_fwd, hipFuncAttributeMaxDynamicSharedMemorySize, LDS_BYTES) != hipSuccess) { fprintf(stderr, "kernel_launch: hipFuncSetAttribute failed\n"); grid = -1; return; }
        if (hipOccupancyMaxActiveBlocksPerMultiprocessor(&per_cu, (const void*)mk_fwd, NTHR, LDS_BYTES) != hipSuccess || per_cu < 1) { fprintf(stderr, "kernel_launch: occupancy query says %d\n", per_cu); }
        (void)hipGetLastError();
        grid = cus;
    }
    if (grid < 0) return;
    (void)hipMemsetAsync((char*)d_ws + WS_CTL, 0, CTL_ZERO_BYTES, stream);
    Args a{};
    for (int i = 0; i < 20; ++i) a.in[i] = (const float*)d_in[i];
    a.out = (float*)d_out; a.ws = (unsigned char*)d_ws;
#ifdef PROBE_DUP
    if (true) { a.ph_lo = 0; a.ph_hi = PROBE_DUP + 1; hipLaunchKernelGGL(mk_fwd, dim3(grid), dim3(NTHR), LDS_BYTES, stream, a);
        (void)hipMemsetAsync((char*)d_ws + WS_CTL, 0, 65536, stream);
        a.ph_lo = PROBE_DUP; a.ph_hi = NPHASE; hipLaunchKernelGGL(mk_fwd, dim3(grid), dim3(NTHR), LDS_BYTES, stream, a); }
#else
    if (MK_N_LAUNCHES == 1) { a.ph_lo = 0; a.ph_hi = NPHASE; hipLaunchKernelGGL(mk_fwd, dim3(grid), dim3(NTHR), LDS_BYTES, stream, a); }
#endif
    else for (int p = 0; p < NPHASE; ++p) { a.ph_lo = p; a.ph_hi = p + 1; hipLaunchKernelGGL(mk_fwd, dim3(grid), dim3(NTHR), LDS_BYTES, stream, a); }
}
```

```cpp
#include <hip/hip_runtime.h>
#include <cstdio>
#include <cstdint>

#ifndef MK_N_LAUNCHES
#define MK_N_LAUNCHES 1
#endif

constexpr int BATCH = 4, SEQ = 4096, D = 1024, NMETA = 16, NH = 8, HD = 64, VD = 128;
constexpr int M = BATCH * SEQ;
constexpr int MP = M + 256;
constexpr int PW = 512, AW = 1024, FF = 2816, INC = 5632;
constexpr int KC = PW + AW;
constexpr float EPS = 1e-6f;
constexpr float LOG2E = 1.4426950408889634f;
constexpr float QSCALE = 0.125f * LOG2E;

typedef unsigned short bf16;
typedef float f32x4 __attribute__((ext_vector_type(4)));
typedef unsigned u32x4 __attribute__((ext_vector_type(4)));
typedef unsigned u32x2 __attribute__((ext_vector_type(2)));

constexpr size_t MiB = 1u << 20;
constexpr size_t WS_CTL = 0, CTL_ZERO_BYTES = 1 * MiB;
constexpr size_t WS_XSLOT = 512 * 1024;
constexpr int CW_CNT = 16384;
constexpr int CW_QUEUE = 2048;
constexpr int CW_BAR = 4096;
constexpr size_t WS_PART = 1 * MiB;
constexpr size_t WS_WIN = 2 * MiB;
constexpr size_t WS_WCAT = 13 * MiB;
constexpr size_t WS_WO = 16 * MiB;
constexpr size_t WS_WGU = 18 * MiB;
constexpr size_t WS_WD = 29 * MiB;
constexpr size_t WS_XN = 36 * MiB;
constexpr size_t WS_UP = WS_XN + (size_t)MP * D * 2;
constexpr size_t WS_K = WS_UP + (size_t)MP * PW * 2;
constexpr size_t WS_V = WS_K + (size_t)MP * AW * 2;
constexpr size_t WS_Q = WS_V + (size_t)MP * AW * 2;
constexpr size_t WS_GP = WS_Q + (size_t)M * AW * 2;
constexpr size_t WS_GA = WS_GP + (size_t)M * D * 2;
constexpr size_t WS_END = WS_GA + (size_t)M * D * 2;
constexpr size_t WS_MERGED = WS_Q, WS_HB = WS_GP;
constexpr size_t WS_ACT = WS_XN;
static_assert(WS_END <= 256 * MiB, "ws map");
static_assert(WS_ACT + (size_t)M * FF * 2 <= WS_Q, "ACT overlay must not reach MERGED / HB");

constexpr int RING_BYTES = 131072, MISC_OFF = RING_BYTES + 320, LDS_BYTES = 147456;
constexpr int NWAVES = 8, NTHR = 512;

#define GAS __attribute__((address_space(1)))
#define LAS __attribute__((address_space(3)))
#define LDS_WAIT() asm volatile("s_waitcnt lgkmcnt(0)" ::: "memory")
#define VM_WAIT() asm volatile("s_waitcnt vmcnt(0)" ::: "memory")

__device__ __forceinline__ unsigned f2bf(float f) { unsigned u = __builtin_bit_cast(unsigned, f); return (u + 0x7fffu + ((u >> 16) & 1u)) >> 16; }
typedef float f32x2_c __attribute__((ext_vector_type(2))); typedef __bf16 bf16x2_c __attribute__((ext_vector_type(2)));
__device__ __forceinline__ unsigned pk2(float lo, float hi) { f32x2_c v = {lo, hi}; bf16x2_c b = __builtin_convertvector(v, bf16x2_c); return __builtin_bit_cast(unsigned, b); }
__device__ __forceinline__ float bf2f(unsigned b) { return __builtin_bit_cast(float, b << 16); }
__device__ __forceinline__ float bflo(unsigned w) { return __builtin_bit_cast(float, w << 16); }
__device__ __forceinline__ float bfhi(unsigned w) { return __builtin_bit_cast(float, w & 0xffff0000u); }
__device__ __forceinline__ float wave_sum(float v) {
#pragma unroll
    for (int o = 1; o < 64; o <<= 1) v += __shfl_xor(v, o);
    return v;
}
__device__ __forceinline__ float sigmoidf_(float x) { return __builtin_amdgcn_rcpf(1.f + __builtin_amdgcn_exp2f(-LOG2E * x)); }

struct Frame {
    LAS unsigned char* lds;
    int tid, lane, wave, G, vcu;
    const float *x, *meta, *btab, *mixw, *win, *pgw, *pscale, *lq1, *lk1, *lq2, *lk2, *sublnw, *wpo, *wao, *wo, *ffnw, *wg, *wu, *wd, *finw;
    float* out;
    unsigned char* ws;
    bf16 *Win_t, *Wcat_t, *Wo_t, *Wgu_t, *Wd_t;
    bf16 *XN, *UP, *Kb, *Vb, *Qb, *GP, *GA, *MERGED, *HB, *ACT, *ACAT;
    float *PART;
};

struct TrDesc { const float* W; const float* kscale; bf16* WT; int K, N, mode, ldw, item; };
__device__ __forceinline__ void tr_load(const TrDesc& d, int lane, float (&v)[32]) {
    const int nblk = d.N / 32, kb = d.item / nblk, nb = d.item % nblk, k0 = 64 * kb, n0 = 32 * nb;
#pragma unroll
    for (int i = 0; i < 32; ++i) v[i] = __builtin_nontemporal_load(d.W + (size_t)(k0 + 2 * i + (lane >> 5)) * d.N + n0 + (lane & 31));
}
__device__ __forceinline__ void tr_to_lds(const TrDesc& d, int lane, float (&v)[32], LAS float* scr) {
    const int nblk = d.N / 32, kb = d.item / nblk, k0 = 64 * kb;
    if (d.kscale) {
#pragma unroll
        for (int i = 0; i < 32; ++i) v[i] *= d.kscale[k0 + 2 * i + (lane >> 5)]; }
#pragma unroll
    for (int i = 0; i < 32; ++i) scr[(2 * i + (lane >> 5)) * 33 + (lane & 31)] = v[i];
    LDS_WAIT(); asm volatile("" ::: "memory");
}
__device__ __forceinline__ void tr_store(const TrDesc& d, int lane, LAS float* scr) {
    const int nblk = d.N / 32, kb = d.item / nblk, nb = d.item % nblk, k0 = 64 * kb, n0 = 32 * nb;
    const int c = lane & 7;
    const int rbase = (d.mode == 0) ? n0 : ((n0 / 128) * 256 + (n0 % 128) + (d.mode == 2 ? 128 : 0));
#pragma unroll
    for (int j = 0; j < 4; ++j) { const int n = (lane >> 3) + 8 * j; const LAS float* s = scr + (8 * c) * 33 + n;
        u32x4 o; o.x = pk2(s[0 * 33], s[1 * 33]); o.y = pk2(s[2 * 33], s[3 * 33]); o.z = pk2(s[4 * 33], s[5 * 33]); o.w = pk2(s[6 * 33], s[7 * 33]);
        *(u32x4*)(d.WT + (size_t)(rbase + n) * d.ldw + k0 + 8 * c) = o; }
    LDS_WAIT(); asm volatile("" ::: "memory");
}
template <int NR> __device__ __forceinline__ void rms_rows_to_bf16(const float* const (&xrow)[NR], const float* w, bf16* const (&orow)[NR], int lane) {
    f32x4 v[NR][4]; float s[NR];
#pragma unroll
    for (int r = 0; r < NR; ++r) { const f32x4* xr = (const f32x4*)xrow[r] + lane;
#pragma unroll
        for (int j = 0; j < 4; ++j) v[r][j] = __builtin_nontemporal_load(xr + 64 * j); }
    const f32x4* wr = (const f32x4*)w + lane; f32x4 ww[4];
#pragma unroll
    for (int j = 0; j < 4; ++j) ww[j] = wr[64 * j];
#pragma unroll
    for (int r = 0; r < NR; ++r) { s[r] = 0.f;
#pragma unroll
        for (int j = 0; j < 4; ++j) s[r] += (v[r][j].x * v[r][j].x + v[r][j].y * v[r][j].y) + (v[r][j].z * v[r][j].z + v[r][j].w * v[r][j].w); }
#pragma unroll
    for (int r = 0; r < NR; ++r) { const float rstd = 1.f / sqrtf(wave_sum(s[r]) * (1.f / D) + EPS);
        unsigned long long* o8 = (unsigned long long*)orow[r] + lane;
#pragma unroll
        for (int j = 0; j < 4; ++j)
            o8[64 * j] = (unsigned long long)pk2(v[r][j].x * rstd * ww[j].x, v[r][j].y * rstd * ww[j].y) | ((unsigned long long)pk2(v[r][j].z * rstd * ww[j].z, v[r][j].w * rstd * ww[j].w) << 32); }
}
constexpr int I_IN = (D / 64) * (INC / 32), I_AO = (AW / 64) * (D / 32), I_O = (D / 64) * (D / 32), I_G = (D / 64) * (FF / 32), I_D = (FF / 64) * (D / 32);
constexpr int I_EFF = (PW / 4) * (D / 4) / 64;
__device__ __forceinline__ void weff_item(Frame& F, int o) {
    const int kb = o / (D / 4), n0 = (o % (D / 4)) * 4, k0 = kb * 4, g = k0 / 128;
    const float* gwr = F.pgw + (size_t)k0 * 128; const float* wr = F.wpo + (size_t)(g * 128) * D + n0; const float* sc = F.pscale + g * 128;
    f32x4 s0 = {0.f, 0.f, 0.f, 0.f}, s1 = s0, s2 = s0, s3 = s0;
#pragma unroll 16
    for (int d = 0; d < 128; ++d) { const f32x4 wv = *(const f32x4*)(wr + (size_t)d * D) * sc[d];
        s0 += wv * gwr[d]; s1 += wv * gwr[128 + d]; s2 += wv * gwr[256 + d]; s3 += wv * gwr[384 + d]; }
#pragma unroll
    for (int j = 0; j < 4; ++j) { u32x2 w; w.x = pk2(s0[j], s1[j]); w.y = pk2(s2[j], s3[j]); *(u32x2*)(F.Wcat_t + (size_t)(n0 + j) * KC + k0) = w; }
}
__device__ __forceinline__ TrDesc tr_desc(const Frame& F, int q, int r) {
    if (q == 2) return TrDesc{F.win, nullptr, F.Win_t, D, INC, 0, D, r};
    if (q == 1) return TrDesc{F.wd, nullptr, F.Wd_t, FF, D, 0, FF, r};
    if (r < I_AO) return TrDesc{F.wao, nullptr, F.Wcat_t + PW, AW, D, 0, KC, r};
    r -= I_AO; if (r < I_O) return TrDesc{F.wo, nullptr, F.Wo_t, D, D, 0, D, r};
    r -= I_O; if (r < I_G) return TrDesc{F.wg, F.ffnw, F.Wgu_t, D, FF, 1, D, r};
    r -= I_G; return TrDesc{F.wu, F.ffnw, F.Wgu_t, D, FF, 2, D, r};
}
__device__ __forceinline__ void tr_run(const Frame& F, int q, int first, int stride, int total, LAS float* scr) {
    if (first >= total) return;
    float va[32], vb[32];
    TrDesc da = tr_desc(F, q, first), db = da; tr_load(da, F.lane, va);
    for (int it = first; it < total; it += 2 * stride) {
        const bool hb = it + stride < total, ha = it + 2 * stride < total;
        tr_to_lds(da, F.lane, va, scr); if (hb) { db = tr_desc(F, q, it + stride); tr_load(db, F.lane, vb); } tr_store(da, F.lane, scr);
        if (!hb) break;
        tr_to_lds(db, F.lane, vb, scr); if (ha) { da = tr_desc(F, q, it + 2 * stride); tr_load(da, F.lane, va); } tr_store(db, F.lane, scr);
    }
}
__device__ __forceinline__ void p0_prologue(Frame& F) {
    LAS float* scr = (LAS float*)(F.lds + F.wave * 16384);
    const int gw = F.vcu * NWAVES + F.wave, NGW = F.G * NWAVES;
    tr_run(F, 2, gw, NGW, I_IN, scr);
    if (M % (NGW * 4) == 0) {
        const int rpw = M / NGW;
        for (int r0 = 0; r0 < rpw; r0 += 4) {
            const float* xr[4]; bf16* orw[4];
#pragma unroll
            for (int r = 0; r < 4; ++r) { const size_t m = (size_t)gw * rpw + r0 + r; xr[r] = F.x + m * D; orw[r] = F.XN + m * D; }
            rms_rows_to_bf16<4>(xr, F.mixw, orw, F.lane);
        }
    } else
    for (int gidx = gw; gidx < M / 4; gidx += NGW) {
        const float* xr[4]; bf16* orw[4];
#pragma unroll
        for (int r = 0; r < 4; ++r) { const size_t m = (size_t)gidx + (size_t)r * (M / 4); xr[r] = F.x + m * D; orw[r] = F.XN + m * D; }
        rms_rows_to_bf16<4>(xr, F.mixw, orw, F.lane);
    }
    for (int m = M + gw; m < MP; m += NGW) {
        if (m < M + NMETA) { const float* xr[1] = {F.meta + (size_t)(m - M) * D}; bf16* orw[1] = {F.XN + (size_t)m * D}; rms_rows_to_bf16<1>(xr, F.mixw, orw, F.lane); }
        else { unsigned long long* o8 = (unsigned long long*)(F.XN + (size_t)m * D) + F.lane;
#pragma unroll
            for (int j = 0; j < 4; ++j) o8[64 * j] = 0ull; }
    }
}
__device__ __forceinline__ void deferred_weights(Frame& F, int q, int ntiles) {
    LAS float* scr = (LAS float*)(F.lds + F.wave * 16384);
    const int busy = ntiles % F.G, c = (int)blockIdx.x;
    int rank, count; if (busy == 0) { rank = c; count = F.G; } else { if (c < busy) return; rank = c - busy; count = F.G - busy; }
    const int w0 = rank * NWAVES + F.wave, nw = count * NWAVES;
    if (q == 1) { tr_run(F, 1, w0, nw, I_D, scr); return; }
    constexpr int T0 = I_AO + I_O + 2 * I_G, QA = 2;
    if (nw > I_EFF && QA * I_EFF <= T0) {
        if (w0 < I_EFF) { tr_run(F, 0, QA * w0, 1, QA * w0 + QA, scr); weff_item(F, w0 * 64 + F.lane); }
        else tr_run(F, 0, QA * I_EFF + (w0 - I_EFF), nw - I_EFF, T0, scr);
    } else {
        tr_run(F, 0, w0, nw, T0, scr);
        for (int r = w0; r < I_EFF; r += nw) weff_item(F, r * 64 + F.lane);
    }
}

namespace pg8 {
#define PG8_LAS __attribute__((address_space(3)))
typedef unsigned short bf16_t;
typedef short bf16x8 __attribute__((ext_vector_type(8)));
typedef float f32x4 __attribute__((ext_vector_type(4)));
typedef unsigned u32x4 __attribute__((ext_vector_type(4)));
constexpr int BM = 256, BK = 64, HALF = 128, HTB = HALF * BK * 2  , STAGE_BYTES = 8 * HTB, NXCD = 8, WGM = 4;

__host__ __device__ __forceinline__ int lds_byte(int r, int c) { const int st = (r >> 4) * 2 + (c >> 5), rr = r & 15, cc = c & 31, ob = rr * 64 + cc * 2; return st * 1024 + (ob ^ (((ob >> 9) & 1) << 5)); }
__host__ __device__ __forceinline__ void stage_rc(int b, int& R, int& C) { const int st = b / 1024, sb = b % 1024, swz = sb ^ (((sb >> 9) & 1) << 5); R = (st >> 1) * 16 + swz / 64; C = (st & 1) * 32 + (swz % 64) / 2; }
__host__ __device__ __forceinline__ int perm32(int rho) { const int n = rho >> 4, i = rho & 15; return 8 * (i >> 2) + 4 * n + (i & 3); }

struct Unit { int pm, pn; };
struct Gemm { const bf16_t* A; const bf16_t* Bt; int M, N, K; };

struct StaticOrder {
    int nM, nN, nwg, G, c;
    __host__ __device__ void init(int M, int N, int G_, int c_) { nM = M / BM; nN = N / BM; nwg = nM * nN; G = G_; c = c_; }
    __host__ __device__ bool next(int i, Unit& u) const {
        const long L = (long)i * G + c; if (L >= nwg) return false;
        int wgid = (int)L; { const int q = nwg / NXCD, r = nwg % NXCD, xcd = wgid % NXCD, off = wgid / NXCD; wgid = (xcd < r ? xcd * (q + 1) : r * (q + 1) + (xcd - r) * q) + off; }
        const int nig = WGM * nN, gid = wgid / nig, fm = gid * WGM, gsz = (nM - fm) < WGM ? (nM - fm) : WGM;
        u.pm = fm + ((wgid % nig) % gsz); u.pn = (wgid % nig) / gsz; return true;
    }
    __device__ __forceinline__ void a_ready(const Unit&) const {}
    __device__ __forceinline__ void done(const Unit&) const {}
};

__device__ __forceinline__ unsigned cvt_pk_bf16(float lo, float hi) { unsigned r; asm volatile("v_cvt_pk_bf16_f32 %0, %1, %2" : "=v"(r) : "v"(lo), "v"(hi)); return r; }
template <class E, class = void> struct MidT { static constexpr int v = -1; };
template <class E> struct MidT<E, decltype((void)E::MID_T)> { static constexpr int v = E::MID_T; };
template <class Epi, class Sched, bool ALIGN_EPI = false, bool SP2 = false>
__device__ __forceinline__ void gemm_phase(PG8_LAS unsigned char* lds, const Gemm g, const Sched& S, const Epi& E, const int wid, const int lane) {
    const int tid = wid * 64 + lane, wr = wid >> 2, wc = wid & 3, fr = lane & 15, fq = lane >> 4;
    const int K = g.K, nt = K / BK;
    unsigned voffA[2], voffB[2];
#pragma unroll
    for (int i = 0; i < 2; ++i) { int R, C; stage_rc(tid * 16 + i * 8192, R, C); const int Rb = Epi::PERM ? ((R & ~31) + perm32(R & 31)) : R;
        voffA[i] = (unsigned)(R * K + C) * 2u; voffB[i] = (unsigned)(Rb * K + C) * 2u; }
    const size_t kstep = (size_t)(BK * 2);
    const size_t hstep = (size_t)HALF * K * 2;
    const size_t tstep = 2 * hstep;
    const unsigned ldsw = (unsigned)wid * 1024u;
    const int aoff = lds_byte(wr * 64 + fr, fq * 8), boff = lds_byte(wc * 32 + fr, fq * 8);
#define PG8_SA(b, h) (((b) * 2 + (h)) * HTB)
#define PG8_SB(b, h) ((4 + (b) * 2 + (h)) * HTB)
#define PG8_STAGE(bufoff, gbase, voff) do { _Pragma("unroll") for (int _i = 0; _i < 2; ++_i) \
        __builtin_amdgcn_global_load_lds((const unsigned*)((const char*)(gbase) + (voff)[_i]), (PG8_LAS unsigned*)(lds + (bufoff) + ldsw + _i * 8192), 16, 0, 0); } while (0)
#define PG8_LDA(dst, b, h) do { _Pragma("unroll") for (int m = 0; m < 4; ++m) _Pragma("unroll") for (int k = 0; k < 2; ++k) dst[m][k] = *(const PG8_LAS bf16x8*)(lds + PG8_SA(b, h) + aoff + m * 2048 + k * 1024); } while (0)
#define PG8_LDB(dst, b, h) do { _Pragma("unroll") for (int n = 0; n < 2; ++n) _Pragma("unroll") for (int k = 0; k < 2; ++k) dst[n][k] = *(const PG8_LAS bf16x8*)(lds + PG8_SB(b, h) + boff + n * 2048 + k * 1024); } while (0)
#define PG8_MMA(ai, bj, At, Bt) do { __builtin_amdgcn_s_setprio(1); _Pragma("unroll") for (int m = 0; m < 4; ++m) _Pragma("unroll") for (int n = 0; n < 2; ++n) _Pragma("unroll") for (int k = 0; k < 2; ++k) \
        acc[ai][bj][m][n] = __builtin_amdgcn_mfma_f32_16x16x32_bf16(Bt[n][k], At[m][k], acc[ai][bj][m][n], 0, 0, 0); __builtin_amdgcn_s_setprio(0); } while (0)
#define PG8_WAIT_V(n) asm volatile("s_waitcnt vmcnt(" #n ")" ::: "memory")
#define PG8_WAIT_L(n) asm volatile("s_waitcnt lgkmcnt(" #n ")" ::: "memory")
#define PG8_BAR __builtin_amdgcn_s_barrier()
#define PG8_SCHED __builtin_amdgcn_sched_barrier(0)
    Unit cur, nxt; int ui = 0;
    if (!S.next(0, cur)) return;
    f32x4 acc[2][2][4][2];
#pragma unroll
    for (int a = 0; a < 2; ++a)
#pragma unroll
        for (int b = 0; b < 2; ++b)
#pragma unroll
            for (int m = 0; m < 4; ++m)
#pragma unroll
                for (int n = 0; n < 2; ++n) acc[a][b][m][n] = (f32x4){0.f, 0.f, 0.f, 0.f};
    bf16x8 At[4][2], B0[2][2], B1[2][2];
    const char* cA = (const char*)g.A + (size_t)cur.pm * tstep; const char* cB = (const char*)g.Bt + (size_t)cur.pn * tstep;
    S.a_ready(cur);
    if constexpr (SP2) {
        PG8_STAGE(PG8_SB(0, 0), cB, voffB); PG8_STAGE(PG8_SB(0, 1), cB + hstep, voffB); PG8_STAGE(PG8_SA(0, 0), cA, voffA); PG8_STAGE(PG8_SA(0, 1), cA + hstep, voffA);
        if (wr == 1) PG8_BAR;
        PG8_WAIT_V(2); PG8_BAR;
        PG8_STAGE(PG8_SB(1, 0), cB + kstep, voffB); PG8_STAGE(PG8_SA(1, 0), cA + kstep, voffA); PG8_STAGE(PG8_SB(1, 1), cB + hstep + kstep, voffB);
        PG8_WAIT_V(6); PG8_BAR;
    } else {
        PG8_STAGE(PG8_SB(0, 0), cB, voffB); PG8_STAGE(PG8_SA(0, 0), cA, voffA); PG8_STAGE(PG8_SB(0, 1), cB + hstep, voffB); PG8_STAGE(PG8_SA(0, 1), cA + hstep, voffA);
        if (wr == 1) PG8_BAR;
        PG8_WAIT_V(4); PG8_BAR;
        PG8_STAGE(PG8_SB(1, 0), cB + kstep, voffB); PG8_STAGE(PG8_SA(1, 0), cA + kstep, voffA); PG8_STAGE(PG8_SB(1, 1), cB + hstep + kstep, voffB);
        PG8_WAIT_V(6); PG8_BAR;
    }
    for (;;) {
        const bool has_next = S.next(ui + 1, nxt);
        const char* nA = has_next ? (const char*)g.A + (size_t)nxt.pm * tstep : cA; const char* nB = has_next ? (const char*)g.Bt + (size_t)nxt.pn * tstep : cB;
        for (int t = 0; t < nt; t += 2) {
            if constexpr (MidT<Epi>::v >= 0) { if (t == MidT<Epi>::v) { PG8_SCHED; E.mid(acc, cur, wr, wc, fr, fq); PG8_SCHED; } }
            const bool last = (t == nt - 2);
            const char* a1 = cA + (size_t)(t + 1) * kstep;
            const char* a2 = last ? nA : cA + (size_t)(t + 2) * kstep; const char* b2 = last ? nB : cB + (size_t)(t + 2) * kstep;
            const char* a3 = a2 + kstep; const char* b3 = b2 + kstep;
            if (last && has_next) S.a_ready(nxt);
            if constexpr (SP2) {
            PG8_LDB(B0, 0, 0); PG8_LDB(B1, 0, 1); PG8_SCHED; PG8_LDA(At, 0, 0); PG8_STAGE(PG8_SA(1, 1), a1 + hstep, voffA);
            PG8_WAIT_V(8); PG8_WAIT_L(0); PG8_BAR; PG8_MMA(0, 0, At, B0); PG8_MMA(0, 1, At, B1); PG8_BAR; PG8_SCHED;
            PG8_LDA(At, 0, 1); PG8_STAGE(PG8_SB(0, 0), b2, voffB); PG8_STAGE(PG8_SB(0, 1), b2 + hstep, voffB); PG8_STAGE(PG8_SA(0, 0), a2, voffA);
            PG8_WAIT_V(8); PG8_WAIT_L(0); PG8_BAR; PG8_MMA(1, 0, At, B0); PG8_MMA(1, 1, At, B1); PG8_BAR; PG8_SCHED;
            PG8_LDB(B0, 1, 0); PG8_LDB(B1, 1, 1); PG8_SCHED; PG8_LDA(At, 1, 0); PG8_STAGE(PG8_SA(0, 1), a2 + hstep, voffA);
            PG8_WAIT_V(8); PG8_WAIT_L(0); PG8_BAR; PG8_MMA(0, 0, At, B0); PG8_MMA(0, 1, At, B1); PG8_BAR; PG8_SCHED;
            PG8_LDA(At, 1, 1); PG8_STAGE(PG8_SB(1, 0), b3, voffB); PG8_STAGE(PG8_SB(1, 1), b3 + hstep, voffB); PG8_STAGE(PG8_SA(1, 0), a3, voffA);
            PG8_WAIT_V(8); PG8_WAIT_L(0); PG8_BAR; PG8_MMA(1, 0, At, B0); PG8_MMA(1, 1, At, B1); PG8_BAR; PG8_SCHED;
            } else {
            PG8_LDB(B0, 0, 0); PG8_SCHED; PG8_LDA(At, 0, 0); PG8_STAGE(PG8_SA(1, 1), a1 + hstep, voffA);
            PG8_WAIT_L(8); PG8_BAR; PG8_WAIT_L(0); PG8_MMA(0, 0, At, B0); PG8_BAR; PG8_SCHED;
            PG8_LDB(B1, 0, 1); PG8_STAGE(PG8_SB(0, 0), b2, voffB);
            PG8_BAR; PG8_WAIT_L(0); PG8_MMA(0, 1, At, B1); PG8_BAR;
            PG8_LDA(At, 0, 1); PG8_STAGE(PG8_SA(0, 0), a2, voffA);
            PG8_BAR; PG8_WAIT_L(0); PG8_MMA(1, 0, At, B0); PG8_BAR; PG8_SCHED;
            PG8_STAGE(PG8_SB(0, 1), b2 + hstep, voffB);
            PG8_WAIT_V(6); PG8_BAR; PG8_MMA(1, 1, At, B1); PG8_BAR;
            PG8_LDB(B0, 1, 0); PG8_SCHED; PG8_LDA(At, 1, 0); PG8_STAGE(PG8_SA(0, 1), a2 + hstep, voffA);
            PG8_WAIT_L(8); PG8_BAR; PG8_WAIT_L(0); PG8_MMA(0, 0, At, B0); PG8_BAR; PG8_SCHED;
            PG8_LDB(B1, 1, 1); PG8_STAGE(PG8_SB(1, 0), b3, voffB);
            PG8_BAR; PG8_WAIT_L(0); PG8_MMA(0, 1, At, B1); PG8_BAR;
            PG8_LDA(At, 1, 1); PG8_STAGE(PG8_SA(1, 0), a3, voffA);
            PG8_BAR; PG8_WAIT_L(0); PG8_MMA(1, 0, At, B0); PG8_BAR; PG8_SCHED;
            PG8_STAGE(PG8_SB(1, 1), b3 + hstep, voffB);
            PG8_WAIT_V(6); PG8_BAR; PG8_MMA(1, 1, At, B1); PG8_BAR;
            }
        }
        if constexpr (ALIGN_EPI) { if (wr == 0) PG8_BAR; }
        if constexpr (!Epi::AFTER_DRAIN) { E(acc, cur, wr, wc, fr, fq); S.done(cur); }
        if (!has_next) break;
#pragma unroll
        for (int a = 0; a < 2; ++a)
#pragma unroll
            for (int b = 0; b < 2; ++b)
#pragma unroll
                for (int m = 0; m < 4; ++m)
#pragma unroll
                    for (int n = 0; n < 2; ++n) acc[a][b][m][n] = (f32x4){0.f, 0.f, 0.f, 0.f};
        cur = nxt; cA = nA; cB = nB; ++ui;
        if constexpr (ALIGN_EPI) { if (wr == 1) PG8_BAR; }
    }
    PG8_WAIT_V(0);
    if constexpr (!ALIGN_EPI) { if (wr == 0) PG8_BAR; }
    PG8_BAR;
    if constexpr (Epi::AFTER_DRAIN) { E.fused(acc, cur, wr, wc, fr, fq, lds, wid, lane); S.done(cur); }
#undef PG8_SA
#undef PG8_SB
#undef PG8_STAGE
#undef PG8_LDA
#undef PG8_LDB
#undef PG8_MMA
#undef PG8_WAIT_V
#undef PG8_WAIT_L
#undef PG8_BAR
#undef PG8_SCHED
}
}

struct EpiP1 {
    bf16 *UP, *Qb, *Kb, *Vb, *GP, *GA;
    __device__ __forceinline__ void store8(int row, int col, f32x4 a, f32x4 b) const {
        bf16* dst; int c;
        if (col < 512) { dst = UP + (size_t)row * PW; c = col; }
        else if (col < 1536) { if (row >= M) return; dst = Qb + (size_t)row * AW; c = col - 512; a = a * QSCALE; b = b * QSCALE; }
        else if (col < 2560) { dst = Kb + (size_t)row * AW; c = col - 1536; }
        else if (col < 3584) { dst = Vb + (size_t)row * AW; c = col - 2560; }
        else { if (row >= M) return; const bool ga = col >= 4608; dst = (ga ? GA : GP) + (size_t)row * D; c = col - (ga ? 4608 : 3584);
#pragma unroll
            for (int i = 0; i < 4; ++i) { a[i] = sigmoidf_(a[i]); b[i] = sigmoidf_(b[i]); } }
        u32x4 w; w.x = pk2(a[0], a[1]); w.y = pk2(a[2], a[3]); w.z = pk2(b[0], b[1]); w.w = pk2(b[2], b[3]);
        *(u32x4*)(dst + c) = w;
    }
};
struct EpiP3 {
    static constexpr bool PERM = true, AFTER_DRAIN = false; static constexpr int MID_T = PW / 64;
    const bf16 *GP, *GA; bf16* MERGED;
    __device__ __forceinline__ static float gsafe(float g) { return __builtin_fmaxf(g, 8.6736174e-19f); }
    __device__ __forceinline__ void mid(f32x4 (&acc)[2][2][4][2], const pg8::Unit& u, int wr, int wc, int fr, int fq) const {
        asm volatile("" : "+v"(fr), "+v"(fq));
        const int row0 = u.pm * 256 + wr * 64 + fr, col0 = u.pn * 256 + wc * 32 + 8 * fq;
#pragma unroll
        for (int ai = 0; ai < 2; ++ai)
#pragma unroll
            for (int m = 0; m < 4; ++m) { const size_t ro = (size_t)(row0 + ai * 128 + m * 16) * D + col0;
#pragma unroll
                for (int bj = 0; bj < 2; ++bj) { const u32x4 p = *(const u32x4*)(GP + ro + bj * 128), a = *(const u32x4*)(GA + ro + bj * 128);
                    f32x4& x = acc[ai][bj][m][0]; f32x4& y = acc[ai][bj][m][1];
                    x[0] *= bflo(p.x) * __builtin_amdgcn_rcpf(gsafe(bflo(a.x))); x[1] *= bfhi(p.x) * __builtin_amdgcn_rcpf(gsafe(bfhi(a.x)));
                    x[2] *= bflo(p.y) * __builtin_amdgcn_rcpf(gsafe(bflo(a.y))); x[3] *= bfhi(p.y) * __builtin_amdgcn_rcpf(gsafe(bfhi(a.y)));
                    y[0] *= bflo(p.z) * __builtin_amdgcn_rcpf(gsafe(bflo(a.z))); y[1] *= bfhi(p.z) * __builtin_amdgcn_rcpf(gsafe(bfhi(a.z)));
                    y[2] *= bflo(p.w) * __builtin_amdgcn_rcpf(gsafe(bflo(a.w))); y[3] *= bfhi(p.w) * __builtin_amdgcn_rcpf(gsafe(bfhi(a.w))); }
                asm volatile("" : "+v"(acc[ai][0][m][0]), "+v"(acc[ai][0][m][1]), "+v"(acc[ai][1][m][0]), "+v"(acc[ai][1][m][1]));
                asm volatile("" ::: "memory"); }
    }
    __device__ __forceinline__ void operator()(const f32x4 (&acc)[2][2][4][2], const pg8::Unit& u, int wr, int wc, int fr, int fq) const {
        const int row0 = u.pm * 256 + wr * 64 + fr, col0 = u.pn * 256 + wc * 32 + 8 * fq;
#pragma unroll
        for (int ai = 0; ai < 2; ++ai)
#pragma unroll
            for (int m = 0; m < 4; ++m) { const size_t ro = (size_t)(row0 + ai * 128 + m * 16) * D + col0;
#pragma unroll
                for (int bj = 0; bj < 2; ++bj) { const u32x4 a = *(const u32x4*)(GA + ro + bj * 128); const f32x4 x = acc[ai][bj][m][0], y = acc[ai][bj][m][1];
                    u32x4 w; w.x = pk2(x[0] * gsafe(bflo(a.x)), x[1] * gsafe(bfhi(a.x))); w.y = pk2(x[2] * gsafe(bflo(a.y)), x[3] * gsafe(bfhi(a.y)));
                    w.z = pk2(y[0] * gsafe(bflo(a.z)), y[1] * gsafe(bfhi(a.z))); w.w = pk2(y[2] * gsafe(bflo(a.w)), y[3] * gsafe(bfhi(a.w)));
                    *(u32x4*)(MERGED + ro + bj * 128) = w; } }
    }
};
struct EpiP4 {
    const float* x; bf16* HB;
    __device__ __forceinline__ float store8(int row, int col, f32x4 a, f32x4 b) const {
        const float* xr = x + (size_t)row * D + col; a = a + __builtin_nontemporal_load((const f32x4*)xr); b = b + __builtin_nontemporal_load((const f32x4*)(xr + 4));
        u32x4 w; w.x = pk2(a[0], a[1]); w.y = pk2(a[2], a[3]); w.z = pk2(b[0], b[1]); w.w = pk2(b[2], b[3]);
        *(u32x4*)(HB + (size_t)row * D + col) = w;
        return (a[0] * a[0] + a[1] * a[1]) + (a[2] * a[2] + a[3] * a[3]) + (b[0] * b[0] + b[1] * b[1]) + (b[2] * b[2] + b[3] * b[3]);
    }
};
struct EpiP5 {
    bf16* ACT;
    __device__ __forceinline__ void store8(int row, int ocol, float rstd, f32x4 g0, f32x4 g1, f32x4 u0, f32x4 u1) const {
        float r[8];
#pragma unroll
        for (int i = 0; i < 4; ++i) { const float ga = g0[i] * rstd, gb = g1[i] * rstd; r[i] = ga * sigmoidf_(ga) * (u0[i] * rstd); r[4 + i] = gb * sigmoidf_(gb) * (u1[i] * rstd); }
        u32x4 w; w.x = pk2(r[0], r[1]); w.y = pk2(r[2], r[3]); w.z = pk2(r[4], r[5]); w.w = pk2(r[6], r[7]);
        *(u32x4*)(ACT + (size_t)row * FF + ocol) = w;
    }
};
struct EpiP6 {
    const bf16* HB; float* H;
    __device__ __forceinline__ void store8(int row, int col, f32x4 a, f32x4 b) const {
        const u32x4 h = *(const u32x4*)(HB + (size_t)row * D + col); float* o = H + (size_t)row * D + col;
        a[0] += bflo(h.x); a[1] += bfhi(h.x); a[2] += bflo(h.y); a[3] += bfhi(h.y); b[0] += bflo(h.z); b[1] += bfhi(h.z); b[2] += bflo(h.w); b[3] += bfhi(h.w);
        *(f32x4*)o = a; *(f32x4*)(o + 4) = b;
    }
};

template <class Fn> struct Epi8 {
    static constexpr bool PERM = true, AFTER_DRAIN = false; Fn f;
    __device__ __forceinline__ void operator()(const f32x4 (&acc)[2][2][4][2], const pg8::Unit& u, int wr, int wc, int fr, int fq) const {
        const int row0 = u.pm * 256 + wr * 64 + fr, col0 = u.pn * 256 + wc * 32 + 8 * fq;
#pragma unroll
        for (int ai = 0; ai < 2; ++ai)
#pragma unroll
            for (int m = 0; m < 4; ++m) { const int row = row0 + ai * 128 + m * 16;
#pragma unroll
                for (int bj = 0; bj < 2; ++bj) f.store8(row, col0 + bj * 128, acc[ai][bj][m][0], acc[ai][bj][m][1]); }
    }
};
struct Epi8P1 {
    static constexpr bool PERM = true, AFTER_DRAIN = false; EpiP1 f;
    template <int CLS> __device__ __forceinline__ void half(const f32x4 (&acc)[2][2][4][2], int bj, int row0, int cb) const {
        bf16* base = CLS == 0 ? f.UP : CLS == 1 ? f.Qb : CLS == 2 ? f.Kb : CLS == 3 ? f.Vb : CLS == 4 ? f.GP : f.GA;
        constexpr int ldc = CLS == 0 ? PW : (CLS >= 4 ? D : AW);
#pragma unroll
        for (int ai = 0; ai < 2; ++ai)
#pragma unroll
            for (int m = 0; m < 4; ++m) { const int row = row0 + ai * 128 + m * 16; f32x4 a = bj ? acc[ai][1][m][0] : acc[ai][0][m][0], b = bj ? acc[ai][1][m][1] : acc[ai][0][m][1];
                if (CLS == 1) { a = a * QSCALE; b = b * QSCALE; }
                if (CLS >= 4) {
#pragma unroll
                    for (int i = 0; i < 4; ++i) { a[i] = sigmoidf_(a[i]); b[i] = sigmoidf_(b[i]); } }
                u32x4 w; w.x = pk2(a[0], a[1]); w.y = pk2(a[2], a[3]); w.z = pk2(b[0], b[1]); w.w = pk2(b[2], b[3]);
                *(u32x4*)(base + (size_t)row * ldc + cb) = w; }
    }
    __device__ __forceinline__ void operator()(const f32x4 (&acc)[2][2][4][2], const pg8::Unit& u, int wr, int wc, int fr, int fq) const {
        asm volatile("" : "+v"(fr), "+v"(fq));
        const int row0 = u.pm * 256 + wr * 64 + fr, lc = wc * 32 + 8 * fq;
        const bool meta_panel = u.pm >= M / 256;
#pragma unroll
        for (int bj = 0; bj < 2; ++bj) {
            const int colt = u.pn * 256 + bj * 128;
            if (colt < 512) half<0>(acc, bj, row0, colt + lc);
            else if (colt < 1536) { if (!meta_panel) half<1>(acc, bj, row0, colt - 512 + lc); }
            else if (colt < 2560) half<2>(acc, bj, row0, colt - 1536 + lc);
            else if (colt < 3584) half<3>(acc, bj, row0, colt - 2560 + lc);
            else if (colt < 4608) { if (!meta_panel) half<4>(acc, bj, row0, colt - 3584 + lc); }
            else { if (!meta_panel) half<5>(acc, bj, row0, colt - 4608 + lc); }
        }
    }
};
struct Epi8P4 {
    static constexpr bool PERM = true, AFTER_DRAIN = false; EpiP4 f; float* PART;
    __device__ __forceinline__ void operator()(const f32x4 (&acc)[2][2][4][2], const pg8::Unit& u, int wr, int wc, int fr, int fq) const {
        const int row0 = u.pm * 256 + wr * 64 + fr, col0 = u.pn * 256 + wc * 32 + 8 * fq;
#pragma unroll
        for (int ai = 0; ai < 2; ++ai)
#pragma unroll
            for (int m = 0; m < 4; ++m) { const int row = row0 + ai * 128 + m * 16;
                float s = f.store8(row, col0, acc[ai][0][m][0], acc[ai][0][m][1]) + f.store8(row, col0 + 128, acc[ai][1][m][0], acc[ai][1][m][1]);
                s += __shfl_xor(s, 16); s += __shfl_xor(s, 32);
                if (fq == 0) PART[(size_t)row * 16 + u.pn * 4 + wc] = s; }
    }
};
struct Epi8P5 {
    static constexpr bool PERM = true, AFTER_DRAIN = false; EpiP5 f; const float* PART;
    __device__ __forceinline__ void operator()(const f32x4 (&acc)[2][2][4][2], const pg8::Unit& u, int wr, int wc, int fr, int fq) const {
        const int row0 = u.pm * 256 + wr * 64 + fr, ocol = u.pn * 128 + wc * 32 + 8 * fq;
#pragma unroll
        for (int ai = 0; ai < 2; ++ai)
#pragma unroll
            for (int m = 0; m < 4; ++m) { const int row = row0 + ai * 128 + m * 16;
                const f32x4 p = *(const f32x4*)(PART + (size_t)row * 16 + 4 * fq); float s = (p.x + p.y) + (p.z + p.w);
                s += __shfl_xor(s, 16); s += __shfl_xor(s, 32);
                const float rstd = __builtin_amdgcn_rsqf(s * (1.f / D) + EPS);
                f.store8(row, ocol, rstd, acc[ai][0][m][0], acc[ai][0][m][1], acc[ai][1][m][0], acc[ai][1][m][1]); }
    }
};
struct EpiFinal {
    static constexpr bool PERM = true, AFTER_DRAIN = true;
    const bf16* HB; float* H; const float* finw; unsigned* xbuf; unsigned* cnt;
    __device__ __forceinline__ void fused(f32x4 (&acc)[2][2][4][2], const pg8::Unit& u, int wr, int wc, int fr, int fq, LAS unsigned char* lds, int wid, int lane) const {
        LAS float* P = (LAS float*)lds;
        LAS float* S = (LAS float*)(lds + 4096);
        const int row0 = u.pm * 256 + wr * 64 + fr, col0 = u.pn * 256 + wc * 32 + 8 * fq;
#pragma unroll
        for (int ai = 0; ai < 2; ++ai)
#pragma unroll
            for (int m = 0; m < 4; ++m) { const int row = row0 + ai * 128 + m * 16; float s = 0.f;
#pragma unroll
                for (int bj = 0; bj < 2; ++bj) { const u32x4 h = *(const u32x4*)(HB + (size_t)row * D + col0 + bj * 128);
                    const f32x4 a = acc[ai][bj][m][0] + (f32x4){bflo(h.x), bfhi(h.x), bflo(h.y), bfhi(h.y)}, b = acc[ai][bj][m][1] + (f32x4){bflo(h.z), bfhi(h.z), bflo(h.w), bfhi(h.w)}; acc[ai][bj][m][0] = a; acc[ai][bj][m][1] = b;
                    s += (a[0] * a[0] + a[1] * a[1]) + (a[2] * a[2] + a[3] * a[3]) + (b[0] * b[0] + b[1] * b[1]) + (b[2] * b[2] + b[3] * b[3]); }
                s += __shfl_xor(s, 16); s += __shfl_xor(s, 32);
                if (fq == 0) P[(ai * 128 + wr * 64 + m * 16 + fr) * 4 + wc] = s;
                if (m & 1) asm volatile("" ::: "memory"); }
        asm volatile("s_waitcnt lgkmcnt(0)" ::: "memory"); __builtin_amdgcn_s_barrier(); asm volatile("" ::: "memory");
        const int row = wid * 32 + (lane & 31);
        if (lane < 32) { const f32x4 p = *(const LAS f32x4*)(P + row * 4); const float t = (p.x + p.y) + (p.z + p.w);
            __hip_atomic_store(xbuf + ((size_t)(u.pm * 256 + row) * 4 + u.pn), __float_as_uint(t), __ATOMIC_RELAXED, __HIP_MEMORY_SCOPE_AGENT); }
        asm volatile("s_waitcnt vmcnt(0)" ::: "memory");
        if (lane == 0) __hip_atomic_fetch_add(cnt + 64 * u.pm, 1u, __ATOMIC_RELAXED, __HIP_MEMORY_SCOPE_AGENT);
        if (wid == 0) {
            for (unsigned sp = 0; sp < (1u << 22); ++sp) {
                if ((unsigned)__builtin_amdgcn_readfirstlane(__hip_atomic_load(cnt + 64 * u.pm, __ATOMIC_RELAXED, __HIP_MEMORY_SCOPE_AGENT)) >= 32u) break;
                __builtin_amdgcn_s_sleep(2); }
            __builtin_amdgcn_fence(__ATOMIC_ACQUIRE, "agent");
        }
        asm volatile("s_waitcnt vmcnt(0) lgkmcnt(0)" ::: "memory"); __builtin_amdgcn_s_barrier(); asm volatile("" ::: "memory");
        if (lane < 32) { const unsigned* slot = xbuf + (size_t)(u.pm * 256 + row) * 4; float t = 0.f;
#pragma unroll
            for (int k = 0; k < 4; ++k) t += __uint_as_float(__hip_atomic_load(slot + k, __ATOMIC_RELAXED, __HIP_MEMORY_SCOPE_AGENT));
            S[row] = 1.f / sqrtf(t * (1.f / D) + EPS); }
        asm volatile("s_waitcnt lgkmcnt(0)" ::: "memory"); __builtin_amdgcn_s_barrier(); asm volatile("" ::: "memory");
        f32x4 wv[2][2];
#pragma unroll
        for (int bj = 0; bj < 2; ++bj) { wv[bj][0] = *(const f32x4*)(finw + col0 + bj * 128); wv[bj][1] = *(const f32x4*)(finw + col0 + bj * 128 + 4); }
#pragma unroll
        for (int ai = 0; ai < 2; ++ai)
#pragma unroll
            for (int m = 0; m < 4; ++m) { const int r = ai * 128 + wr * 64 + m * 16 + fr; const float rs = S[r]; float* h = H + (size_t)(u.pm * 256 + r) * D + col0;
#pragma unroll
                for (int bj = 0; bj < 2; ++bj) { *(f32x4*)(h + bj * 128) = acc[ai][bj][m][0] * rs * wv[bj][0]; *(f32x4*)(h + bj * 128 + 4) = acc[ai][bj][m][1] * rs * wv[bj][1]; } }
    }
};
struct OrderP1 {
    pg8::StaticOrder so;
    __device__ void init(int G, int c) { so.init(M, INC, G, c); }
    __device__ bool next(int i, pg8::Unit& u) const {
        if (so.next(i, u)) return true;
        const long e = (long)i * so.G + so.c - so.nwg; if (e < 0 || e >= 10) return false;
        u.pm = M / 256; u.pn = (e < 2) ? (int)e : (int)e + 4; return true;
    }
    __device__ __forceinline__ void a_ready(const pg8::Unit&) const {}
    __device__ __forceinline__ void done(const pg8::Unit&) const {}
};

__device__ __forceinline__ void bf8_add(float (&s)[8], const u32x4 v, float sg) {
    s[0] += sg * bflo(v.x); s[1] += sg * bfhi(v.x); s[2] += sg * bflo(v.y); s[3] += sg * bfhi(v.y); s[4] += sg * bflo(v.z); s[5] += sg * bfhi(v.z); s[6] += sg * bflo(v.w); s[7] += sg * bfhi(v.w);
}
__device__ __forceinline__ void pool_phase(Frame& F) {
    constexpr int RUN = 8;
    const long total = (long)(M / RUN) * (PW / 8);
    for (long it = (long)blockIdx.x * NTHR + F.tid; it < total; it += (long)F.G * NTHR) {
        const int m0 = (int)(it / (PW / 8)) * RUN, c0 = (int)(it % (PW / 8)) * 8, b = m0 / SEQ, t0 = m0 % SEQ, g = c0 / 128, w = 2 << g;
        const float iw = 1.f / (float)w;
        auto urow = [&](int tt) -> const bf16* { return F.UP + ((tt >= 0) ? (size_t)(b * SEQ + tt) : (size_t)(M + NMETA + tt)) * PW + c0; };
        float s[8];
#pragma unroll
        for (int j = 0; j < 8; ++j) s[j] = 0.f;
        for (int i = 1; i < w; ++i) bf8_add(s, *(const u32x4*)urow(t0 - i), 1.f);
#pragma unroll
        for (int r = 0; r < RUN; ++r) { const int t = t0 + r;
            const u32x4 self = *(const u32x4*)urow(t); bf8_add(s, self, 1.f);
            u32x4 o; o.x = pk2(s[0] * iw - bflo(self.x), s[1] * iw - bfhi(self.x)); o.y = pk2(s[2] * iw - bflo(self.y), s[3] * iw - bfhi(self.y));
            o.z = pk2(s[4] * iw - bflo(self.z), s[5] * iw - bfhi(self.z)); o.w = pk2(s[6] * iw - bflo(self.w), s[7] * iw - bfhi(self.w));
            *(u32x4*)(F.ACAT + (size_t)(m0 + r) * KC + c0) = o;
            if (r + 1 < RUN) bf8_add(s, *(const u32x4*)urow(t - w + 1), -1.f); }
    }
}

__device__ __forceinline__ int t5_bucket(int rel) {
    const int n = rel < 0 ? -rel : rel; int r = rel > 0 ? 16 : 0;
    int v;
    if (n < 8) v = n; else if (n < 12) v = 8; else if (n < 16) v = 9; else if (n < 23) v = 10; else if (n < 32) v = 11; else if (n < 46) v = 12; else if (n < 64) v = 13; else if (n < 91) v = 14; else v = 15;
    return r + v;
}
__device__ __forceinline__ float compute_lambda(const Frame& F) {
    float a = 0.f, b = 0.f;
    for (int i = 0; i < HD; ++i) { a += F.lq1[i] * F.lk1[i]; b += F.lq2[i] * F.lk2[i]; }
    return __expf(a) - __expf(b) + 0.2f;
}
namespace attn {
typedef short bf16x8 __attribute__((ext_vector_type(8)));
typedef short s16x4 __attribute__((ext_vector_type(4)));
typedef float f32x16 __attribute__((ext_vector_type(16)));
typedef short v4i16_t __attribute__((ext_vector_type(4)));
typedef LAS const char* lds_cptr;
constexpr int RSLOT = 16384, LDS_KR = 0, LDS_VR = 3 * RSLOT;
constexpr int STG_PITCH = 132;
constexpr int LDS_WS = 6 * RSLOT, LDS_BIAS = LDS_WS + 2048, NBIAS = 320;
constexpr int THR = 8;
static_assert(128 * STG_PITCH * 4 <= LDS_WS && LDS_BIAS + NBIAS * 4 <= RING_BYTES, "attention LDS map");
__device__ __forceinline__ int crow(int r, int hi) { return (r & 3) + 8 * (r >> 2) + 4 * hi; }
__device__ __forceinline__ void glds16s(const void* sbase, unsigned voff, unsigned lds_dst) { unsigned keep;
    asm volatile("s_nop 4\n\ts_mov_b32 %0, m0\n\ts_mov_b32 m0, %3\n\ts_nop 0\n\tglobal_load_lds_dwordx4 %1, %2\n\ts_mov_b32 m0, %0" : "=&s"(keep) : "v"(voff), "s"(sbase), "s"(lds_dst) : "memory"); }
typedef float f32x2_t __attribute__((ext_vector_type(2))); typedef __bf16 bf16x2_t __attribute__((ext_vector_type(2)));
__device__ __forceinline__ unsigned cvtpk(float lo, float hi) { f32x2_t v = {lo, hi}; bf16x2_t b = __builtin_convertvector(v, bf16x2_t); return __builtin_bit_cast(unsigned, b); }
__device__ __forceinline__ s16x4 vtr(lds_cptr p) { return __builtin_bit_cast(s16x4, __builtin_amdgcn_ds_read_tr16_b64_v4i16((LAS v4i16_t*)p)); }
#define ATT_WAIT_BAR() asm volatile("s_waitcnt vmcnt(0) lgkmcnt(0)\n\ts_barrier" ::: "memory")
#define ATT_MX3(a, b, c) __builtin_fmaxf(__builtin_fmaxf((a), (b)), (c))
__device__ __forceinline__ float rowmax(const f32x16& p0, const f32x16& p1) {
    float a = ATT_MX3(p0[0], p0[1], p1[0]), b = ATT_MX3(p0[2], p0[3], p1[1]); a = ATT_MX3(a, p1[2], p1[3]);
#pragma unroll
    for (int r = 4; r < 16; r += 4) { a = ATT_MX3(a, p0[r], p0[r + 1]); b = ATT_MX3(b, p0[r + 2], p0[r + 3]); a = ATT_MX3(a, p1[r], p1[r + 1]); b = ATT_MX3(b, p1[r + 2], p1[r + 3]); }
    float m = __builtin_fmaxf(a, b); auto rr = __builtin_amdgcn_permlane32_swap(__float_as_uint(m), __float_as_uint(m), false, false);
    return __builtin_fmaxf(__uint_as_float(rr[0]), __uint_as_float(rr[1]));
}

__device__ __forceinline__ void pv_tile(f32x16 (&o)[4], const u32x4 (&pw)[4], const lds_cptr vp) {
#pragma unroll
    for (int db = 0; db < 4; ++db)
#pragma unroll
        for (int ks = 0; ks < 4; ++ks) {
            const s16x4 lo = vtr(vp + db * 4096 + ks * 1024), hh = vtr(vp + db * 4096 + ks * 1024 + 512);
            const bf16x8 vf = (bf16x8){lo[0], lo[1], lo[2], lo[3], hh[0], hh[1], hh[2], hh[3]};
            o[db] = __builtin_amdgcn_mfma_f32_32x32x16_bf16(__builtin_bit_cast(bf16x8, pw[ks]), vf, o[db], 0, 0, 0);
        }
}
#define ATT_SBAR() __builtin_amdgcn_sched_barrier(0)
#define ATT_PIN(x) asm volatile("" : "+v"(x))
#define ATT_MFMA(a, b, c) __builtin_amdgcn_mfma_f32_32x32x16_bf16(a, b, c, 0, 0, 0)

__device__ __forceinline__ void attn_unit(const Frame& F, int b, int h, int qb, float lam) {
    int lane = F.lane; asm volatile("" : "+v"(lane));
    const int r32 = lane & 31, hi = lane >> 5, wid = F.wave, rg = wid & 3, map = wid >> 2;
    const int q0w = qb * 128 + rg * 32;
    const size_t rowbase = (size_t)b * SEQ;
    const LAS unsigned char* lds = F.lds;
    const unsigned lds0 = (unsigned)(uintptr_t)lds;
    LAS float* wsf = (LAS float*)(lds + LDS_WS) + wid * 64;
    const LAS float* tb = (const LAS float*)(lds + LDS_BIAS);
    const int NT = 2 * qb + 3;
    const unsigned kvoff = (unsigned)(lane * AW + wid * 8) * 2u;
    const unsigned vvoff = (unsigned)((16 * (wid & 3) + (lane >> 2)) * AW + (wid >> 2) * 32 + (lane & 3) * 8) * 2u;
    const unsigned pdst = lds0 + wid * 1024;
#define ATT_TROW(t) ((t) == 0 ? (size_t)M : rowbase + (size_t)64 * ((t) - 1))
#define ATT_DMA_K(t, slot) do { const bf16* kb_ = F.Kb + ATT_TROW(t) * AW + h * 128; const unsigned d_ = (unsigned)__builtin_amdgcn_readfirstlane(pdst + LDS_KR + (slot)); \
        glds16s(kb_, kvoff, d_); glds16s(kb_ + 64, kvoff, d_ + 8192); } while (0)
#define ATT_DMA_V(t, slot) do { const bf16* vb_ = F.Vb + ATT_TROW(t) * AW + h * 128; const unsigned d_ = (unsigned)__builtin_amdgcn_readfirstlane(pdst + LDS_VR + (slot)); \
        glds16s(vb_, vvoff, d_); glds16s(vb_ + 64, vvoff, d_ + 8192); } while (0)
    ATT_DMA_K(0, 0); ATT_DMA_V(0, 0); ATT_DMA_K(1, RSLOT);
    bf16x8 qr[4];
    { const bf16* Qw = F.Qb + (rowbase + q0w + r32) * AW + h * 128 + map * 64 + hi * 8;
#pragma unroll
      for (int d0 = 0; d0 < 4; ++d0) qr[d0] = *(const bf16x8*)(Qw + d0 * 16); }
    float mhat = 0.f, l_reg = 0.f; f32x16 o[4]; f32x16 negm = f32x16{};
#pragma unroll
    for (int i = 0; i < 4; ++i) o[i] = f32x16{};
    const lds_cptr kp0 = (lds_cptr)lds + LDS_KR + map * 8192 + hi * 1024 + r32 * 16;
    const lds_cptr vp0 = (lds_cptr)lds + LDS_VR + ((lane >> 4) & 1) * 32 + (lane & 3) * 8 + (4 * hi + ((lane & 15) >> 2)) * 64;
    const bool last_active = rg >= 2;
    bf16x8 kf[8];
#define ATT_KLOAD(kp_, j) do { kf[2 * (j)] = *(const LAS bf16x8*)((kp_) + (j) * 2048); kf[2 * (j) + 1] = *(const LAS bf16x8*)((kp_) + (j) * 2048 + 512); } while (0)
    ATT_WAIT_BAR();
    f32x16 pA0, pA1, pB0, pB1;
    ATT_DMA_K(2, 2 * RSLOT); ATT_DMA_V(1, RSLOT);
    { ATT_KLOAD(kp0, 0); ATT_KLOAD(kp0, 1); ATT_KLOAD(kp0, 2); ATT_KLOAD(kp0, 3);
      pA0 = ATT_MFMA(kf[0], qr[0], f32x16{}); pA1 = ATT_MFMA(kf[1], qr[0], f32x16{});
#pragma unroll
      for (int d0 = 1; d0 < 4; ++d0) { pA0 = ATT_MFMA(kf[2 * d0], qr[d0], pA0); pA1 = ATT_MFMA(kf[2 * d0 + 1], qr[d0], pA1); }
      if ((NMETA + q0w) - 63 < 91) {
          const LAS float* tbl = tb + ((NMETA + q0w + r32) + 128 - 4 * hi - 12);
#pragma unroll
          for (int r = 0; r < 8; ++r) pA0[r] += tbl[12 - ((r & 3) + 8 * (r >> 2))];
      }
#pragma unroll
      for (int r = 0; r < 16; ++r) { if (r >= 8) pA0[r] = -1e30f; pA1[r] = -1e30f; }
      mhat = rowmax(pA0, pA1);
#pragma unroll
      for (int r = 0; r < 16; ++r) negm[r] = -mhat;
      asm volatile("" : "+v"(negm));
#pragma unroll
      for (int r = 0; r < 16; ++r) { pA0[r] = __builtin_amdgcn_exp2f(pA0[r] - mhat); pA1[r] = __builtin_amdgcn_exp2f(pA1[r] - mhat); }
      const lds_cptr kn = kp0 + RSLOT; ATT_KLOAD(kn, 0); ATT_KLOAD(kn, 1); ATT_KLOAD(kn, 2); ATT_KLOAD(kn, 3); }
    asm volatile("s_waitcnt vmcnt(2) lgkmcnt(0)\n\ts_barrier" ::: "memory");
    s16x4 vlo[8], vhi[8]; u32x4 pw0, pw1, pw2, pw3; bool resc;
    int s_prev = 0, s_cur = RSLOT, s_next = 2 * RSLOT;
#define ATT_ROT() do { const int n_ = s_prev; s_prev = s_cur; s_cur = s_next; s_next = n_; } while (0)
#define ATT_VRD(i, f) do { vlo[i] = vtr(vp_ + (((f) >> 2) * 4096 + ((f) & 3) * 1024)); vhi[i] = vtr(vp_ + (((f) >> 2) * 4096 + ((f) & 3) * 1024 + 512)); } while (0)
#define ATT_VFR(i) (bf16x8){vlo[i][0], vlo[i][1], vlo[i][2], vlo[i][3], vhi[i][0], vhi[i][1], vhi[i][2], vhi[i][3]}
#define ATT_PAF(k) __builtin_bit_cast(bf16x8, pw##k)
#define ATT_GAPA(MF, A0, A1, A2, A3, W0, W1, PW) do { MF; sacc += A0; sacc += A1; sacc += A2; sacc += A3; ATT_PIN(sacc); W0; W1; ATT_PIN(PW); ATT_SBAR(); } while (0)
#define ATT_EX(v) __builtin_amdgcn_exp2f(v)
#define ATT_PV(i) o[(i) >> 2] = ATT_MFMA(__builtin_bit_cast(bf16x8, (((i) & 3) == 0) ? pw0 : (((i) & 3) == 1) ? pw1 : (((i) & 3) == 2) ? pw2 : pw3), ATT_VFR((i) & 7), o[(i) >> 2])
#define ATT_KRD(j) kf[j] = *(const LAS bf16x8*)(kn_ + ((j) >> 1) * 2048 + ((j) & 1) * 512)
#define ATT_EXP1(C0, C1, e) do { if ((e) < 16) C0[(e) & 15] = ATT_EX(C0[(e) & 15]); else C1[(e) & 15] = ATT_EX(C1[(e) & 15]); } while (0)
#define ATT_STEP(C0, C1, P0, P1, t) do { \
        if ((t) + 2 < NT) ATT_DMA_K((t) + 2, s_prev); \
        if ((t) + 1 < NT) ATT_DMA_V((t) + 1, s_next); \
        const lds_cptr vp_ = vp0 + s_prev; const lds_cptr kn_ = kp0 + s_next; \
        ATT_SBAR(); \
        float sacc = 0.f; \
        ATT_VRD(0, 0); ATT_VRD(1, 1); ATT_SBAR(); \
        ATT_GAPA(C0 = ATT_MFMA(kf[0], qr[0], negm), P0[0], P0[1], P0[2], P0[3],     pw0[0] = cvtpk(P0[0], P0[1]),   pw0[1] = cvtpk(P0[2], P0[3]),   pw0); \
        ATT_VRD(2, 2); ATT_SBAR(); \
        ATT_GAPA(C1 = ATT_MFMA(kf[1], qr[0], negm), P0[4], P0[5], P0[6], P0[7],     pw0[2] = cvtpk(P0[4], P0[5]),   pw0[3] = cvtpk(P0[6], P0[7]),   pw0); \
        ATT_VRD(3, 3); ATT_SBAR(); \
        ATT_GAPA(C0 = ATT_MFMA(kf[2], qr[1], C0),       P0[8], P0[9], P0[10], P0[11],   pw1[0] = cvtpk(P0[8], P0[9]),   pw1[1] = cvtpk(P0[10], P0[11]), pw1); \
        ATT_VRD(4, 4); ATT_SBAR(); \
        ATT_GAPA(C1 = ATT_MFMA(kf[3], qr[1], C1),       P0[12], P0[13], P0[14], P0[15], pw1[2] = cvtpk(P0[12], P0[13]), pw1[3] = cvtpk(P0[14], P0[15]), pw1); \
        ATT_VRD(5, 5); ATT_SBAR(); \
        ATT_GAPA(C0 = ATT_MFMA(kf[4], qr[2], C0),       P1[0], P1[1], P1[2], P1[3],     pw2[0] = cvtpk(P1[0], P1[1]),   pw2[1] = cvtpk(P1[2], P1[3]),   pw2); \
        ATT_VRD(6, 6); ATT_SBAR(); \
        ATT_GAPA(C1 = ATT_MFMA(kf[5], qr[2], C1),       P1[4], P1[5], P1[6], P1[7],     pw2[2] = cvtpk(P1[4], P1[5]),   pw2[3] = cvtpk(P1[6], P1[7]),   pw2); \
        ATT_VRD(7, 7); ATT_SBAR(); \
        ATT_GAPA(C0 = ATT_MFMA(kf[6], qr[3], C0),       P1[8], P1[9], P1[10], P1[11],   pw3[0] = cvtpk(P1[8], P1[9]),   pw3[1] = cvtpk(P1[10], P1[11]), pw3); \
        ATT_GAPA(C1 = ATT_MFMA(kf[7], qr[3], C1),       P1[12], P1[13], P1[14], P1[15], pw3[2] = cvtpk(P1[12], P1[13]), pw3[3] = cvtpk(P1[14], P1[15]), pw3); \
        l_reg += sacc; \
        { const int kpos0_ = NMETA + 64 * ((t) - 1); \
          if ((NMETA + q0w) - (kpos0_ + 63) < 91) {                                     \
              const LAS float* tbl_ = tb + ((NMETA + q0w + r32) - kpos0_ + 128 - 4 * hi - 60);     \
              _Pragma("unroll") for (int r = 0; r < 16; ++r) { const int c_ = (r & 3) + 8 * (r >> 2); C0[r] += tbl_[60 - c_]; C1[r] += tbl_[28 - c_]; } } \
          if ((t) == NT - 1 && !last_active) { _Pragma("unroll") for (int r = 0; r < 16; ++r) { C0[r] = -1e30f; C1[r] = -1e30f; } } } \
          \
        float ma_, mb_; resc = false; \
        ATT_SBAR(); \
        ATT_PV(0); ma_ = ATT_MX3(C0[0], C0[1], C1[0]); mb_ = ATT_MX3(C0[2], C0[3], C1[1]); ma_ = ATT_MX3(ma_, C1[2], C1[3]); ma_ = ATT_MX3(ma_, C0[4], C0[5]); ATT_PIN(ma_); ATT_PIN(mb_); ATT_VRD(0, 8); ATT_SBAR(); \
        ATT_PV(1); mb_ = ATT_MX3(mb_, C0[6], C0[7]); ma_ = ATT_MX3(ma_, C1[4], C1[5]); mb_ = ATT_MX3(mb_, C1[6], C1[7]); ma_ = ATT_MX3(ma_, C0[8], C0[9]); ATT_PIN(ma_); ATT_PIN(mb_); ATT_VRD(1, 9); ATT_SBAR(); \
        ATT_PV(2); mb_ = ATT_MX3(mb_, C0[10], C0[11]); ma_ = ATT_MX3(ma_, C1[8], C1[9]); mb_ = ATT_MX3(mb_, C1[10], C1[11]); ma_ = ATT_MX3(ma_, C0[12], C0[13]); ATT_PIN(ma_); ATT_PIN(mb_); ATT_VRD(2, 10); ATT_SBAR(); \
        ATT_PV(3); mb_ = ATT_MX3(mb_, C0[14], C0[15]); ma_ = ATT_MX3(ma_, C1[12], C1[13]); mb_ = ATT_MX3(mb_, C1[14], C1[15]); ATT_VRD(3, 11); \
        float rm_ = __builtin_fmaxf(ma_, mb_); { auto rr_ = __builtin_amdgcn_permlane32_swap(__float_as_uint(rm_), __float_as_uint(rm_), false, false); rm_ = __builtin_fmaxf(__uint_as_float(rr_[0]), __uint_as_float(rr_[1])); } \
        const bool grow_ = __any(rm_ > (float)THR); \
        ATT_SBAR(); \
          \
        ATT_PV(4); ATT_VRD(4, 12); ATT_KRD(0); ATT_SBAR(); \
        ATT_PV(5); ATT_VRD(5, 13); ATT_KRD(1); ATT_SBAR(); \
        if (grow_) {                                                                    \
            const float dl_ = __builtin_fmaxf(rm_, 0.f); mhat += dl_; const float f_ = __builtin_amdgcn_exp2f(-dl_); l_reg *= f_; if (hi == 0) wsf[r32] = f_; resc = true; \
            _Pragma("unroll") for (int r = 0; r < 16; ++r) { C0[r] -= dl_; C1[r] -= dl_; negm[r] = -mhat; } asm volatile("" : "+v"(negm)); } \
        ATT_SBAR(); \
          \
        ATT_PV(6);  ATT_EXP1(C0, C1, 0);  ATT_EXP1(C0, C1, 1);  ATT_EXP1(C0, C1, 2);  ATT_PIN(C0); ATT_VRD(6, 14); ATT_KRD(2); ATT_SBAR(); \
        ATT_PV(7);  ATT_EXP1(C0, C1, 3);  ATT_EXP1(C0, C1, 4);  ATT_EXP1(C0, C1, 5);  ATT_PIN(C0); ATT_VRD(7, 15); ATT_KRD(3); ATT_SBAR(); \
        ATT_PV(8);  ATT_EXP1(C0, C1, 6);  ATT_EXP1(C0, C1, 7);  ATT_EXP1(C0, C1, 8);  ATT_PIN(C0); ATT_KRD(4); ATT_SBAR(); \
        ATT_PV(9);  ATT_EXP1(C0, C1, 9);  ATT_EXP1(C0, C1, 10); ATT_EXP1(C0, C1, 11); ATT_PIN(C0); ATT_KRD(5); ATT_SBAR(); \
        ATT_PV(10); ATT_EXP1(C0, C1, 12); ATT_EXP1(C0, C1, 13); ATT_EXP1(C0, C1, 14); ATT_PIN(C0); ATT_KRD(6); ATT_SBAR(); \
        ATT_PV(11); ATT_EXP1(C0, C1, 15); ATT_EXP1(C0, C1, 16); ATT_EXP1(C0, C1, 17); ATT_PIN(C0); ATT_PIN(C1); ATT_KRD(7); ATT_SBAR(); \
        ATT_PV(12); ATT_EXP1(C0, C1, 18); ATT_EXP1(C0, C1, 19); ATT_EXP1(C0, C1, 20); ATT_EXP1(C0, C1, 21); ATT_PIN(C1); ATT_SBAR(); \
        ATT_PV(13); ATT_EXP1(C0, C1, 22); ATT_EXP1(C0, C1, 23); ATT_EXP1(C0, C1, 24); ATT_EXP1(C0, C1, 25); ATT_PIN(C1); ATT_SBAR(); \
        ATT_PV(14); ATT_EXP1(C0, C1, 26); ATT_EXP1(C0, C1, 27); ATT_EXP1(C0, C1, 28); ATT_PIN(C1); ATT_SBAR(); \
        ATT_PV(15); ATT_EXP1(C0, C1, 29); ATT_EXP1(C0, C1, 30); ATT_EXP1(C0, C1, 31); ATT_PIN(C1); ATT_SBAR(); \
        if (resc) { LDS_WAIT(); \
            _Pragma("unroll") for (int r = 0; r < 16; ++r) { const float fr_ = wsf[crow(r, hi)]; _Pragma("unroll") for (int i = 0; i < 4; ++i) o[i][r] *= fr_; } } \
        if ((t) + 1 < NT) asm volatile("s_waitcnt vmcnt(2) lgkmcnt(0)\n\ts_barrier" ::: "memory"); else asm volatile("s_waitcnt vmcnt(0) lgkmcnt(0)\n\ts_barrier" ::: "memory"); \
        ATT_ROT(); \
    } while (0)
#pragma unroll 1
    for (int t = 1; t < NT; t += 2) {
        ATT_STEP(pB0, pB1, pA0, pA1, t);
        ATT_STEP(pA0, pA1, pB0, pB1, t + 1);
    }
    { float sacc = 0.f;
#pragma unroll
      for (int r = 0; r < 16; ++r) sacc += pA0[r] + pA1[r];
      l_reg += sacc;
      u32x4 pw[4];
      pw[0] = (u32x4){cvtpk(pA0[0], pA0[1]), cvtpk(pA0[2], pA0[3]), cvtpk(pA0[4], pA0[5]), cvtpk(pA0[6], pA0[7])};
      pw[1] = (u32x4){cvtpk(pA0[8], pA0[9]), cvtpk(pA0[10], pA0[11]), cvtpk(pA0[12], pA0[13]), cvtpk(pA0[14], pA0[15])};
      pw[2] = (u32x4){cvtpk(pA1[0], pA1[1]), cvtpk(pA1[2], pA1[3]), cvtpk(pA1[4], pA1[5]), cvtpk(pA1[6], pA1[7])};
      pw[3] = (u32x4){cvtpk(pA1[8], pA1[9]), cvtpk(pA1[10], pA1[11]), cvtpk(pA1[12], pA1[13]), cvtpk(pA1[14], pA1[15])};
      pv_tile(o, pw, vp0 + s_prev); }
    ATT_WAIT_BAR();
#undef ATT_STEP
#undef ATT_GAPA
#undef ATT_PV
#undef ATT_KRD
#undef ATT_EXP1
#undef ATT_VRD
#undef ATT_KLOAD
    { auto rr = __builtin_amdgcn_permlane32_swap(__float_as_uint(l_reg), __float_as_uint(l_reg), false, false); l_reg = __uint_as_float(rr[0]) + __uint_as_float(rr[1]); }
    if (hi == 0) wsf[32 + r32] = l_reg;
    LDS_WAIT();
    float rli[16];
#pragma unroll
    for (int r = 0; r < 16; ++r) rli[r] = 1.f / wsf[32 + crow(r, hi)];
    LAS float* stg = (LAS float*)lds;
    if (map == 1) {
#pragma unroll
        for (int r = 0; r < 16; ++r) { LAS float* sp = stg + (32 * rg + crow(r, hi)) * STG_PITCH + r32;
#pragma unroll
            for (int i = 0; i < 4; ++i) sp[32 * i] = o[i][r] * rli[r]; }
    }
    ATT_WAIT_BAR();
    if (map == 0) {
#pragma unroll
        for (int r = 0; r < 16; ++r) { LAS float* sp = stg + (32 * rg + crow(r, hi)) * STG_PITCH + r32;
#pragma unroll
            for (int i = 0; i < 4; ++i) sp[32 * i] = o[i][r] * rli[r] - lam * sp[32 * i]; }
    }
    ATT_WAIT_BAR();
    { int lane2 = F.lane; asm volatile("" : "+v"(lane2)); const int row = wid * 16 + (lane2 >> 2), c0 = (lane2 & 3) * 32;
      const LAS float* sp = stg + row * STG_PITCH + c0; f32x4 v[8]; float ss = 0.f;
#pragma unroll
      for (int i = 0; i < 8; ++i) { v[i] = *(const LAS f32x4*)(sp + 4 * i); ss += (v[i].x * v[i].x + v[i].y * v[i].y) + (v[i].z * v[i].z + v[i].w * v[i].w); }
      ss += __shfl_xor(ss, 1); ss += __shfl_xor(ss, 2);
      const float rs = 0.8f / sqrtf(ss * (1.f / 128.f) + EPS);
      bf16* ao = F.ACAT + (rowbase + (size_t)qb * 128 + row) * KC + PW + h * 128 + c0; const f32x4* sw = (const f32x4*)(F.sublnw + c0);
#pragma unroll
      for (int i = 0; i < 4; ++i) { const f32x4 a = v[2 * i] * rs * sw[2 * i], c = v[2 * i + 1] * rs * sw[2 * i + 1];
          u32x4 w; w.x = pk2(a.x, a.y); w.y = pk2(a.z, a.w); w.z = pk2(c.x, c.y); w.w = pk2(c.z, c.w); *(u32x4*)(ao + 8 * i) = w; } }
    ATT_WAIT_BAR();
#undef ATT_TROW
#undef ATT_DMA_K
#undef ATT_DMA_V
#undef ATT_ROT
#undef ATT_VFR
#undef ATT_PAF
#undef ATT_EX
}
__device__ __forceinline__ void attn_phase(const Frame& F) {
    const float lam = compute_lambda(F);
    for (int v = F.vcu; v < 256; v += F.G) {
        const int xg = v >> 5, j = v & 31;
#pragma unroll 1
        for (int r = 0; r < 4; ++r) {
            const int bh = 4 * xg + r, b = bh / NH, h = bh % NH, j2 = (j + 16) & 31;
            const int qb = (r == 0) ? j : (r == 1) ? 31 - j : (r == 2) ? j2 : 31 - j2;
            __syncthreads();
            int tid_ = F.wave * 64 + (int)__builtin_amdgcn_mbcnt_hi(~0u, __builtin_amdgcn_mbcnt_lo(~0u, 0u)); asm volatile("" : "+v"(tid_));
            if (tid_ < NBIAS) { const int d = min(max(tid_ - 128, -127), 91);
                ((LAS float*)(F.lds + LDS_BIAS))[tid_] = (F.btab[t5_bucket(-d) * NH + h] - F.btab[15 * NH + h]) * LOG2E; }
            __syncthreads();
            attn_unit(F, b, h, qb, lam);
        }
    }
}
}

__device__ __forceinline__ void final_norm_phase(Frame& F) {
    const int gw = F.vcu * NWAVES + F.wave, NGW = F.G * NWAVES;
    for (int m = gw; m < M; m += NGW) {
        f32x4* xr = (f32x4*)(F.out + (size_t)m * D) + F.lane; const f32x4* wr = (const f32x4*)F.finw + F.lane;
        f32x4 v[4]; float s = 0.f;
#pragma unroll
        for (int j = 0; j < 4; ++j) { v[j] = xr[64 * j]; s += (v[j].x * v[j].x + v[j].y * v[j].y) + (v[j].z * v[j].z + v[j].w * v[j].w); }
        const float rstd = 1.f / sqrtf(wave_sum(s) * (1.f / D) + EPS);
#pragma unroll
        for (int j = 0; j < 4; ++j) xr[64 * j] = v[j] * rstd * wr[64 * j];
    }
}

typedef GAS unsigned gu32;
typedef GAS unsigned long long gu64;
#define RLX_AGENT __ATOMIC_RELAXED, __HIP_MEMORY_SCOPE_AGENT
#define XB_TMO      128
#define XB_XCNT(j)  (256  + 64 * (j))
#define XB_XSUB(j)  (1280 + 64 * (j))
#define XB_XGEN(j)  (2304 + 64 * (j))
#define XB_TOP      3328
#define XB_TOPGEN   3392
#define XCD_BAR_WORDS 3456
#define XB_SPIN_CAP (1u << 18)

__device__ __forceinline__ unsigned xb_ld(unsigned* p)              { return __hip_atomic_load(p, __ATOMIC_RELAXED, __HIP_MEMORY_SCOPE_AGENT); }
__device__ __forceinline__ unsigned xb_add(unsigned* p, unsigned v) { return __hip_atomic_fetch_add(p, v, __ATOMIC_RELAXED, __HIP_MEMORY_SCOPE_AGENT); }
__device__ __forceinline__ unsigned xb_xcc_id() { return (unsigned)__builtin_amdgcn_s_getreg((3 << 11) | 20) & 0xFu; }
#define XB_SPIN(cond, bar) do { unsigned _sp = 0; while (cond) { __builtin_amdgcn_s_sleep(1); \
    if ((++_sp & 255u) == 0u) { if (xb_ld(&(bar)[XB_TMO])) break; if (_sp > XB_SPIN_CAP) { atomicAdd(&(bar)[XB_TMO], 1u); break; } } } } while (0)

struct XcdBarrier {
    unsigned* bar; unsigned x;
    volatile LAS unsigned* st;
};

__device__ __forceinline__ XcdBarrier xcd_barrier_post(unsigned* bar, volatile LAS unsigned* st) {
    XcdBarrier b; b.bar = bar; b.x = xb_xcc_id(); b.st = st;
    if (threadIdx.x == 0) (void)xb_add(&bar[XB_XCNT(b.x)], 1u);
    return b;
}
__device__ __forceinline__ void xcd_barrier_complete(unsigned* bar, unsigned x, unsigned& nloc, unsigned& nx) {
    const unsigned G = gridDim.x * gridDim.y * gridDim.z;
    unsigned sum, cnt, mine, sp = 0u;
    for (;;) {
        sum = 0u; cnt = 0u; mine = 0u;
#pragma unroll
        for (unsigned j = 0; j < 16; ++j) { const unsigned c = xb_ld(&bar[XB_XCNT(j)]); sum += c; cnt += (c > 0u) ? 1u : 0u; mine = (j == x) ? c : mine; }
        if (sum == G) break;
        __builtin_amdgcn_s_sleep(1);
        if ((++sp & 255u) == 0u) { if (xb_ld(&bar[XB_TMO])) break; if (sp > XB_SPIN_CAP) { atomicAdd(&bar[XB_TMO], 1u); break; } }
    }
    nloc = mine > 0u ? mine : 1u; nx = cnt > 0u ? cnt : 1u;
}

__device__ __forceinline__ void xcd_barrier(const XcdBarrier& b) {
    asm volatile("s_waitcnt vmcnt(0)" ::: "memory");
    __syncthreads();
    if (threadIdx.x == 0) {
        unsigned* bar = b.bar;
        __builtin_amdgcn_s_waitcnt(0);
        unsigned nloc = b.st[0], nx = b.st[1];
        if (nloc == 0u) { xcd_barrier_complete(bar, b.x, nloc, nx); b.st[0] = nloc; b.st[1] = nx; }
        const unsigned old = xb_add(&bar[XB_XSUB(b.x)], 1u);
        const unsigned gen = old / nloc;
        if (old + 1u == (gen + 1u) * nloc) {
            __builtin_amdgcn_fence(__ATOMIC_RELEASE, "agent");
            asm volatile("s_waitcnt vmcnt(0)" ::: "memory");
            const unsigned og = xb_add(&bar[XB_TOP], 1u);
            const unsigned tg = og / nx;
            if (og + 1u == (tg + 1u) * nx) xb_add(&bar[XB_TOPGEN], 1u);
            else XB_SPIN(xb_ld(&bar[XB_TOPGEN]) == tg, bar);
            __builtin_amdgcn_fence(__ATOMIC_ACQUIRE, "agent");
            xb_add(&bar[XB_XGEN(b.x)], 1u);
            asm volatile("s_waitcnt vmcnt(0)" ::: "memory");
        } else {
            XB_SPIN(xb_ld(&bar[XB_XGEN(b.x)]) == gen, bar);
            __builtin_amdgcn_fence(__ATOMIC_ACQUIRE, "agent");
            asm volatile("s_waitcnt vmcnt(0)" ::: "memory");
        }
    }
    __syncthreads();
}

struct Args { const float* in[20]; float* out; unsigned char* ws; int ph_lo, ph_hi; };
constexpr int NPHASE = 8;

__global__ void __launch_bounds__(NTHR, 2) mk_fwd(Args args) {
    extern __shared__ __attribute__((aligned(16))) unsigned char lds[];
    Frame F;
    F.lds = (LAS unsigned char*)lds;
    F.wave = __builtin_amdgcn_readfirstlane((int)threadIdx.x >> 6); F.lane = (int)__builtin_amdgcn_mbcnt_hi(~0u, __builtin_amdgcn_mbcnt_lo(~0u, 0u)); F.tid = F.wave * 64 + F.lane;
    F.G = gridDim.x; { const int bx = blockIdx.x; F.vcu = (F.G % 8 == 0) ? (bx % 8) * (F.G / 8) + bx / 8 : bx; }
    F.x = args.in[0]; F.meta = args.in[1]; F.btab = args.in[2]; F.mixw = args.in[3]; F.win = args.in[4]; F.pgw = args.in[5]; F.pscale = args.in[6];
    F.lq1 = args.in[7]; F.lk1 = args.in[8]; F.lq2 = args.in[9]; F.lk2 = args.in[10]; F.sublnw = args.in[11]; F.wpo = args.in[12]; F.wao = args.in[13];
    F.wo = args.in[14]; F.ffnw = args.in[15]; F.wg = args.in[16]; F.wu = args.in[17]; F.wd = args.in[18]; F.finw = args.in[19];
    F.out = args.out; F.ws = args.ws; unsigned char* ws = args.ws;
    F.Win_t = (bf16*)(ws + WS_WIN); F.Wcat_t = (bf16*)(ws + WS_WCAT); F.Wo_t = (bf16*)(ws + WS_WO); F.Wgu_t = (bf16*)(ws + WS_WGU); F.Wd_t = (bf16*)(ws + WS_WD);
    F.XN = (bf16*)(ws + WS_XN); F.UP = (bf16*)(ws + WS_UP); F.Kb = (bf16*)(ws + WS_K); F.Vb = (bf16*)(ws + WS_V); F.Qb = (bf16*)(ws + WS_Q); F.GP = (bf16*)(ws + WS_GP); F.GA = (bf16*)(ws + WS_GA);
    F.MERGED = (bf16*)(ws + WS_MERGED); F.HB = (bf16*)(ws + WS_HB); F.ACT = (bf16*)(ws + WS_ACT); F.PART = (float*)(ws + WS_PART); F.ACAT = (bf16*)args.out;
    const int lo = args.ph_lo, hi = args.ph_hi;
    for (int u = F.tid; u < (LDS_BYTES - RING_BYTES) / 4; u += NTHR) ((LAS unsigned*)(F.lds + RING_BYTES))[u] = 0u;
    __syncthreads();
    XcdBarrier bar; bar.bar = (unsigned*)(ws + WS_CTL) + CW_BAR; bar.x = 0; bar.st = nullptr;
    if (hi - lo > 1) bar = xcd_barrier_post((unsigned*)(ws + WS_CTL) + CW_BAR, (volatile LAS unsigned*)(F.lds + MISC_OFF) + 8);
#define IN(k) (lo <= (k) && (k) < hi)
#define SEAM(k) do { if (IN(k) && IN((k) + 1)) xcd_barrier(bar); } while (0)
    if (IN(0)) { p0_prologue(F); }
    SEAM(0);
    if (IN(1)) {
        pg8::Gemm g{F.XN, F.Win_t, MP, INC, D}; OrderP1 S; S.init(F.G, (int)blockIdx.x);
        Epi8P1 E{{F.UP, F.Qb, F.Kb, F.Vb, F.GP, F.GA}};
        pg8::gemm_phase<Epi8P1, OrderP1, true, true>(F.lds, g, S, E, F.wave, F.lane);
        deferred_weights(F, 0, (M / 256) * (INC / 256) + 10);
    }
    SEAM(1);
    if (IN(2)) { pool_phase(F); __syncthreads(); attn::attn_phase(F); }
    SEAM(2);
    if (IN(3)) {
        pg8::Gemm g{F.ACAT, F.Wcat_t, M, D, KC}; pg8::StaticOrder S; S.init(M, D, F.G, (int)blockIdx.x);
        EpiP3 E{F.GP, F.GA, F.MERGED}; pg8::gemm_phase<EpiP3, pg8::StaticOrder, true, true>(F.lds, g, S, E, F.wave, F.lane);
    }
    SEAM(3);
    if (IN(4)) {
        pg8::Gemm g{F.MERGED, F.Wo_t, M, D, D}; pg8::StaticOrder S; S.init(M, D, F.G, (int)blockIdx.x);
        Epi8P4 E{{F.x, F.HB}, F.PART}; pg8::gemm_phase<Epi8P4, pg8::StaticOrder, true, true>(F.lds, g, S, E, F.wave, F.lane);
    }
    SEAM(4);
    if (IN(5)) {
        pg8::Gemm g{F.HB, F.Wgu_t, M, 2 * FF, D}; pg8::StaticOrder S; S.init(M, 2 * FF, F.G, (int)blockIdx.x);
        Epi8P5 E{{F.ACT}, F.PART}; pg8::gemm_phase<Epi8P5, pg8::StaticOrder, true, true>(F.lds, g, S, E, F.wave, F.lane);
        deferred_weights(F, 1, (M / 256) * (2 * FF / 256));
    }
    SEAM(5);
    if (IN(6)) {
        pg8::Gemm g{F.ACT, F.Wd_t, M, D, FF}; pg8::StaticOrder S; S.init(M, D, F.G, (int)blockIdx.x);
        if (F.G == 256) { EpiFinal E{F.HB, F.out, F.finw, (unsigned*)(ws + WS_XSLOT), (unsigned*)(ws + WS_CTL) + CW_CNT}; pg8::gemm_phase<EpiFinal, pg8::StaticOrder, false, true>(F.lds, g, S, E, F.wave, F.lane); }
        else { Epi8<EpiP6> E{{F.HB, F.out}}; pg8::gemm_phase<Epi8<EpiP6>, pg8::StaticOrder, true, true>(F.lds, g, S, E, F.wave, F.lane); }
    }
    if (F.G != 256) { SEAM(6); if (IN(7)) final_norm_phase(F); }
#undef IN
#undef SEAM
}

extern "C" void kernel_launch(void* const* d_in, const int* in_sizes, int n_in, void* d_out, int out_size, void* d_ws, size_t ws_size, hipStream_t stream) {
    static int grid = 0;
    if (grid == 0) {
        if (n_in != 20 || out_size != M * D || ws_size < WS_END) { fprintf(stderr, "kernel_launch: unexpected shapes (n_in %d out %d ws %zu)\n", n_in, out_size, ws_size); grid = -1; return; }
        int dev = 0, cus = 0, per_cu = 0;
        if (hipGetDevice(&dev) != hipSuccess || hipDeviceGetAttribute(&cus, hipDeviceAttributeMultiprocessorCount, dev) != hipSuccess) { grid = -1; return; }
        if (hipFuncSetAttribute((const void*)mk_fwd, hipFuncAttributeMaxDynamicSharedMemorySize, LDS_BYTES) != hipSuccess) { fprintf(stderr, "kernel_launch: hipFuncSetAttribute failed\n"); grid = -1; return; }
        if (hipOccupancyMaxActiveBlocksPerMultiprocessor(&per_cu, (const void*)mk_fwd, NTHR, LDS_BYTES) != hipSuccess || per_cu < 1) { fprintf(stderr, "kernel_launch: occupancy query says %d\n", per_cu); }
        (void)hipGetLastError();
        grid = cus;
    }
    if (grid < 0) return;
    (void)hipMemsetAsync((char*)d_ws + WS_CTL, 0, CTL_ZERO_BYTES, stream);
    Args a{};
    for (int i = 0; i < 20; ++i) a.in[i] = (const float*)d_in[i];
    a.out = (float*)d_out; a.ws = (unsigned char*)d_ws;
#ifdef PROBE_DUP
    if (true) { a.ph_lo = 0; a.ph_hi = PROBE_DUP + 1; hipLaunchKernelGGL(mk_fwd, dim3(grid), dim3(NTHR), LDS_BYTES, stream, a);
        (void)hipMemsetAsync((char*)d_ws + WS_CTL, 0, 65536, stream);
        a.ph_lo = PROBE_DUP; a.ph_hi = NPHASE; hipLaunchKernelGGL(mk_fwd, dim3(grid), dim3(NTHR), LDS_BYTES, stream, a); }
#else
    if (MK_N_LAUNCHES == 1) { a.ph_lo = 0; a.ph_hi = NPHASE; hipLaunchKernelGGL(mk_fwd, dim3(grid), dim3(NTHR), LDS_BYTES, stream, a); }
#endif
    else for (int p = 0; p < NPHASE; ++p) { a.ph_lo = p; a.ph_hi = p + 1; hipLaunchKernelGGL(mk_fwd, dim3(grid), dim3(NTHR), LDS_BYTES, stream, a); }
}
```

```cpp
#include <hip/hip_runtime.h>
#include <cstdio>
#include <cstdint>

#ifndef MK_N_LAUNCHES
#define MK_N_LAUNCHES 1
#endif

constexpr int BATCH = 4, SEQ = 4096, D = 1024, NMETA = 16, NH = 8, HD = 64, VD = 128;
constexpr int M = BATCH * SEQ;
constexpr int MP = M + 256;
constexpr int PW = 512, AW = 1024, FF = 2816, INC = 5632;
constexpr int KC = PW + AW;
constexpr float EPS = 1e-6f;
constexpr float LOG2E = 1.4426950408889634f;
constexpr float QSCALE = 0.125f * LOG2E;

typedef unsigned short bf16;
typedef float f32x4 __attribute__((ext_vector_type(4)));
typedef unsigned u32x4 __attribute__((ext_vector_type(4)));
typedef unsigned u32x2 __attribute__((ext_vector_type(2)));

constexpr size_t MiB = 1u << 20;
constexpr size_t WS_CTL = 0, CTL_ZERO_BYTES = 1 * MiB;
constexpr size_t WS_XSLOT = 512 * 1024;
constexpr int CW_CNT = 16384;
constexpr int CW_QUEUE = 2048;
constexpr int CW_BAR = 4096;
constexpr size_t WS_PART = 1 * MiB;
constexpr size_t WS_WIN = 2 * MiB;
constexpr size_t WS_WCAT = 13 * MiB;
constexpr size_t WS_WO = 16 * MiB;
constexpr size_t WS_WGU = 18 * MiB;
constexpr size_t WS_WD = 29 * MiB;
constexpr size_t WS_XN = 36 * MiB;
constexpr size_t WS_UP = WS_XN + (size_t)MP * D * 2;
constexpr size_t WS_K = WS_UP + (size_t)MP * PW * 2;
constexpr size_t WS_V = WS_K + (size_t)MP * AW * 2;
constexpr size_t WS_Q = WS_V + (size_t)MP * AW * 2;
constexpr size_t WS_GP = WS_Q + (size_t)M * AW * 2;
constexpr size_t WS_GA = WS_GP + (size_t)M * D * 2;
constexpr size_t WS_END = WS_GA + (size_t)M * D * 2;
constexpr size_t WS_MERGED = WS_Q, WS_HB = WS_GP;
constexpr size_t WS_ACT = WS_XN;
static_assert(WS_END <= 256 * MiB, "ws map");
static_assert(WS_ACT + (size_t)M * FF * 2 <= WS_Q, "ACT overlay must not reach MERGED / HB");

constexpr int RING_BYTES = 131072, MISC_OFF = RING_BYTES + 320, LDS_BYTES = 147456;
constexpr int NWAVES = 8, NTHR = 512;

#define GAS __attribute__((address_space(1)))
#define LAS __attribute__((address_space(3)))
#define LDS_WAIT() asm volatile("s_waitcnt lgkmcnt(0)" ::: "memory")
#define VM_WAIT() asm volatile("s_waitcnt vmcnt(0)" ::: "memory")

__device__ __forceinline__ unsigned f2bf(float f) { unsigned u = __builtin_bit_cast(unsigned, f); return (u + 0x7fffu + ((u >> 16) & 1u)) >> 16; }
typedef float f32x2_c __attribute__((ext_vector_type(2))); typedef __bf16 bf16x2_c __attribute__((ext_vector_type(2)));
__device__ __forceinline__ unsigned pk2(float lo, float hi) { f32x2_c v = {lo, hi}; bf16x2_c b = __builtin_convertvector(v, bf16x2_c); return __builtin_bit_cast(unsigned, b); }
__device__ __forceinline__ float bf2f(unsigned b) { return __builtin_bit_cast(float, b << 16); }
__device__ __forceinline__ float bflo(unsigned w) { return __builtin_bit_cast(float, w << 16); }
__device__ __forceinline__ float bfhi(unsigned w) { return __builtin_bit_cast(float, w & 0xffff0000u); }
__device__ __forceinline__ float wave_sum(float v) {
#pragma unroll
    for (int o = 1; o < 64; o <<= 1) v += __shfl_xor(v, o);
    return v;
}
__device__ __forceinline__ float sigmoidf_(float x) { return __builtin_amdgcn_rcpf(1.f + __builtin_amdgcn_exp2f(-LOG2E * x)); }

struct Frame {
    LAS unsigned char* lds;
    int tid, lane, wave, G, vcu;
    const float *x, *meta, *btab, *mixw, *win, *pgw, *pscale, *lq1, *lk1, *lq2, *lk2, *sublnw, *wpo, *wao, *wo, *ffnw, *wg, *wu, *wd, *finw;
    float* out;
    unsigned char* ws;
    bf16 *Win_t, *Wcat_t, *Wo_t, *Wgu_t, *Wd_t;
    bf16 *XN, *UP, *Kb, *Vb, *Qb, *GP, *GA, *MERGED, *HB, *ACT, *ACAT;
    float *PART;
};

struct TrDesc { const float* W; const float* kscale; bf16* WT; int K, N, mode, ldw, item; };
__device__ __forceinline__ void tr_load(const TrDesc& d, int lane, float (&v)[32]) {
    const int nblk = d.N / 32, kb = d.item / nblk, nb = d.item % nblk, k0 = 64 * kb, n0 = 32 * nb;
#pragma unroll
    for (int i = 0; i < 32; ++i) v[i] = __builtin_nontemporal_load(d.W + (size_t)(k0 + 2 * i + (lane >> 5)) * d.N + n0 + (lane & 31));
}
__device__ __forceinline__ void tr_to_lds(const TrDesc& d, int lane, float (&v)[32], LAS float* scr) {
    const int nblk = d.N / 32, kb = d.item / nblk, k0 = 64 * kb;
    if (d.kscale) {
#pragma unroll
        for (int i = 0; i < 32; ++i) v[i] *= d.kscale[k0 + 2 * i + (lane >> 5)]; }
#pragma unroll
    for (int i = 0; i < 32; ++i) scr[(2 * i + (lane >> 5)) * 33 + (lane & 31)] = v[i];
    LDS_WAIT(); asm volatile("" ::: "memory");
}
__device__ __forceinline__ void tr_store(const TrDesc& d, int lane, LAS float* scr) {
    const int nblk = d.N / 32, kb = d.item / nblk, nb = d.item % nblk, k0 = 64 * kb, n0 = 32 * nb;
    const int c = lane & 7;
    const int rbase = (d.mode == 0) ? n0 : ((n0 / 128) * 256 + (n0 % 128) + (d.mode == 2 ? 128 : 0));
#pragma unroll
    for (int j = 0; j < 4; ++j) { const int n = (lane >> 3) + 8 * j; const LAS float* s = scr + (8 * c) * 33 + n;
        u32x4 o; o.x = pk2(s[0 * 33], s[1 * 33]); o.y = pk2(s[2 * 33], s[3 * 33]); o.z = pk2(s[4 * 33], s[5 * 33]); o.w = pk2(s[6 * 33], s[7 * 33]);
        *(u32x4*)(d.WT + (size_t)(rbase + n) * d.ldw + k0 + 8 * c) = o; }
    LDS_WAIT(); asm volatile("" ::: "memory");
}
template <int NR> __device__ __forceinline__ void rms_rows_to_bf16(const float* const (&xrow)[NR], const float* w, bf16* const (&orow)[NR], int lane) {
    f32x4 v[NR][4]; float s[NR];
#pragma unroll
    for (int r = 0; r < NR; ++r) { const f32x4* xr = (const f32x4*)xrow[r] + lane;
#pragma unroll
        for (int j = 0; j < 4; ++j) v[r][j] = __builtin_nontemporal_load(xr + 64 * j); }
    const f32x4* wr = (const f32x4*)w + lane; f32x4 ww[4];
#pragma unroll
    for (int j = 0; j < 4; ++j) ww[j] = wr[64 * j];
#pragma unroll
    for (int r = 0; r < NR; ++r) { s[r] = 0.f;
#pragma unroll
        for (int j = 0; j < 4; ++j) s[r] += (v[r][j].x * v[r][j].x + v[r][j].y * v[r][j].y) + (v[r][j].z * v[r][j].z + v[r][j].w * v[r][j].w); }
#pragma unroll
    for (int r = 0; r < NR; ++r) { const float rstd = 1.f / sqrtf(wave_sum(s[r]) * (1.f / D) + EPS);
        unsigned long long* o8 = (unsigned long long*)orow[r] + lane;
#pragma unroll
        for (int j = 0; j < 4; ++j)
            o8[64 * j] = (unsigned long long)pk2(v[r][j].x * rstd * ww[j].x, v[r][j].y * rstd * ww[j].y) | ((unsigned long long)pk2(v[r][j].z * rstd * ww[j].z, v[r][j].w * rstd * ww[j].w) << 32); }
}
constexpr int I_IN = (D / 64) * (INC / 32), I_AO = (AW / 64) * (D / 32), I_O = (D / 64) * (D / 32), I_G = (D / 64) * (FF / 32), I_D = (FF / 64) * (D / 32);
constexpr int I_EFF = (PW / 4) * (D / 4) / 64;
__device__ __forceinline__ void weff_item(Frame& F, int o) {
    const int kb = o / (D / 4), n0 = (o % (D / 4)) * 4, k0 = kb * 4, g = k0 / 128;
    const float* gwr = F.pgw + (size_t)k0 * 128; const float* wr = F.wpo + (size_t)(g * 128) * D + n0; const float* sc = F.pscale + g * 128;
    f32x4 s0 = {0.f, 0.f, 0.f, 0.f}, s1 = s0, s2 = s0, s3 = s0;
#pragma unroll 16
    for (int d = 0; d < 128; ++d) { const f32x4 wv = *(const f32x4*)(wr + (size_t)d * D) * sc[d];
        s0 += wv * gwr[d]; s1 += wv * gwr[128 + d]; s2 += wv * gwr[256 + d]; s3 += wv * gwr[384 + d]; }
#pragma unroll
    for (int j = 0; j < 4; ++j) { u32x2 w; w.x = pk2(s0[j], s1[j]); w.y = pk2(s2[j], s3[j]); *(u32x2*)(F.Wcat_t + (size_t)(n0 + j) * KC + k0) = w; }
}
__device__ __forceinline__ TrDesc tr_desc(const Frame& F, int q, int r) {
    if (q == 2) return TrDesc{F.win, nullptr, F.Win_t, D, INC, 0, D, r};
    if (q == 1) return TrDesc{F.wd, nullptr, F.Wd_t, FF, D, 0, FF, r};
    if (r < I_AO) return TrDesc{F.wao, nullptr, F.Wcat_t + PW, AW, D, 0, KC, r};
    r -= I_AO; if (r < I_O) return TrDesc{F.wo, nullptr, F.Wo_t, D, D, 0, D, r};
    r -= I_O; if (r < I_G) return TrDesc{F.wg, F.ffnw, F.Wgu_t, D, FF, 1, D, r};
    r -= I_G; return TrDesc{F.wu, F.ffnw, F.Wgu_t, D, FF, 2, D, r};
}
__device__ __forceinline__ void tr_run(const Frame& F, int q, int first, int stride, int total, LAS float* scr) {
    if (first >= total) return;
    float va[32], vb[32];
    TrDesc da = tr_desc(F, q, first), db = da; tr_load(da, F.lane, va);
    for (int it = first; it < total; it += 2 * stride) {
        const bool hb = it + stride < total, ha = it + 2 * stride < total;
        tr_to_lds(da, F.lane, va, scr); if (hb) { db = tr_desc(F, q, it + stride); tr_load(db, F.lane, vb); } tr_store(da, F.lane, scr);
        if (!hb) break;
        tr_to_lds(db, F.lane, vb, scr); if (ha) { da = tr_desc(F, q, it + 2 * stride); tr_load(da, F.lane, va); } tr_store(db, F.lane, scr);
    }
}
__device__ __forceinline__ void p0_prologue(Frame& F) {
    LAS float* scr = (LAS float*)(F.lds + F.wave * 16384);
    const int gw = F.vcu * NWAVES + F.wave, NGW = F.G * NWAVES;
    tr_run(F, 2, gw, NGW, I_IN, scr);
    if (M % (NGW * 4) == 0) {
        const int rpw = M / NGW;
        for (int r0 = 0; r0 < rpw; r0 += 4) {
            const float* xr[4]; bf16* orw[4];
#pragma unroll
            for (int r = 0; r < 4; ++r) { const size_t m = (size_t)gw * rpw + r0 + r; xr[r] = F.x + m * D; orw[r] = F.XN + m * D; }
            rms_rows_to_bf16<4>(xr, F.mixw, orw, F.lane);
        }
    } else
    for (int gidx = gw; gidx < M / 4; gidx += NGW) {
        const float* xr[4]; bf16* orw[4];
#pragma unroll
        for (int r = 0; r < 4; ++r) { const size_t m = (size_t)gidx + (size_t)r * (M / 4); xr[r] = F.x + m * D; orw[r] = F.XN + m * D; }
        rms_rows_to_bf16<4>(xr, F.mixw, orw, F.lane);
    }
    for (int m = M + gw; m < MP; m += NGW) {
        if (m < M + NMETA) { const float* xr[1] = {F.meta + (size_t)(m - M) * D}; bf16* orw[1] = {F.XN + (size_t)m * D}; rms_rows_to_bf16<1>(xr, F.mixw, orw, F.lane); }
        else { unsigned long long* o8 = (unsigned long long*)(F.XN + (size_t)m * D) + F.lane;
#pragma unroll
            for (int j = 0; j < 4; ++j) o8[64 * j] = 0ull; }
    }
}
__device__ __forceinline__ void deferred_weights(Frame& F, int q, int ntiles) {
    LAS float* scr = (LAS float*)(F.lds + F.wave * 16384);
    const int busy = ntiles % F.G, c = (int)blockIdx.x;
    int rank, count; if (busy == 0) { rank = c; count = F.G; } else { if (c < busy) return; rank = c - busy; count = F.G - busy; }
    const int w0 = rank * NWAVES + F.wave, nw = count * NWAVES;
    if (q == 1) { tr_run(F, 1, w0, nw, I_D, scr); return; }
    constexpr int T0 = I_AO + I_O + 2 * I_G, QA = 2;
    if (nw > I_EFF && QA * I_EFF <= T0) {
        if (w0 < I_EFF) { tr_run(F, 0, QA * w0, 1, QA * w0 + QA, scr); weff_item(F, w0 * 64 + F.lane); }
        else tr_run(F, 0, QA * I_EFF + (w0 - I_EFF), nw - I_EFF, T0, scr);
    } else {
        tr_run(F, 0, w0, nw, T0, scr);
        for (int r = w0; r < I_EFF; r += nw) weff_item(F, r * 64 + F.lane);
    }
}

namespace pg8 {
#define PG8_LAS __attribute__((address_space(3)))
typedef unsigned short bf16_t;
typedef short bf16x8 __attribute__((ext_vector_type(8)));
typedef float f32x4 __attribute__((ext_vector_type(4)));
typedef unsigned u32x4 __attribute__((ext_vector_type(4)));
constexpr int BM = 256, BK = 64, HALF = 128, HTB = HALF * BK * 2  , STAGE_BYTES = 8 * HTB, NXCD = 8, WGM = 4;

__host__ __device__ __forceinline__ int lds_byte(int r, int c) { const int st = (r >> 4) * 2 + (c >> 5), rr = r & 15, cc = c & 31, ob = rr * 64 + cc * 2; return st * 1024 + (ob ^ (((ob >> 9) & 1) << 5)); }
__host__ __device__ __forceinline__ void stage_rc(int b, int& R, int& C) { const int st = b / 1024, sb = b % 1024, swz = sb ^ (((sb >> 9) & 1) << 5); R = (st >> 1) * 16 + swz / 64; C = (st & 1) * 32 + (swz % 64) / 2; }
__host__ __device__ __forceinline__ int perm32(int rho) { const int n = rho >> 4, i = rho & 15; return 8 * (i >> 2) + 4 * n + (i & 3); }

struct Unit { int pm, pn; };
struct Gemm { const bf16_t* A; const bf16_t* Bt; int M, N, K; };

struct StaticOrder {
    int nM, nN, nwg, G, c;
    __host__ __device__ void init(int M, int N, int G_, int c_) { nM = M / BM; nN = N / BM; nwg = nM * nN; G = G_; c = c_; }
    __host__ __device__ bool next(int i, Unit& u) const {
        const long L = (long)i * G + c; if (L >= nwg) return false;
        int wgid = (int)L; { const int q = nwg / NXCD, r = nwg % NXCD, xcd = wgid % NXCD, off = wgid / NXCD; wgid = (xcd < r ? xcd * (q + 1) : r * (q + 1) + (xcd - r) * q) + off; }
        const int nig = WGM * nN, gid = wgid / nig, fm = gid * WGM, gsz = (nM - fm) < WGM ? (nM - fm) : WGM;
        u.pm = fm + ((wgid % nig) % gsz); u.pn = (wgid % nig) / gsz; return true;
    }
    __device__ __forceinline__ void a_ready(const Unit&) const {}
    __device__ __forceinline__ void done(const Unit&) const {}
};

__device__ __forceinline__ unsigned cvt_pk_bf16(float lo, float hi) { unsigned r; asm volatile("v_cvt_pk_bf16_f32 %0, %1, %2" : "=v"(r) : "v"(lo), "v"(hi)); return r; }
template <class E, class = void> struct MidT { static constexpr int v = -1; };
template <class E> struct MidT<E, decltype((void)E::MID_T)> { static constexpr int v = E::MID_T; };
template <class Epi, class Sched, bool ALIGN_EPI = false, bool SP2 = false>
__device__ __forceinline__ void gemm_phase(PG8_LAS unsigned char* lds, const Gemm g, const Sched& S, const Epi& E, const int wid, const int lane) {
    const int tid = wid * 64 + lane, wr = wid >> 2, wc = wid & 3, fr = lane & 15, fq = lane >> 4;
    const int K = g.K, nt = K / BK;
    unsigned voffA[2], voffB[2];
#pragma unroll
    for (int i = 0; i < 2; ++i) { int R, C; stage_rc(tid * 16 + i * 8192, R, C); const int Rb = Epi::PERM ? ((R & ~31) + perm32(R & 31)) : R;
        voffA[i] = (unsigned)(R * K + C) * 2u; voffB[i] = (unsigned)(Rb * K + C) * 2u; }
    const size_t kstep = (size_t)(BK * 2);
    const size_t hstep = (size_t)HALF * K * 2;
    const size_t tstep = 2 * hstep;
    const unsigned ldsw = (unsigned)wid * 1024u;
    const int aoff = lds_byte(wr * 64 + fr, fq * 8), boff = lds_byte(wc * 32 + fr, fq * 8);
#define PG8_SA(b, h) (((b) * 2 + (h)) * HTB)
#define PG8_SB(b, h) ((4 + (b) * 2 + (h)) * HTB)
#define PG8_STAGE(bufoff, gbase, voff) do { _Pragma("unroll") for (int _i = 0; _i < 2; ++_i) \
        __builtin_amdgcn_global_load_lds((const unsigned*)((const char*)(gbase) + (voff)[_i]), (PG8_LAS unsigned*)(lds + (bufoff) + ldsw + _i * 8192), 16, 0, 0); } while (0)
#define PG8_LDA(dst, b, h) do { _Pragma("unroll") for (int m = 0; m < 4; ++m) _Pragma("unroll") for (int k = 0; k < 2; ++k) dst[m][k] = *(const PG8_LAS bf16x8*)(lds + PG8_SA(b, h) + aoff + m * 2048 + k * 1024); } while (0)
#define PG8_LDB(dst, b, h) do { _Pragma("unroll") for (int n = 0; n < 2; ++n) _Pragma("unroll") for (int k = 0; k < 2; ++k) dst[n][k] = *(const PG8_LAS bf16x8*)(lds + PG8_SB(b, h) + boff + n * 2048 + k * 1024); } while (0)
#define PG8_MMA(ai, bj, At, Bt) do { __builtin_amdgcn_s_setprio(1); _Pragma("unroll") for (int m = 0; m < 4; ++m) _Pragma("unroll") for (int n = 0; n < 2; ++n) _Pragma("unroll") for (int k = 0; k < 2; ++k) \
        acc[ai][bj][m][n] = __builtin_amdgcn_mfma_f32_16x16x32_bf16(Bt[n][k], At[m][k], acc[ai][bj][m][n], 0, 0, 0); __builtin_amdgcn_s_setprio(0); } while (0)
#define PG8_WAIT_V(n) asm volatile("s_waitcnt vmcnt(" #n ")" ::: "memory")
#define PG8_WAIT_L(n) asm volatile("s_waitcnt lgkmcnt(" #n ")" ::: "memory")
#define PG8_BAR __builtin_amdgcn_s_barrier()
#define PG8_SCHED __builtin_amdgcn_sched_barrier(0)
    Unit cur, nxt; int ui = 0;
    if (!S.next(0, cur)) return;
    f32x4 acc[2][2][4][2];
#pragma unroll
    for (int a = 0; a < 2; ++a)
#pragma unroll
        for (int b = 0; b < 2; ++b)
#pragma unroll
            for (int m = 0; m < 4; ++m)
#pragma unroll
                for (int n = 0; n < 2; ++n) acc[a][b][m][n] = (f32x4){0.f, 0.f, 0.f, 0.f};
    bf16x8 At[4][2], B0[2][2], B1[2][2];
    const char* cA = (const char*)g.A + (size_t)cur.pm * tstep; const char* cB = (const char*)g.Bt + (size_t)cur.pn * tstep;
    S.a_ready(cur);
    if constexpr (SP2) {
        PG8_STAGE(PG8_SB(0, 0), cB, voffB); PG8_STAGE(PG8_SB(0, 1), cB + hstep, voffB); PG8_STAGE(PG8_SA(0, 0), cA, voffA); PG8_STAGE(PG8_SA(0, 1), cA + hstep, voffA);
        if (wr == 1) PG8_BAR;
        PG8_WAIT_V(2); PG8_BAR;
        PG8_STAGE(PG8_SB(1, 0), cB + kstep, voffB); PG8_STAGE(PG8_SA(1, 0), cA + kstep, voffA); PG8_STAGE(PG8_SB(1, 1), cB + hstep + kstep, voffB);
        PG8_WAIT_V(6); PG8_BAR;
    } else {
        PG8_STAGE(PG8_SB(0, 0), cB, voffB); PG8_STAGE(PG8_SA(0, 0), cA, voffA); PG8_STAGE(PG8_SB(0, 1), cB + hstep, voffB); PG8_STAGE(PG8_SA(0, 1), cA + hstep, voffA);
        if (wr == 1) PG8_BAR;
        PG8_WAIT_V(4); PG8_BAR;
        PG8_STAGE(PG8_SB(1, 0), cB + kstep, voffB); PG8_STAGE(PG8_SA(1, 0), cA + kstep, voffA); PG8_STAGE(PG8_SB(1, 1), cB + hstep + kstep, voffB);
        PG8_WAIT_V(6); PG8_BAR;
    }
    for (;;) {
        const bool has_next = S.next(ui + 1, nxt);
        const char* nA = has_next ? (const char*)g.A + (size_t)nxt.pm * tstep : cA; const char* nB = has_next ? (const char*)g.Bt + (size_t)nxt.pn * tstep : cB;
        for (int t = 0; t < nt; t += 2) {
            if constexpr (MidT<Epi>::v >= 0) { if (t == MidT<Epi>::v) { PG8_SCHED; E.mid(acc, cur, wr, wc, fr, fq); PG8_SCHED; } }
            const bool last = (t == nt - 2);
            const char* a1 = cA + (size_t)(t + 1) * kstep;
            const char* a2 = last ? nA : cA + (size_t)(t + 2) * kstep; const char* b2 = last ? nB : cB + (size_t)(t + 2) * kstep;
            const char* a3 = a2 + kstep; const char* b3 = b2 + kstep;
            if (last && has_next) S.a_ready(nxt);
            if constexpr (SP2) {
            PG8_LDB(B0, 0, 0); PG8_LDB(B1, 0, 1); PG8_SCHED; PG8_LDA(At, 0, 0); PG8_STAGE(PG8_SA(1, 1), a1 + hstep, voffA);
            PG8_WAIT_V(8); PG8_WAIT_L(0); PG8_BAR; PG8_MMA(0, 0, At, B0); PG8_MMA(0, 1, At, B1); PG8_BAR; PG8_SCHED;
            PG8_LDA(At, 0, 1); PG8_STAGE(PG8_SB(0, 0), b2, voffB); PG8_STAGE(PG8_SB(0, 1), b2 + hstep, voffB); PG8_STAGE(PG8_SA(0, 0), a2, voffA);
            PG8_WAIT_V(8); PG8_WAIT_L(0); PG8_BAR; PG8_MMA(1, 0, At, B0); PG8_MMA(1, 1, At, B1); PG8_BAR; PG8_SCHED;
            PG8_LDB(B0, 1, 0); PG8_LDB(B1, 1, 1); PG8_SCHED; PG8_LDA(At, 1, 0); PG8_STAGE(PG8_SA(0, 1), a2 + hstep, voffA);
            PG8_WAIT_V(8); PG8_WAIT_L(0); PG8_BAR; PG8_MMA(0, 0, At, B0); PG8_MMA(0, 1, At, B1); PG8_BAR; PG8_SCHED;
            PG8_LDA(At, 1, 1); PG8_STAGE(PG8_SB(1, 0), b3, voffB); PG8_STAGE(PG8_SB(1, 1), b3 + hstep, voffB); PG8_STAGE(PG8_SA(1, 0), a3, voffA);
            PG8_WAIT_V(8); PG8_WAIT_L(0); PG8_BAR; PG8_MMA(1, 0, At, B0); PG8_MMA(1, 1, At, B1); PG8_BAR; PG8_SCHED;
            } else {
            PG8_LDB(B0, 0, 0); PG8_SCHED; PG8_LDA(At, 0, 0); PG8_STAGE(PG8_SA(1, 1), a1 + hstep, voffA);
            PG8_WAIT_L(8); PG8_BAR; PG8_WAIT_L(0); PG8_MMA(0, 0, At, B0); PG8_BAR; PG8_SCHED;
            PG8_LDB(B1, 0, 1); PG8_STAGE(PG8_SB(0, 0), b2, voffB);
            PG8_BAR; PG8_WAIT_L(0); PG8_MMA(0, 1, At, B1); PG8_BAR;
            PG8_LDA(At, 0, 1); PG8_STAGE(PG8_SA(0, 0), a2, voffA);
            PG8_BAR; PG8_WAIT_L(0); PG8_MMA(1, 0, At, B0); PG8_BAR; PG8_SCHED;
            PG8_STAGE(PG8_SB(0, 1), b2 + hstep, voffB);
            PG8_WAIT_V(6); PG8_BAR; PG8_MMA(1, 1, At, B1); PG8_BAR;
            PG8_LDB(B0, 1, 0); PG8_SCHED; PG8_LDA(At, 1, 0); PG8_STAGE(PG8_SA(0, 1), a2 + hstep, voffA);
            PG8_WAIT_L(8); PG8_BAR; PG8_WAIT_L(0); PG8_MMA(0, 0, At, B0); PG8_BAR; PG8_SCHED;
            PG8_LDB(B1, 1, 1); PG8_STAGE(PG8_SB(1, 0), b3, voffB);
            PG8_BAR; PG8_WAIT_L(0); PG8_MMA(0, 1, At, B1); PG8_BAR;
            PG8_LDA(At, 1, 1); PG8_STAGE(PG8_SA(1, 0), a3, voffA);
            PG8_BAR; PG8_WAIT_L(0); PG8_MMA(1, 0, At, B0); PG8_BAR; PG8_SCHED;
            PG8_STAGE(PG8_SB(1, 1), b3 + hstep, voffB);
            PG8_WAIT_V(6); PG8_BAR; PG8_MMA(1, 1, At, B1); PG8_BAR;
            }
        }
        if constexpr (ALIGN_EPI) { if (wr == 0) PG8_BAR; }
        if constexpr (!Epi::AFTER_DRAIN) { E(acc, cur, wr, wc, fr, fq); S.done(cur); }
        if (!has_next) break;
#pragma unroll
        for (int a = 0; a < 2; ++a)
#pragma unroll
            for (int b = 0; b < 2; ++b)
#pragma unroll
                for (int m = 0; m < 4; ++m)
#pragma unroll
                    for (int n = 0; n < 2; ++n) acc[a][b][m][n] = (f32x4){0.f, 0.f, 0.f, 0.f};
        cur = nxt; cA = nA; cB = nB; ++ui;
        if constexpr (ALIGN_EPI) { if (wr == 1) PG8_BAR; }
    }
    PG8_WAIT_V(0);
    if constexpr (!ALIGN_EPI) { if (wr == 0) PG8_BAR; }
    PG8_BAR;
    if constexpr (Epi::AFTER_DRAIN) { E.fused(acc, cur, wr, wc, fr, fq, lds, wid, lane); S.done(cur); }
#undef PG8_SA
#undef PG8_SB
#undef PG8_STAGE
#undef PG8_LDA
#undef PG8_LDB
#undef PG8_MMA
#undef PG8_WAIT_V
#undef PG8_WAIT_L
#undef PG8_BAR
#undef PG8_SCHED
}
}

struct EpiP1 {
    bf16 *UP, *Qb, *Kb, *Vb, *GP, *GA;
    __device__ __forceinline__ void store8(int row, int col, f32x4 a, f32x4 b) const {
        bf16* dst; int c;
        if (col < 512) { dst = UP + (size_t)row * PW; c = col; }
        else if (col < 1536) { if (row >= M) return; dst = Qb + (size_t)row * AW; c = col - 512; a = a * QSCALE; b = b * QSCALE; }
        else if (col < 2560) { dst = Kb + (size_t)row * AW; c = col - 1536; }
        else if (col < 3584) { dst = Vb + (size_t)row * AW; c = col - 2560; }
        else { if (row >= M) return; const bool ga = col >= 4608; dst = (ga ? GA : GP) + (size_t)row * D; c = col - (ga ? 4608 : 3584);
#pragma unroll
            for (int i = 0; i < 4; ++i) { a[i] = sigmoidf_(a[i]); b[i] = sigmoidf_(b[i]); } }
        u32x4 w; w.x = pk2(a[0], a[1]); w.y = pk2(a[2], a[3]); w.z = pk2(b[0], b[1]); w.w = pk2(b[2], b[3]);
        *(u32x4*)(dst + c) = w;
    }
};
struct EpiP3 {
    static constexpr bool PERM = true, AFTER_DRAIN = false; static constexpr int MID_T = PW / 64;
    const bf16 *GP, *GA; bf16* MERGED;
    __device__ __forceinline__ static float gsafe(float g) { return __builtin_fmaxf(g, 8.6736174e-19f); }
    __device__ __forceinline__ void mid(f32x4 (&acc)[2][2][4][2], const pg8::Unit& u, int wr, int wc, int fr, int fq) const {
        asm volatile("" : "+v"(fr), "+v"(fq));
        const int row0 = u.pm * 256 + wr * 64 + fr, col0 = u.pn * 256 + wc * 32 + 8 * fq;
#pragma unroll
        for (int ai = 0; ai < 2; ++ai)
#pragma unroll
            for (int m = 0; m < 4; ++m) { const size_t ro = (size_t)(row0 + ai * 128 + m * 16) * D + col0;
#pragma unroll
                for (int bj = 0; bj < 2; ++bj) { const u32x4 p = *(const u32x4*)(GP + ro + bj * 128), a = *(const u32x4*)(GA + ro + bj * 128);
                    f32x4& x = acc[ai][bj][m][0]; f32x4& y = acc[ai][bj][m][1];
                    x[0] *= bflo(p.x) * __builtin_amdgcn_rcpf(gsafe(bflo(a.x))); x[1] *= bfhi(p.x) * __builtin_amdgcn_rcpf(gsafe(bfhi(a.x)));
                    x[2] *= bflo(p.y) * __builtin_amdgcn_rcpf(gsafe(bflo(a.y))); x[3] *= bfhi(p.y) * __builtin_amdgcn_rcpf(gsafe(bfhi(a.y)));
                    y[0] *= bflo(p.z) * __builtin_amdgcn_rcpf(gsafe(bflo(a.z))); y[1] *= bfhi(p.z) * __builtin_amdgcn_rcpf(gsafe(bfhi(a.z)));
                    y[2] *= bflo(p.w) * __builtin_amdgcn_rcpf(gsafe(bflo(a.w))); y[3] *= bfhi(p.w) * __builtin_amdgcn_rcpf(gsafe(bfhi(a.w))); }
                asm volatile("" : "+v"(acc[ai][0][m][0]), "+v"(acc[ai][0][m][1]), "+v"(acc[ai][1][m][0]), "+v"(acc[ai][1][m][1]));
                asm volatile("" ::: "memory"); }
    }
    __device__ __forceinline__ void operator()(const f32x4 (&acc)[2][2][4][2], const pg8::Unit& u, int wr, int wc, int fr, int fq) const {
        const int row0 = u.pm * 256 + wr * 64 + fr, col0 = u.pn * 256 + wc * 32 + 8 * fq;
#pragma unroll
        for (int ai = 0; ai < 2; ++ai)
#pragma unroll
            for (int m = 0; m < 4; ++m) { const size_t ro = (size_t)(row0 + ai * 128 + m * 16) * D + col0;
#pragma unroll
                for (int bj = 0; bj < 2; ++bj) { const u32x4 a = *(const u32x4*)(GA + ro + bj * 128); const f32x4 x = acc[ai][bj][m][0], y = acc[ai][bj][m][1];
                    u32x4 w; w.x = pk2(x[0] * gsafe(bflo(a.x)), x[1] * gsafe(bfhi(a.x))); w.y = pk2(x[2] * gsafe(bflo(a.y)), x[3] * gsafe(bfhi(a.y)));
                    w.z = pk2(y[0] * gsafe(bflo(a.z)), y[1] * gsafe(bfhi(a.z))); w.w = pk2(y[2] * gsafe(bflo(a.w)), y[3] * gsafe(bfhi(a.w)));
                    *(u32x4*)(MERGED + ro + bj * 128) = w; } }
    }
};
struct EpiP4 {
    const float* x; bf16* HB;
    __device__ __forceinline__ float store8(int row, int col, f32x4 a, f32x4 b) const {
        const float* xr = x + (size_t)row * D + col; a = a + __builtin_nontemporal_load((const f32x4*)xr); b = b + __builtin_nontemporal_load((const f32x4*)(xr + 4));
        u32x4 w; w.x = pk2(a[0], a[1]); w.y = pk2(a[2], a[3]); w.z = pk2(b[0], b[1]); w.w = pk2(b[2], b[3]);
        *(u32x4*)(HB + (size_t)row * D + col) = w;
        return (a[0] * a[0] + a[1] * a[1]) + (a[2] * a[2] + a[3] * a[3]) + (b[0] * b[0] + b[1] * b[1]) + (b[2] * b[2] + b[3] * b[3]);
    }
};
struct EpiP5 {
    bf16* ACT;
    __device__ __forceinline__ void store8(int row, int ocol, float rstd, f32x4 g0, f32x4 g1, f32x4 u0, f32x4 u1) const {
        float r[8];
#pragma unroll
        for (int i = 0; i < 4; ++i) { const float ga = g0[i] * rstd, gb = g1[i] * rstd; r[i] = ga * sigmoidf_(ga) * (u0[i] * rstd); r[4 + i] = gb * sigmoidf_(gb) * (u1[i] * rstd); }
        u32x4 w; w.x = pk2(r[0], r[1]); w.y = pk2(r[2], r[3]); w.z = pk2(r[4], r[5]); w.w = pk2(r[6], r[7]);
        *(u32x4*)(ACT + (size_t)row * FF + ocol) = w;
    }
};
struct EpiP6 {
    const bf16* HB; float* H;
    __device__ __forceinline__ void store8(int row, int col, f32x4 a, f32x4 b) const {
        const u32x4 h = *(const u32x4*)(HB + (size_t)row * D + col); float* o = H + (size_t)row * D + col;
        a[0] += bflo(h.x); a[1] += bfhi(h.x); a[2] += bflo(h.y); a[3] += bfhi(h.y); b[0] += bflo(h.z); b[1] += bfhi(h.z); b[2] += bflo(h.w); b[3] += bfhi(h.w);
        *(f32x4*)o = a; *(f32x4*)(o + 4) = b;
    }
};

template <class Fn> struct Epi8 {
    static constexpr bool PERM = true, AFTER_DRAIN = false; Fn f;
    __device__ __forceinline__ void operator()(const f32x4 (&acc)[2][2][4][2], const pg8::Unit& u, int wr, int wc, int fr, int fq) const {
        const int row0 = u.pm * 256 + wr * 64 + fr, col0 = u.pn * 256 + wc * 32 + 8 * fq;
#pragma unroll
        for (int ai = 0; ai < 2; ++ai)
#pragma unroll
            for (int m = 0; m < 4; ++m) { const int row = row0 + ai * 128 + m * 16;
#pragma unroll
                for (int bj = 0; bj < 2; ++bj) f.store8(row, col0 + bj * 128, acc[ai][bj][m][0], acc[ai][bj][m][1]); }
    }
};
struct Epi8P1 {
    static constexpr bool PERM = true, AFTER_DRAIN = false; EpiP1 f;
    template <int CLS> __device__ __forceinline__ void half(const f32x4 (&acc)[2][2][4][2], int bj, int row0, int cb) const {
        bf16* base = CLS == 0 ? f.UP : CLS == 1 ? f.Qb : CLS == 2 ? f.Kb : CLS == 3 ? f.Vb : CLS == 4 ? f.GP : f.GA;
        constexpr int ldc = CLS == 0 ? PW : (CLS >= 4 ? D : AW);
#pragma unroll
        for (int ai = 0; ai < 2; ++ai)
#pragma unroll
            for (int m = 0; m < 4; ++m) { const int row = row0 + ai * 128 + m * 16; f32x4 a = bj ? acc[ai][1][m][0] : acc[ai][0][m][0], b = bj ? acc[ai][1][m][1] : acc[ai][0][m][1];
                if (CLS == 1) { a = a * QSCALE; b = b * QSCALE; }
                if (CLS >= 4) {
#pragma unroll
                    for (int i = 0; i < 4; ++i) { a[i] = sigmoidf_(a[i]); b[i] = sigmoidf_(b[i]); } }
                u32x4 w; w.x = pk2(a[0], a[1]); w.y = pk2(a[2], a[3]); w.z = pk2(b[0], b[1]); w.w = pk2(b[2], b[3]);
                *(u32x4*)(base + (size_t)row * ldc + cb) = w; }
    }
    __device__ __forceinline__ void operator()(const f32x4 (&acc)[2][2][4][2], const pg8::Unit& u, int wr, int wc, int fr, int fq) const {
        asm volatile("" : "+v"(fr), "+v"(fq));
        const int row0 = u.pm * 256 + wr * 64 + fr, lc = wc * 32 + 8 * fq;
        const bool meta_panel = u.pm >= M / 256;
#pragma unroll
        for (int bj = 0; bj < 2; ++bj) {
            const int colt = u.pn * 256 + bj * 128;
            if (colt < 512) half<0>(acc, bj, row0, colt + lc);
            else if (colt < 1536) { if (!meta_panel) half<1>(acc, bj, row0, colt - 512 + lc); }
            else if (colt < 2560) half<2>(acc, bj, row0, colt - 1536 + lc);
            else if (colt < 3584) half<3>(acc, bj, row0, colt - 2560 + lc);
            else if (colt < 4608) { if (!meta_panel) half<4>(acc, bj, row0, colt - 3584 + lc); }
            else { if (!meta_panel) half<5>(acc, bj, row0, colt - 4608 + lc); }
        }
    }
};
struct Epi8P4 {
    static constexpr bool PERM = true, AFTER_DRAIN = false; EpiP4 f; float* PART;
    __device__ __forceinline__ void operator()(const f32x4 (&acc)[2][2][4][2], const pg8::Unit& u, int wr, int wc, int fr, int fq) const {
        const int row0 = u.pm * 256 + wr * 64 + fr, col0 = u.pn * 256 + wc * 32 + 8 * fq;
#pragma unroll
        for (int ai = 0; ai < 2; ++ai)
#pragma unroll
            for (int m = 0; m < 4; ++m) { const int row = row0 + ai * 128 + m * 16;
                float s = f.store8(row, col0, acc[ai][0][m][0], acc[ai][0][m][1]) + f.store8(row, col0 + 128, acc[ai][1][m][0], acc[ai][1][m][1]);
                s += __shfl_xor(s, 16); s += __shfl_xor(s, 32);
                if (fq == 0) PART[(size_t)row * 16 + u.pn * 4 + wc] = s; }
    }
};
struct Epi8P5 {
    static constexpr bool PERM = true, AFTER_DRAIN = false; EpiP5 f; const float* PART;
    __device__ __forceinline__ void operator()(const f32x4 (&acc)[2][2][4][2], const pg8::Unit& u, int wr, int wc, int fr, int fq) const {
        const int row0 = u.pm * 256 + wr * 64 + fr, ocol = u.pn * 128 + wc * 32 + 8 * fq;
#pragma unroll
        for (int ai = 0; ai < 2; ++ai)
#pragma unroll
            for (int m = 0; m < 4; ++m) { const int row = row0 + ai * 128 + m * 16;
                const f32x4 p = *(const f32x4*)(PART + (size_t)row * 16 + 4 * fq); float s = (p.x + p.y) + (p.z + p.w);
                s += __shfl_xor(s, 16); s += __shfl_xor(s, 32);
                const float rstd = __builtin_amdgcn_rsqf(s * (1.f / D) + EPS);
                f.store8(row, ocol, rstd, acc[ai][0][m][0], acc[ai][0][m][1], acc[ai][1][m][0], acc[ai][1][m][1]); }
    }
};
struct EpiFinal {
    static constexpr bool PERM = true, AFTER_DRAIN = true;
    const bf16* HB; float* H; const float* finw; unsigned* xbuf; unsigned* cnt;
    __device__ __forceinline__ void fused(f32x4 (&acc)[2][2][4][2], const pg8::Unit& u, int wr, int wc, int fr, int fq, LAS unsigned char* lds, int wid, int lane) const {
        LAS float* P = (LAS float*)lds;
        LAS float* S = (LAS float*)(lds + 4096);
        const int row0 = u.pm * 256 + wr * 64 + fr, col0 = u.pn * 256 + wc * 32 + 8 * fq;
#pragma unroll
        for (int ai = 0; ai < 2; ++ai)
#pragma unroll
            for (int m = 0; m < 4; ++m) { const int row = row0 + ai * 128 + m * 16; float s = 0.f;
#pragma unroll
                for (int bj = 0; bj < 2; ++bj) { const u32x4 h = *(const u32x4*)(HB + (size_t)row * D + col0 + bj * 128);
                    const f32x4 a = acc[ai][bj][m][0] + (f32x4){bflo(h.x), bfhi(h.x), bflo(h.y), bfhi(h.y)}, b = acc[ai][bj][m][1] + (f32x4){bflo(h.z), bfhi(h.z), bflo(h.w), bfhi(h.w)}; acc[ai][bj][m][0] = a; acc[ai][bj][m][1] = b;
                    s += (a[0] * a[0] + a[1] * a[1]) + (a[2] * a[2] + a[3] * a[3]) + (b[0] * b[0] + b[1] * b[1]) + (b[2] * b[2] + b[3] * b[3]); }
                s += __shfl_xor(s, 16); s += __shfl_xor(s, 32);
                if (fq == 0) P[(ai * 128 + wr * 64 + m * 16 + fr) * 4 + wc] = s;
                if (m & 1) asm volatile("" ::: "memory"); }
        asm volatile("s_waitcnt lgkmcnt(0)" ::: "memory"); __builtin_amdgcn_s_barrier(); asm volatile("" ::: "memory");
        const int row = wid * 32 + (lane & 31);
        if (lane < 32) { const f32x4 p = *(const LAS f32x4*)(P + row * 4); const float t = (p.x + p.y) + (p.z + p.w);
            __hip_atomic_store(xbuf + ((size_t)(u.pm * 256 + row) * 4 + u.pn), __float_as_uint(t), __ATOMIC_RELAXED, __HIP_MEMORY_SCOPE_AGENT); }
        asm volatile("s_waitcnt vmcnt(0)" ::: "memory");
        if (lane == 0) __hip_atomic_fetch_add(cnt + 64 * u.pm, 1u, __ATOMIC_RELAXED, __HIP_MEMORY_SCOPE_AGENT);
        if (wid == 0) {
            for (unsigned sp = 0; sp < (1u << 22); ++sp) {
                if ((unsigned)__builtin_amdgcn_readfirstlane(__hip_atomic_load(cnt + 64 * u.pm, __ATOMIC_RELAXED, __HIP_MEMORY_SCOPE_AGENT)) >= 32u) break;
                __builtin_amdgcn_s_sleep(2); }
            __builtin_amdgcn_fence(__ATOMIC_ACQUIRE, "agent");
        }
        asm volatile("s_waitcnt vmcnt(0) lgkmcnt(0)" ::: "memory"); __builtin_amdgcn_s_barrier(); asm volatile("" ::: "memory");
        if (lane < 32) { const unsigned* slot = xbuf + (size_t)(u.pm * 256 + row) * 4; float t = 0.f;
#pragma unroll
            for (int k = 0; k < 4; ++k) t += __uint_as_float(__hip_atomic_load(slot + k, __ATOMIC_RELAXED, __HIP_MEMORY_SCOPE_AGENT));
            S[row] = 1.f / sqrtf(t * (1.f / D) + EPS); }
        asm volatile("s_waitcnt lgkmcnt(0)" ::: "memory"); __builtin_amdgcn_s_barrier(); asm volatile("" ::: "memory");
        f32x4 wv[2][2];
#pragma unroll
        for (int bj = 0; bj < 2; ++bj) { wv[bj][0] = *(const f32x4*)(finw + col0 + bj * 128); wv[bj][1] = *(const f32x4*)(finw + col0 + bj * 128 + 4); }
#pragma unroll
        for (int ai = 0; ai < 2; ++ai)
#pragma unroll
            for (int m = 0; m < 4; ++m) { const int r = ai * 128 + wr * 64 + m * 16 + fr; const float rs = S[r]; float* h = H + (size_t)(u.pm * 256 + r) * D + col0;
#pragma unroll
                for (int bj = 0; bj < 2; ++bj) { *(f32x4*)(h + bj * 128) = acc[ai][bj][m][0] * rs * wv[bj][0]; *(f32x4*)(h + bj * 128 + 4) = acc[ai][bj][m][1] * rs * wv[bj][1]; } }
    }
};
struct OrderP1 {
    pg8::StaticOrder so;
    __device__ void init(int G, int c) { so.init(M, INC, G, c); }
    __device__ bool next(int i, pg8::Unit& u) const {
        if (so.next(i, u)) return true;
        const long e = (long)i * so.G + so.c - so.nwg; if (e < 0 || e >= 10) return false;
        u.pm = M / 256; u.pn = (e < 2) ? (int)e : (int)e + 4; return true;
    }
    __device__ __forceinline__ void a_ready(const pg8::Unit&) const {}
    __device__ __forceinline__ void done(const pg8::Unit&) const {}
};

__device__ __forceinline__ void bf8_add(float (&s)[8], const u32x4 v, float sg) {
    s[0] += sg * bflo(v.x); s[1] += sg * bfhi(v.x); s[2] += sg * bflo(v.y); s[3] += sg * bfhi(v.y); s[4] += sg * bflo(v.z); s[5] += sg * bfhi(v.z); s[6] += sg * bflo(v.w); s[7] += sg * bfhi(v.w);
}
__device__ __forceinline__ void pool_phase(Frame& F) {
    constexpr int RUN = 8;
    const long total = (long)(M / RUN) * (PW / 8);
    for (long it = (long)blockIdx.x * NTHR + F.tid; it < total; it += (long)F.G * NTHR) {
        const int m0 = (int)(it / (PW / 8)) * RUN, c0 = (int)(it % (PW / 8)) * 8, b = m0 / SEQ, t0 = m0 % SEQ, g = c0 / 128, w = 2 << g;
        const float iw = 1.f / (float)w;
        auto urow = [&](int tt) -> const bf16* { return F.UP + ((tt >= 0) ? (size_t)(b * SEQ + tt) : (size_t)(M + NMETA + tt)) * PW + c0; };
        float s[8];
#pragma unroll
        for (int j = 0; j < 8; ++j) s[j] = 0.f;
        for (int i = 1; i < w; ++i) bf8_add(s, *(const u32x4*)urow(t0 - i), 1.f);
#pragma unroll
        for (int r = 0; r < RUN; ++r) { const int t = t0 + r;
            const u32x4 self = *(const u32x4*)urow(t); bf8_add(s, self, 1.f);
            u32x4 o; o.x = pk2(s[0] * iw - bflo(self.x), s[1] * iw - bfhi(self.x)); o.y = pk2(s[2] * iw - bflo(self.y), s[3] * iw - bfhi(self.y));
            o.z = pk2(s[4] * iw - bflo(self.z), s[5] * iw - bfhi(self.z)); o.w = pk2(s[6] * iw - bflo(self.w), s[7] * iw - bfhi(self.w));
            *(u32x4*)(F.ACAT + (size_t)(m0 + r) * KC + c0) = o;
            if (r + 1 < RUN) bf8_add(s, *(const u32x4*)urow(t - w + 1), -1.f); }
    }
}

__device__ __forceinline__ int t5_bucket(int rel) {
    const int n = rel < 0 ? -rel : rel; int r = rel > 0 ? 16 : 0;
    int v;
    if (n < 8) v = n; else if (n < 12) v = 8; else if (n < 16) v = 9; else if (n < 23) v = 10; else if (n < 32) v = 11; else if (n < 46) v = 12; else if (n < 64) v = 13; else if (n < 91) v = 14; else v = 15;
    return r + v;
}
__device__ __forceinline__ float compute_lambda(const Frame& F) {
    float a = 0.f, b = 0.f;
    for (int i = 0; i < HD; ++i) { a += F.lq1[i] * F.lk1[i]; b += F.lq2[i] * F.lk2[i]; }
    return __expf(a) - __expf(b) + 0.2f;
}
namespace attn {
typedef short bf16x8 __attribute__((ext_vector_type(8)));
typedef short s16x4 __attribute__((ext_vector_type(4)));
typedef float f32x16 __attribute__((ext_vector_type(16)));
typedef short v4i16_t __attribute__((ext_vector_type(4)));
typedef LAS const char* lds_cptr;
constexpr int RSLOT = 16384, LDS_KR = 0, LDS_VR = 3 * RSLOT;
constexpr int STG_PITCH = 132;
constexpr int LDS_WS = 6 * RSLOT, LDS_BIAS = LDS_WS + 2048, NBIAS = 320;
constexpr int THR = 8;
static_assert(128 * STG_PITCH * 4 <= LDS_WS && LDS_BIAS + NBIAS * 4 <= RING_BYTES, "attention LDS map");
__device__ __forceinline__ int crow(int r, int hi) { return (r & 3) + 8 * (r >> 2) + 4 * hi; }
__device__ __forceinline__ void glds16s(const void* sbase, unsigned voff, unsigned lds_dst) { unsigned keep;
    asm volatile("s_nop 4\n\ts_mov_b32 %0, m0\n\ts_mov_b32 m0, %3\n\ts_nop 0\n\tglobal_load_lds_dwordx4 %1, %2\n\ts_mov_b32 m0, %0" : "=&s"(keep) : "v"(voff), "s"(sbase), "s"(lds_dst) : "memory"); }
typedef float f32x2_t __attribute__((ext_vector_type(2))); typedef __bf16 bf16x2_t __attribute__((ext_vector_type(2)));
__device__ __forceinline__ unsigned cvtpk(float lo, float hi) { f32x2_t v = {lo, hi}; bf16x2_t b = __builtin_convertvector(v, bf16x2_t); return __builtin_bit_cast(unsigned, b); }
__device__ __forceinline__ s16x4 vtr(lds_cptr p) { return __builtin_bit_cast(s16x4, __builtin_amdgcn_ds_read_tr16_b64_v4i16((LAS v4i16_t*)p)); }
#define ATT_WAIT_BAR() asm volatile("s_waitcnt vmcnt(0) lgkmcnt(0)\n\ts_barrier" ::: "memory")
#define ATT_MX3(a, b, c) __builtin_fmaxf(__builtin_fmaxf((a), (b)), (c))
__device__ __forceinline__ float rowmax(const f32x16& p0, const f32x16& p1) {
    float a = ATT_MX3(p0[0], p0[1], p1[0]), b = ATT_MX3(p0[2], p0[3], p1[1]); a = ATT_MX3(a, p1[2], p1[3]);
#pragma unroll
    for (int r = 4; r < 16; r += 4) { a = ATT_MX3(a, p0[r], p0[r + 1]); b = ATT_MX3(b, p0[r + 2], p0[r + 3]); a = ATT_MX3(a, p1[r], p1[r + 1]); b = ATT_MX3(b, p1[r + 2], p1[r + 3]); }
    float m = __builtin_fmaxf(a, b); auto rr = __builtin_amdgcn_permlane32_swap(__float_as_uint(m), __float_as_uint(m), false, false);
    return __builtin_fmaxf(__uint_as_float(rr[0]), __uint_as_float(rr[1]));
}

__device__ __forceinline__ void pv_tile(f32x16 (&o)[4], const u32x4 (&pw)[4], const lds_cptr vp) {
#pragma unroll
    for (int db = 0; db < 4; ++db)
#pragma unroll
        for (int ks = 0; ks < 4; ++ks) {
            const s16x4 lo = vtr(vp + db * 4096 + ks * 1024), hh = vtr(vp + db * 4096 + ks * 1024 + 512);
            const bf16x8 vf = (bf16x8){lo[0], lo[1], lo[2], lo[3], hh[0], hh[1], hh[2], hh[3]};
            o[db] = __builtin_amdgcn_mfma_f32_32x32x16_bf16(__builtin_bit_cast(bf16x8, pw[ks]), vf, o[db], 0, 0, 0);
        }
}
#define ATT_SBAR() __builtin_amdgcn_sched_barrier(0)
#define ATT_PIN(x) asm volatile("" : "+v"(x))
#define ATT_MFMA(a, b, c) __builtin_amdgcn_mfma_f32_32x32x16_bf16(a, b, c, 0, 0, 0)

__device__ __forceinline__ void attn_unit(const Frame& F, int b, int h, int qb, float lam) {
    int lane = F.lane; asm volatile("" : "+v"(lane));
    const int r32 = lane & 31, hi = lane >> 5, wid = F.wave, rg = wid & 3, map = wid >> 2;
    const int q0w = qb * 128 + rg * 32;
    const size_t rowbase = (size_t)b * SEQ;
    const LAS unsigned char* lds = F.lds;
    const unsigned lds0 = (unsigned)(uintptr_t)lds;
    LAS float* wsf = (LAS float*)(lds + LDS_WS) + wid * 64;
    const LAS float* tb = (const LAS float*)(lds + LDS_BIAS);
    const int NT = 2 * qb + 3;
    const unsigned kvoff = (unsigned)(lane * AW + wid * 8) * 2u;
    const unsigned vvoff = (unsigned)((16 * (wid & 3) + (lane >> 2)) * AW + (wid >> 2) * 32 + (lane & 3) * 8) * 2u;
    const unsigned pdst = lds0 + wid * 1024;
#define ATT_TROW(t) ((t) == 0 ? (size_t)M : rowbase + (size_t)64 * ((t) - 1))
#define ATT_DMA_K(t, slot) do { const bf16* kb_ = F.Kb + ATT_TROW(t) * AW + h * 128; const unsigned d_ = (unsigned)__builtin_amdgcn_readfirstlane(pdst + LDS_KR + (slot)); \
        glds16s(kb_, kvoff, d_); glds16s(kb_ + 64, kvoff, d_ + 8192); } while (0)
#define ATT_DMA_V(t, slot) do { const bf16* vb_ = F.Vb + ATT_TROW(t) * AW + h * 128; const unsigned d_ = (unsigned)__builtin_amdgcn_readfirstlane(pdst + LDS_VR + (slot)); \
        glds16s(vb_, vvoff, d_); glds16s(vb_ + 64, vvoff, d_ + 8192); } while (0)
    ATT_DMA_K(0, 0); ATT_DMA_V(0, 0); ATT_DMA_K(1, RSLOT);
    bf16x8 qr[4];
    { const bf16* Qw = F.Qb + (rowbase + q0w + r32) * AW + h * 128 + map * 64 + hi * 8;
#pragma unroll
      for (int d0 = 0; d0 < 4; ++d0) qr[d0] = *(const bf16x8*)(Qw + d0 * 16); }
    float mhat = 0.f, l_reg = 0.f; f32x16 o[4]; f32x16 negm = f32x16{};
#pragma unroll
    for (int i = 0; i < 4; ++i) o[i] = f32x16{};
    const lds_cptr kp0 = (lds_cptr)lds + LDS_KR + map * 8192 + hi * 1024 + r32 * 16;
    const lds_cptr vp0 = (lds_cptr)lds + LDS_VR + ((lane >> 4) & 1) * 32 + (lane & 3) * 8 + (4 * hi + ((lane & 15) >> 2)) * 64;
    const bool last_active = rg >= 2;
    bf16x8 kf[8];
#define ATT_KLOAD(kp_, j) do { kf[2 * (j)] = *(const LAS bf16x8*)((kp_) + (j) * 2048); kf[2 * (j) + 1] = *(const LAS bf16x8*)((kp_) + (j) * 2048 + 512); } while (0)
    ATT_WAIT_BAR();
    f32x16 pA0, pA1, pB0, pB1;
    ATT_DMA_K(2, 2 * RSLOT); ATT_DMA_V(1, RSLOT);
    { ATT_KLOAD(kp0, 0); ATT_KLOAD(kp0, 1); ATT_KLOAD(kp0, 2); ATT_KLOAD(kp0, 3);
      pA0 = ATT_MFMA(kf[0], qr[0], f32x16{}); pA1 = ATT_MFMA(kf[1], qr[0], f32x16{});
#pragma unroll
      for (int d0 = 1; d0 < 4; ++d0) { pA0 = ATT_MFMA(kf[2 * d0], qr[d0], pA0); pA1 = ATT_MFMA(kf[2 * d0 + 1], qr[d0], pA1); }
      if ((NMETA + q0w) - 63 < 91) {
          const LAS float* tbl = tb + ((NMETA + q0w + r32) + 128 - 4 * hi - 12);
#pragma unroll
          for (int r = 0; r < 8; ++r) pA0[r] += tbl[12 - ((r & 3) + 8 * (r >> 2))];
      }
#pragma unroll
      for (int r = 0; r < 16; ++r) { if (r >= 8) pA0[r] = -1e30f; pA1[r] = -1e30f; }
      mhat = rowmax(pA0, pA1);
#pragma unroll
      for (int r = 0; r < 16; ++r) negm[r] = -mhat;
      asm volatile("" : "+v"(negm));
#pragma unroll
      for (int r = 0; r < 16; ++r) { pA0[r] = __builtin_amdgcn_exp2f(pA0[r] - mhat); pA1[r] = __builtin_amdgcn_exp2f(pA1[r] - mhat); }
      const lds_cptr kn = kp0 + RSLOT; ATT_KLOAD(kn, 0); ATT_KLOAD(kn, 1); ATT_KLOAD(kn, 2); ATT_KLOAD(kn, 3); }
    asm volatile("s_waitcnt vmcnt(2) lgkmcnt(0)\n\ts_barrier" ::: "memory");
    s16x4 vlo[8], vhi[8]; u32x4 pw0, pw1, pw2, pw3; bool resc;
    int s_prev = 0, s_cur = RSLOT, s_next = 2 * RSLOT;
#define ATT_ROT() do { const int n_ = s_prev; s_prev = s_cur; s_cur = s_next; s_next = n_; } while (0)
#define ATT_VRD(i, f) do { vlo[i] = vtr(vp_ + (((f) >> 2) * 4096 + ((f) & 3) * 1024)); vhi[i] = vtr(vp_ + (((f) >> 2) * 4096 + ((f) & 3) * 1024 + 512)); } while (0)
#define ATT_VFR(i) (bf16x8){vlo[i][0], vlo[i][1], vlo[i][2], vlo[i][3], vhi[i][0], vhi[i][1], vhi[i][2], vhi[i][3]}
#define ATT_PAF(k) __builtin_bit_cast(bf16x8, pw##k)
#define ATT_GAPA(MF, A0, A1, A2, A3, W0, W1, PW) do { MF; sacc += A0; sacc += A1; sacc += A2; sacc += A3; ATT_PIN(sacc); W0; W1; ATT_PIN(PW); ATT_SBAR(); } while (0)
#define ATT_EX(v) __builtin_amdgcn_exp2f(v)
#define ATT_PV(i) o[(i) >> 2] = ATT_MFMA(__builtin_bit_cast(bf16x8, (((i) & 3) == 0) ? pw0 : (((i) & 3) == 1) ? pw1 : (((i) & 3) == 2) ? pw2 : pw3), ATT_VFR((i) & 7), o[(i) >> 2])
#define ATT_KRD(j) kf[j] = *(const LAS bf16x8*)(kn_ + ((j) >> 1) * 2048 + ((j) & 1) * 512)
#define ATT_EXP1(C0, C1, e) do { if ((e) < 16) C0[(e) & 15] = ATT_EX(C0[(e) & 15]); else C1[(e) & 15] = ATT_EX(C1[(e) & 15]); } while (0)
#define ATT_STEP(C0, C1, P0, P1, t) do { \
        if ((t) + 2 < NT) ATT_DMA_K((t) + 2, s_prev); \
        if ((t) + 1 < NT) ATT_DMA_V((t) + 1, s_next); \
        const lds_cptr vp_ = vp0 + s_prev; const lds_cptr kn_ = kp0 + s_next; \
        ATT_SBAR(); \
        float sacc = 0.f; \
        ATT_VRD(0, 0); ATT_VRD(1, 1); ATT_SBAR(); \
        ATT_GAPA(C0 = ATT_MFMA(kf[0], qr[0], negm), P0[0], P0[1], P0[2], P0[3],     pw0[0] = cvtpk(P0[0], P0[1]),   pw0[1] = cvtpk(P0[2], P0[3]),   pw0); \
        ATT_VRD(2, 2); ATT_SBAR(); \
        ATT_GAPA(C1 = ATT_MFMA(kf[1], qr[0], negm), P0[4], P0[5], P0[6], P0[7],     pw0[2] = cvtpk(P0[4], P0[5]),   pw0[3] = cvtpk(P0[6], P0[7]),   pw0); \
        ATT_VRD(3, 3); ATT_SBAR(); \
        ATT_GAPA(C0 = ATT_MFMA(kf[2], qr[1], C0),       P0[8], P0[9], P0[10], P0[11],   pw1[0] = cvtpk(P0[8], P0[9]),   pw1[1] = cvtpk(P0[10], P0[11]), pw1); \
        ATT_VRD(4, 4); ATT_SBAR(); \
        ATT_GAPA(C1 = ATT_MFMA(kf[3], qr[1], C1),       P0[12], P0[13], P0[14], P0[15], pw1[2] = cvtpk(P0[12], P0[13]), pw1[3] = cvtpk(P0[14], P0[15]), pw1); \
        ATT_VRD(5, 5); ATT_SBAR(); \
        ATT_GAPA(C0 = ATT_MFMA(kf[4], qr[2], C0),       P1[0], P1[1], P1[2], P1[3],     pw2[0] = cvtpk(P1[0], P1[1]),   pw2[1] = cvtpk(P1[2], P1[3]),   pw2); \
        ATT_VRD(6, 6); ATT_SBAR(); \
        ATT_GAPA(C1 = ATT_MFMA(kf[5], qr[2], C1),       P1[4], P1[5], P1[6], P1[7],     pw2[2] = cvtpk(P1[4], P1[5]),   pw2[3] = cvtpk(P1[6], P1[7]),   pw2); \
        ATT_VRD(7, 7); ATT_SBAR(); \
        ATT_GAPA(C0 = ATT_MFMA(kf[6], qr[3], C0),       P1[8], P1[9], P1[10], P1[11],   pw3[0] = cvtpk(P1[8], P1[9]),   pw3[1] = cvtpk(P1[10], P1[11]), pw3); \
        ATT_GAPA(C1 = ATT_MFMA(kf[7], qr[3], C1),       P1[12], P1[13], P1[14], P1[15], pw3[2] = cvtpk(P1[12], P1[13]), pw3[3] = cvtpk(P1[14], P1[15]), pw3); \
        l_reg += sacc; \
        { const int kpos0_ = NMETA + 64 * ((t) - 1); \
          if ((NMETA + q0w) - (kpos0_ + 63) < 91) {                                     \
              const LAS float* tbl_ = tb + ((NMETA + q0w + r32) - kpos0_ + 128 - 4 * hi - 60);     \
              _Pragma("unroll") for (int r = 0; r < 16; ++r) { const int c_ = (r & 3) + 8 * (r >> 2); C0[r] += tbl_[60 - c_]; C1[r] += tbl_[28 - c_]; } } \
          if ((t) == NT - 1 && !last_active) { _Pragma("unroll") for (int r = 0; r < 16; ++r) { C0[r] = -1e30f; C1[r] = -1e30f; } } } \
          \
        float ma_, mb_; resc = false; \
        ATT_SBAR(); \
        ATT_PV(0); ma_ = ATT_MX3(C0[0], C0[1], C1[0]); mb_ = ATT_MX3(C0[2], C0[3], C1[1]); ma_ = ATT_MX3(ma_, C1[2], C1[3]); ma_ = ATT_MX3(ma_, C0[4], C0[5]); ATT_PIN(ma_); ATT_PIN(mb_); ATT_VRD(0, 8); ATT_SBAR(); \
        ATT_PV(1); mb_ = ATT_MX3(mb_, C0[6], C0[7]); ma_ = ATT_MX3(ma_, C1[4], C1[5]); mb_ = ATT_MX3(mb_, C1[6], C1[7]); ma_ = ATT_MX3(ma_, C0[8], C0[9]); ATT_PIN(ma_); ATT_PIN(mb_); ATT_VRD(1, 9); ATT_SBAR(); \
        ATT_PV(2); mb_ = ATT_MX3(mb_, C0[10], C0[11]); ma_ = ATT_MX3(ma_, C1[8], C1[9]); mb_ = ATT_MX3(mb_, C1[10], C1[11]); ma_ = ATT_MX3(ma_, C0[12], C0[13]); ATT_PIN(ma_); ATT_PIN(mb_); ATT_VRD(2, 10); ATT_SBAR(); \
        ATT_PV(3); mb_ = ATT_MX3(mb_, C0[14], C0[15]); ma_ = ATT_MX3(ma_, C1[12], C1[13]); mb_ = ATT_MX3(mb_, C1[14], C1[15]); ATT_VRD(3, 11); \
        float rm_ = __builtin_fmaxf(ma_, mb_); { auto rr_ = __builtin_amdgcn_permlane32_swap(__float_as_uint(rm_), __float_as_uint(rm_), false, false); rm_ = __builtin_fmaxf(__uint_as_float(rr_[0]), __uint_as_float(rr_[1])); } \
        const bool grow_ = __any(rm_ > (float)THR); \
        ATT_SBAR(); \
          \
        ATT_PV(4); ATT_VRD(4, 12); ATT_KRD(0); ATT_SBAR(); \
        ATT_PV(5); ATT_VRD(5, 13); ATT_KRD(1); ATT_SBAR(); \
        if (grow_) {                                                                    \
            const float dl_ = __builtin_fmaxf(rm_, 0.f); mhat += dl_; const float f_ = __builtin_amdgcn_exp2f(-dl_); l_reg *= f_; if (hi == 0) wsf[r32] = f_; resc = true; \
            _Pragma("unroll") for (int r = 0; r < 16; ++r) { C0[r] -= dl_; C1[r] -= dl_; negm[r] = -mhat; } asm volatile("" : "+v"(negm)); } \
        ATT_SBAR(); \
          \
        ATT_PV(6);  ATT_EXP1(C0, C1, 0);  ATT_EXP1(C0, C1, 1);  ATT_EXP1(C0, C1, 2);  ATT_PIN(C0); ATT_VRD(6, 14); ATT_KRD(2); ATT_SBAR(); \
        ATT_PV(7);  ATT_EXP1(C0, C1, 3);  ATT_EXP1(C0, C1, 4);  ATT_EXP1(C0, C1, 5);  ATT_PIN(C0); ATT_VRD(7, 15); ATT_KRD(3); ATT_SBAR(); \
        ATT_PV(8);  ATT_EXP1(C0, C1, 6);  ATT_EXP1(C0, C1, 7);  ATT_EXP1(C0, C1, 8);  ATT_PIN(C0); ATT_KRD(4); ATT_SBAR(); \
        ATT_PV(9);  ATT_EXP1(C0, C1, 9);  ATT_EXP1(C0, C1, 10); ATT_EXP1(C0, C1, 11); ATT_PIN(C0); ATT_KRD(5); ATT_SBAR(); \
        ATT_PV(10); ATT_EXP1(C0, C1, 12); ATT_EXP1(C0, C1, 13); ATT_EXP1(C0, C1, 14); ATT_PIN(C0); ATT_KRD(6); ATT_SBAR(); \
        ATT_PV(11); ATT_EXP1(C0, C1, 15); ATT_EXP1(C0, C1, 16); ATT_EXP1(C0, C1, 17); ATT_PIN(C0); ATT_PIN(C1); ATT_KRD(7); ATT_SBAR(); \
        ATT_PV(12); ATT_EXP1(C0, C1, 18); ATT_EXP1(C0, C1, 19); ATT_EXP1(C0, C1, 20); ATT_EXP1(C0, C1, 21); ATT_PIN(C1); ATT_SBAR(); \
        ATT_PV(13); ATT_EXP1(C0, C1, 22); ATT_EXP1(C0, C1, 23); ATT_EXP1(C0, C1, 24); ATT_EXP1(C0, C1, 25); ATT_PIN(C1); ATT_SBAR(); \
        ATT_PV(14); ATT_EXP1(C0, C1, 26); ATT_EXP1(C0, C1, 27); ATT_EXP1(C0, C1, 28); ATT_PIN(C1); ATT_SBAR(); \
        ATT_PV(15); ATT_EXP1(C0, C1, 29); ATT_EXP1(C0, C1, 30); ATT_EXP1(C0, C1, 31); ATT_PIN(C1); ATT_SBAR(); \
        if (resc) { LDS_WAIT(); \
            _Pragma("unroll") for (int r = 0; r < 16; ++r) { const float fr_ = wsf[crow(r, hi)]; _Pragma("unroll") for (int i = 0; i < 4; ++i) o[i][r] *= fr_; } } \
        if ((t) + 1 < NT) asm volatile("s_waitcnt vmcnt(2) lgkmcnt(0)\n\ts_barrier" ::: "memory"); else asm volatile("s_waitcnt vmcnt(0) lgkmcnt(0)\n\ts_barrier" ::: "memory"); \
        ATT_ROT(); \
    } while (0)
#pragma unroll 1
    for (int t = 1; t < NT; t += 2) {
        ATT_STEP(pB0, pB1, pA0, pA1, t);
        ATT_STEP(pA0, pA1, pB0, pB1, t + 1);
    }
    { float sacc = 0.f;
#pragma unroll
      for (int r = 0; r < 16; ++r) sacc += pA0[r] + pA1[r];
      l_reg += sacc;
      u32x4 pw[4];
      pw[0] = (u32x4){cvtpk(pA0[0], pA0[1]), cvtpk(pA0[2], pA0[3]), cvtpk(pA0[4], pA0[5]), cvtpk(pA0[6], pA0[7])};
      pw[1] = (u32x4){cvtpk(pA0[8], pA0[9]), cvtpk(pA0[10], pA0[11]), cvtpk(pA0[12], pA0[13]), cvtpk(pA0[14], pA0[15])};
      pw[2] = (u32x4){cvtpk(pA1[0], pA1[1]), cvtpk(pA1[2], pA1[3]), cvtpk(pA1[4], pA1[5]), cvtpk(pA1[6], pA1[7])};
      pw[3] = (u32x4){cvtpk(pA1[8], pA1[9]), cvtpk(pA1[10], pA1[11]), cvtpk(pA1[12], pA1[13]), cvtpk(pA1[14], pA1[15])};
      pv_tile(o, pw, vp0 + s_prev); }
    ATT_WAIT_BAR();
#undef ATT_STEP
#undef ATT_GAPA
#undef ATT_PV
#undef ATT_KRD
#undef ATT_EXP1
#undef ATT_VRD
#undef ATT_KLOAD
    { auto rr = __builtin_amdgcn_permlane32_swap(__float_as_uint(l_reg), __float_as_uint(l_reg), false, false); l_reg = __uint_as_float(rr[0]) + __uint_as_float(rr[1]); }
    if (hi == 0) wsf[32 + r32] = l_reg;
    LDS_WAIT();
    float rli[16];
#pragma unroll
    for (int r = 0; r < 16; ++r) rli[r] = 1.f / wsf[32 + crow(r, hi)];
    LAS float* stg = (LAS float*)lds;
    if (map == 1) {
#pragma unroll
        for (int r = 0; r < 16; ++r) { LAS float* sp = stg + (32 * rg + crow(r, hi)) * STG_PITCH + r32;
#pragma unroll
            for (int i = 0; i < 4; ++i) sp[32 * i] = o[i][r] * rli[r]; }
    }
    ATT_WAIT_BAR();
    if (map == 0) {
#pragma unroll
        for (int r = 0; r < 16; ++r) { LAS float* sp = stg + (32 * rg + crow(r, hi)) * STG_PITCH + r32;
#pragma unroll
            for (int i = 0; i < 4; ++i) sp[32 * i] = o[i][r] * rli[r] - lam * sp[32 * i]; }
    }
    ATT_WAIT_BAR();
    { int lane2 = F.lane; asm volatile("" : "+v"(lane2)); const int row = wid * 16 + (lane2 >> 2), c0 = (lane2 & 3) * 32;
      const LAS float* sp = stg + row * STG_PITCH + c0; f32x4 v[8]; float ss = 0.f;
#pragma unroll
      for (int i = 0; i < 8; ++i) { v[i] = *(const LAS f32x4*)(sp + 4 * i); ss += (v[i].x * v[i].x + v[i].y * v[i].y) + (v[i].z * v[i].z + v[i].w * v[i].w); }
      ss += __shfl_xor(ss, 1); ss += __shfl_xor(ss, 2);
      const float rs = 0.8f / sqrtf(ss * (1.f / 128.f) + EPS);
      bf16* ao = F.ACAT + (rowbase + (size_t)qb * 128 + row) * KC + PW + h * 128 + c0; const f32x4* sw = (const f32x4*)(F.sublnw + c0);
#pragma unroll
      for (int i = 0; i < 4; ++i) { const f32x4 a = v[2 * i] * rs * sw[2 * i], c = v[2 * i + 1] * rs * sw[2 * i + 1];
          u32x4 w; w.x = pk2(a.x, a.y); w.y = pk2(a.z, a.w); w.z = pk2(c.x, c.y); w.w = pk2(c.z, c.w); *(u32x4*)(ao + 8 * i) = w; } }
    ATT_WAIT_BAR();
#undef ATT_TROW
#undef ATT_DMA_K
#undef ATT_DMA_V
#undef ATT_ROT
#undef ATT_VFR
#undef ATT_PAF
#undef ATT_EX
}
__device__ __forceinline__ void attn_phase(const Frame& F) {
    const float lam = compute_lambda(F);
    for (int v = F.vcu; v < 256; v += F.G) {
        const int xg = v >> 5, j = v & 31;
#pragma unroll 1
        for (int r = 0; r < 4; ++r) {
            const int bh = 4 * xg + r, b = bh / NH, h = bh % NH, j2 = (j + 16) & 31;
            const int qb = (r == 0) ? j : (r == 1) ? 31 - j : (r == 2) ? j2 : 31 - j2;
            __syncthreads();
            int tid_ = F.wave * 64 + (int)__builtin_amdgcn_mbcnt_hi(~0u, __builtin_amdgcn_mbcnt_lo(~0u, 0u)); asm volatile("" : "+v"(tid_));
            if (tid_ < NBIAS) { const int d = min(max(tid_ - 128, -127), 91);
                ((LAS float*)(F.lds + LDS_BIAS))[tid_] = (F.btab[t5_bucket(-d) * NH + h] - F.btab[15 * NH + h]) * LOG2E; }
            __syncthreads();
            attn_unit(F, b, h, qb, lam);
        }
    }
}
}

__device__ __forceinline__ void final_norm_phase(Frame& F) {
    const int gw = F.vcu * NWAVES + F.wave, NGW = F.G * NWAVES;
    for (int m = gw; m < M; m += NGW) {
        f32x4* xr = (f32x4*)(F.out + (size_t)m * D) + F.lane; const f32x4* wr = (const f32x4*)F.finw + F.lane;
        f32x4 v[4]; float s = 0.f;
#pragma unroll
        for (int j = 0; j < 4; ++j) { v[j] = xr[64 * j]; s += (v[j].x * v[j].x + v[j].y * v[j].y) + (v[j].z * v[j].z + v[j].w * v[j].w); }
        const float rstd = 1.f / sqrtf(wave_sum(s) * (1.f / D) + EPS);
#pragma unroll
        for (int j = 0; j < 4; ++j) xr[64 * j] = v[j] * rstd * wr[64 * j];
    }
}

typedef GAS unsigned gu32;
typedef GAS unsigned long long gu64;
#define RLX_AGENT __ATOMIC_RELAXED, __HIP_MEMORY_SCOPE_AGENT
#define XB_TMO      128
#define XB_XCNT(j)  (256  + 64 * (j))
#define XB_XSUB(j)  (1280 + 64 * (j))
#define XB_XGEN(j)  (2304 + 64 * (j))
#define XB_TOP      3328
#define XB_TOPGEN   3392
#define XCD_BAR_WORDS 3456
#define XB_SPIN_CAP (1u << 18)

__device__ __forceinline__ unsigned xb_ld(unsigned* p)              { return __hip_atomic_load(p, __ATOMIC_RELAXED, __HIP_MEMORY_SCOPE_AGENT); }
__device__ __forceinline__ unsigned xb_add(unsigned* p, unsigned v) { return __hip_atomic_fetch_add(p, v, __ATOMIC_RELAXED, __HIP_MEMORY_SCOPE_AGENT); }
__device__ __forceinline__ unsigned xb_xcc_id() { return (unsigned)__builtin_amdgcn_s_getreg((3 << 11) | 20) & 0xFu; }
#define XB_SPIN(cond, bar) do { unsigned _sp = 0; while (cond) { __builtin_amdgcn_s_sleep(1); \
    if ((++_sp & 255u) == 0u) { if (xb_ld(&(bar)[XB_TMO])) break; if (_sp > XB_SPIN_CAP) { atomicAdd(&(bar)[XB_TMO], 1u); break; } } } } while (0)

struct XcdBarrier {
    unsigned* bar; unsigned x;
    volatile LAS unsigned* st;
};

__device__ __forceinline__ XcdBarrier xcd_barrier_post(unsigned* bar, volatile LAS unsigned* st) {
    XcdBarrier b; b.bar = bar; b.x = xb_xcc_id(); b.st = st;
    if (threadIdx.x == 0) (void)xb_add(&bar[XB_XCNT(b.x)], 1u);
    return b;
}
__device__ __forceinline__ void xcd_barrier_complete(unsigned* bar, unsigned x, unsigned& nloc, unsigned& nx) {
    const unsigned G = gridDim.x * gridDim.y * gridDim.z;
    unsigned sum, cnt, mine, sp = 0u;
    for (;;) {
        sum = 0u; cnt = 0u; mine = 0u;
#pragma unroll
        for (unsigned j = 0; j < 16; ++j) { const unsigned c = xb_ld(&bar[XB_XCNT(j)]); sum += c; cnt += (c > 0u) ? 1u : 0u; mine = (j == x) ? c : mine; }
        if (sum == G) break;
        __builtin_amdgcn_s_sleep(1);
        if ((++sp & 255u) == 0u) { if (xb_ld(&bar[XB_TMO])) break; if (sp > XB_SPIN_CAP) { atomicAdd(&bar[XB_TMO], 1u); break; } }
    }
    nloc = mine > 0u ? mine : 1u; nx = cnt > 0u ? cnt : 1u;
}

__device__ __forceinline__ void xcd_barrier(const XcdBarrier& b) {
    asm volatile("s_waitcnt vmcnt(0)" ::: "memory");
    __syncthreads();
    if (threadIdx.x == 0) {
        unsigned* bar = b.bar;
        __builtin_amdgcn_s_waitcnt(0);
        unsigned nloc = b.st[0], nx = b.st[1];
        if (nloc == 0u) { xcd_barrier_complete(bar, b.x, nloc, nx); b.st[0] = nloc; b.st[1] = nx; }
        const unsigned old = xb_add(&bar[XB_XSUB(b.x)], 1u);
        const unsigned gen = old / nloc;
        if (old + 1u == (gen + 1u) * nloc) {
            __builtin_amdgcn_fence(__ATOMIC_RELEASE, "agent");
            asm volatile("s_waitcnt vmcnt(0)" ::: "memory");
            const unsigned og = xb_add(&bar[XB_TOP], 1u);
            const unsigned tg = og / nx;
            if (og + 1u == (tg + 1u) * nx) xb_add(&bar[XB_TOPGEN], 1u);
            else XB_SPIN(xb_ld(&bar[XB_TOPGEN]) == tg, bar);
            __builtin_amdgcn_fence(__ATOMIC_ACQUIRE, "agent");
            xb_add(&bar[XB_XGEN(b.x)], 1u);
            asm volatile("s_waitcnt vmcnt(0)" ::: "memory");
        } else {
            XB_SPIN(xb_ld(&bar[XB_XGEN(b.x)]) == gen, bar);
            __builtin_amdgcn_fence(__ATOMIC_ACQUIRE, "agent");
            asm volatile("s_waitcnt vmcnt(0)" ::: "memory");
        }
    }
    __syncthreads();
}

struct Args { const float* in[20]; float* out; unsigned char* ws; int ph_lo, ph_hi; };
constexpr int NPHASE = 8;

__global__ void __launch_bounds__(NTHR, 2) mk_fwd(Args args) {
    extern __shared__ __attribute__((aligned(16))) unsigned char lds[];
    Frame F;
    F.lds = (LAS unsigned char*)lds;
    F.wave = __builtin_amdgcn_readfirstlane((int)threadIdx.x >> 6); F.lane = (int)__builtin_amdgcn_mbcnt_hi(~0u, __builtin_amdgcn_mbcnt_lo(~0u, 0u)); F.tid = F.wave * 64 + F.lane;
    F.G = gridDim.x; { const int bx = blockIdx.x; F.vcu = (F.G % 8 == 0) ? (bx % 8) * (F.G / 8) + bx / 8 : bx; }
    F.x = args.in[0]; F.meta = args.in[1]; F.btab = args.in[2]; F.mixw = args.in[3]; F.win = args.in[4]; F.pgw = args.in[5]; F.pscale = args.in[6];
    F.lq1 = args.in[7]; F.lk1 = args.in[8]; F.lq2 = args.in[9]; F.lk2 = args.in[10]; F.sublnw = args.in[11]; F.wpo = args.in[12]; F.wao = args.in[13];
    F.wo = args.in[14]; F.ffnw = args.in[15]; F.wg = args.in[16]; F.wu = args.in[17]; F.wd = args.in[18]; F.finw = args.in[19];
    F.out = args.out; F.ws = args.ws; unsigned char* ws = args.ws;
    F.Win_t = (bf16*)(ws + WS_WIN); F.Wcat_t = (bf16*)(ws + WS_WCAT); F.Wo_t = (bf16*)(ws + WS_WO); F.Wgu_t = (bf16*)(ws + WS_WGU); F.Wd_t = (bf16*)(ws + WS_WD);
    F.XN = (bf16*)(ws + WS_XN); F.UP = (bf16*)(ws + WS_UP); F.Kb = (bf16*)(ws + WS_K); F.Vb = (bf16*)(ws + WS_V); F.Qb = (bf16*)(ws + WS_Q); F.GP = (bf16*)(ws + WS_GP); F.GA = (bf16*)(ws + WS_GA);
    F.MERGED = (bf16*)(ws + WS_MERGED); F.HB = (bf16*)(ws + WS_HB); F.ACT = (bf16*)(ws + WS_ACT); F.PART = (float*)(ws + WS_PART); F.ACAT = (bf16*)args.out;
    const int lo = args.ph_lo, hi = args.ph_hi;
    for (int u = F.tid; u < (LDS_BYTES - RING_BYTES) / 4; u += NTHR) ((LAS unsigned*)(F.lds + RING_BYTES))[u] = 0u;
    __syncthreads();
    XcdBarrier bar; bar.bar = (unsigned*)(ws + WS_CTL) + CW_BAR; bar.x = 0; bar.st = nullptr;
    if (hi - lo > 1) bar = xcd_barrier_post((unsigned*)(ws + WS_CTL) + CW_BAR, (volatile LAS unsigned*)(F.lds + MISC_OFF) + 8);
#define IN(k) (lo <= (k) && (k) < hi)
#define SEAM(k) do { if (IN(k) && IN((k) + 1)) xcd_barrier(bar); } while (0)
    if (IN(0)) { p0_prologue(F); }
    SEAM(0);
    if (IN(1)) {
        pg8::Gemm g{F.XN, F.Win_t, MP, INC, D}; OrderP1 S; S.init(F.G, (int)blockIdx.x);
        Epi8P1 E{{F.UP, F.Qb, F.Kb, F.Vb, F.GP, F.GA}};
        deferred_weights(F, 0, (M / 256) * (INC / 256) + 10); __syncthreads();
        pg8::gemm_phase<Epi8P1, OrderP1, true, true>(F.lds, g, S, E, F.wave, F.lane);
    }
    SEAM(1);
    if (IN(2)) { pool_phase(F); __syncthreads(); attn::attn_phase(F); }
    SEAM(2);
    if (IN(3)) {
        pg8::Gemm g{F.ACAT, F.Wcat_t, M, D, KC}; pg8::StaticOrder S; S.init(M, D, F.G, (int)blockIdx.x);
        EpiP3 E{F.GP, F.GA, F.MERGED}; pg8::gemm_phase<EpiP3, pg8::StaticOrder, true, true>(F.lds, g, S, E, F.wave, F.lane);
    }
    SEAM(3);
    if (IN(4)) {
        pg8::Gemm g{F.MERGED, F.Wo_t, M, D, D}; pg8::StaticOrder S; S.init(M, D, F.G, (int)blockIdx.x);
        Epi8P4 E{{F.x, F.HB}, F.PART}; pg8::gemm_phase<Epi8P4, pg8::StaticOrder, true, true>(F.lds, g, S, E, F.wave, F.lane);
    }
    SEAM(4);
    if (IN(5)) {
        pg8::Gemm g{F.HB, F.Wgu_t, M, 2 * FF, D}; pg8::StaticOrder S; S.init(M, 2 * FF, F.G, (int)blockIdx.x);
        deferred_weights(F, 1, (M / 256) * (2 * FF / 256)); __syncthreads();
        Epi8P5 E{{F.ACT}, F.PART}; pg8::gemm_phase<Epi8P5, pg8::StaticOrder, true, true>(F.lds, g, S, E, F.wave, F.lane);
    }
    SEAM(5);
    if (IN(6)) {
        pg8::Gemm g{F.ACT, F.Wd_t, M, D, FF}; pg8::StaticOrder S; S.init(M, D, F.G, (int)blockIdx.x);
        if (F.G == 256) { EpiFinal E{F.HB, F.out, F.finw, (unsigned*)(ws + WS_XSLOT), (unsigned*)(ws + WS_CTL) + CW_CNT}; pg8::gemm_phase<EpiFinal, pg8::StaticOrder, false, true>(F.lds, g, S, E, F.wave, F.lane); }
        else { Epi8<EpiP6> E{{F.HB, F.out}}; pg8::gemm_phase<Epi8<EpiP6>, pg8::StaticOrder, true, true>(F.lds, g, S, E, F.wave, F.lane); }
    }
    if (F.G != 256) { SEAM(6); if (IN(7)) final_norm_phase(F); }
#undef IN
#undef SEAM
}

extern "C" void kernel_launch(void* const* d_in, const int* in_sizes, int n_in, void* d_out, int out_size, void* d_ws, size_t ws_size, hipStream_t stream) {
    static int grid = 0;
    if (grid == 0) {
        if (n_in != 20 || out_size != M * D || ws_size < WS_END) { fprintf(stderr, "kernel_launch: unexpected shapes (n_in %d out %d ws %zu)\n", n_in, out_size, ws_size); grid = -1; return; }
        int dev = 0, cus = 0, per_cu = 0;
        if (hipGetDevice(&dev) != hipSuccess || hipDeviceGetAttribute(&cus, hipDeviceAttributeMultiprocessorCount, dev) != hipSuccess) { grid = -1; return; }
        if (hipFuncSetAttribute((const void*)mk_fwd, hipFuncAttributeMaxDynamicSharedMemorySize, LDS_BYTES) != hipSuccess) { fprintf(stderr, "kernel_launch: hipFuncSetAttribute failed\n"); grid = -1; return; }
        if (hipOccupancyMaxActiveBlocksPerMultiprocessor(&per_cu, (const void*)mk_fwd, NTHR, LDS_BYTES) != hipSuccess || per_cu < 1) { fprintf(stderr, "kernel_launch: occupancy query says %d\n", per_cu); }
        (void)hipGetLastError();
        grid = cus;
    }
    if (grid < 0) return;
    (void)hipMemsetAsync((char*)d_ws + WS_CTL, 0, CTL_ZERO_BYTES, stream);
    Args a{};
    for (int i = 0; i < 20; ++i) a.in[i] = (const float*)d_in[i];
    a.out = (float*)d_out; a.ws = (unsigned char*)d_ws;
#ifdef PROBE_DUP
    if (true) { a.ph_lo = 0; a.ph_hi = PROBE_DUP + 1; hipLaunchKernelGGL(mk_fwd, dim3(grid), dim3(NTHR), LDS_BYTES, stream, a);
        (void)hipMemsetAsync((char*)d_ws + WS_CTL, 0, 65536, stream);
        a.ph_lo = PROBE_DUP; a.ph_hi = NPHASE; hipLaunchKernelGGL(mk_fwd, dim3(grid), dim3(NTHR), LDS_BYTES, stream, a); }
#else
    if (MK_N_LAUNCHES == 1) { a.ph_lo = 0; a.ph_hi = NPHASE; hipLaunchKernelGGL(mk_fwd, dim3(grid), dim3(NTHR), LDS_BYTES, stream, a); }
#endif
    else for (int p = 0; p < NPHASE; ++p) { a.ph_lo = p; a.ph_hi = p + 1; hipLaunchKernelGGL(mk_fwd, dim3(grid), dim3(NTHR), LDS_BYTES, stream, a); }
}
```

```cpp
#include <hip/hip_runtime.h>
#include <cstdio>
#include <cstdint>

#ifndef MK_N_LAUNCHES
#define MK_N_LAUNCHES 1
#endif

constexpr int BATCH = 4, SEQ = 4096, D = 1024, NMETA = 16, NH = 8, HD = 64, VD = 128;
constexpr int M = BATCH * SEQ;
constexpr int MP = M + 256;
constexpr int PW = 512, AW = 1024, FF = 2816, INC = 5632;
constexpr int KC = PW + AW;
constexpr float EPS = 1e-6f;
constexpr float LOG2E = 1.4426950408889634f;
constexpr float QSCALE = 0.125f * LOG2E;

typedef unsigned short bf16;
typedef float f32x4 __attribute__((ext_vector_type(4)));
typedef unsigned u32x4 __attribute__((ext_vector_type(4)));
typedef unsigned u32x2 __attribute__((ext_vector_type(2)));

constexpr size_t MiB = 1u << 20;
constexpr size_t WS_CTL = 0, CTL_ZERO_BYTES = 1 * MiB;
constexpr size_t WS_XSLOT = 512 * 1024;
constexpr int CW_CNT = 16384;
constexpr int CW_QUEUE = 2048;
constexpr int CW_BAR = 4096;
constexpr size_t WS_PART = 1 * MiB;
constexpr size_t WS_WIN = 2 * MiB;
constexpr size_t WS_WCAT = 13 * MiB;
constexpr size_t WS_WO = 16 * MiB;
constexpr size_t WS_WGU = 18 * MiB;
constexpr size_t WS_WD = 29 * MiB;
constexpr size_t WS_XN = 36 * MiB;
constexpr size_t WS_UP = WS_XN + (size_t)MP * D * 2;
constexpr size_t WS_K = WS_UP + (size_t)MP * PW * 2;
constexpr size_t WS_V = WS_K + (size_t)MP * AW * 2;
constexpr size_t WS_Q = WS_V + (size_t)MP * AW * 2;
constexpr size_t WS_GP = WS_Q + (size_t)M * AW * 2;
constexpr size_t WS_GA = WS_GP + (size_t)M * D * 2;
constexpr size_t WS_END = WS_GA + (size_t)M * D * 2;
constexpr size_t WS_MERGED = WS_Q, WS_HB = WS_GP;
constexpr size_t WS_ACT = WS_XN;
static_assert(WS_END <= 256 * MiB, "ws map");
static_assert(WS_ACT + (size_t)M * FF * 2 <= WS_Q, "ACT overlay must not reach MERGED / HB");

constexpr int RING_BYTES = 131072, MISC_OFF = RING_BYTES + 320, LDS_BYTES = 147456;
constexpr int NWAVES = 8, NTHR = 512;

#define GAS __attribute__((address_space(1)))
#define LAS __attribute__((address_space(3)))
#define LDS_WAIT() asm volatile("s_waitcnt lgkmcnt(0)" ::: "memory")
#define VM_WAIT() asm volatile("s_waitcnt vmcnt(0)" ::: "memory")

__device__ __forceinline__ unsigned f2bf(float f) { unsigned u = __builtin_bit_cast(unsigned, f); return (u + 0x7fffu + ((u >> 16) & 1u)) >> 16; }
typedef float f32x2_c __attribute__((ext_vector_type(2))); typedef __bf16 bf16x2_c __attribute__((ext_vector_type(2)));
__device__ __forceinline__ unsigned pk2(float lo, float hi) { f32x2_c v = {lo, hi}; bf16x2_c b = __builtin_convertvector(v, bf16x2_c); return __builtin_bit_cast(unsigned, b); }
__device__ __forceinline__ float bf2f(unsigned b) { return __builtin_bit_cast(float, b << 16); }
__device__ __forceinline__ float bflo(unsigned w) { return __builtin_bit_cast(float, w << 16); }
__device__ __forceinline__ float bfhi(unsigned w) { return __builtin_bit_cast(float, w & 0xffff0000u); }
__device__ __forceinline__ float wave_sum(float v) {
#pragma unroll
    for (int o = 1; o < 64; o <<= 1) v += __shfl_xor(v, o);
    return v;
}
__device__ __forceinline__ float sigmoidf_(float x) { return __builtin_amdgcn_rcpf(1.f + __builtin_amdgcn_exp2f(-LOG2E * x)); }

struct Frame {
    LAS unsigned char* lds;
    int tid, lane, wave, G, vcu;
    const float *x, *meta, *btab, *mixw, *win, *pgw, *pscale, *lq1, *lk1, *lq2, *lk2, *sublnw, *wpo, *wao, *wo, *ffnw, *wg, *wu, *wd, *finw;
    float* out;
    unsigned char* ws;
    bf16 *Win_t, *Wcat_t, *Wo_t, *Wgu_t, *Wd_t;
    bf16 *XN, *UP, *Kb, *Vb, *Qb, *GP, *GA, *MERGED, *HB, *ACT, *ACAT;
    float *PART;
};

struct TrDesc { const float* W; const float* kscale; bf16* WT; int K, N, mode, ldw, item; };
__device__ __forceinline__ void tr_load(const TrDesc& d, int lane, float (&v)[32]) {
    const int nblk = d.N / 32, kb = d.item / nblk, nb = d.item % nblk, k0 = 64 * kb, n0 = 32 * nb;
#pragma unroll
    for (int i = 0; i < 32; ++i) v[i] = __builtin_nontemporal_load(d.W + (size_t)(k0 + 2 * i + (lane >> 5)) * d.N + n0 + (lane & 31));
}
__device__ __forceinline__ void tr_to_lds(const TrDesc& d, int lane, float (&v)[32], LAS float* scr) {
    const int nblk = d.N / 32, kb = d.item / nblk, k0 = 64 * kb;
    if (d.kscale) {
#pragma unroll
        for (int i = 0; i < 32; ++i) v[i] *= d.kscale[k0 + 2 * i + (lane >> 5)]; }
#pragma unroll
    for (int i = 0; i < 32; ++i) scr[(2 * i + (lane >> 5)) * 33 + (lane & 31)] = v[i];
    LDS_WAIT(); asm volatile("" ::: "memory");
}
__device__ __forceinline__ void tr_store(const TrDesc& d, int lane, LAS float* scr) {
    const int nblk = d.N / 32, kb = d.item / nblk, nb = d.item % nblk, k0 = 64 * kb, n0 = 32 * nb;
    const int c = lane & 7;
    const int rbase = (d.mode == 0) ? n0 : ((n0 / 128) * 256 + (n0 % 128) + (d.mode == 2 ? 128 : 0));
#pragma unroll
    for (int j = 0; j < 4; ++j) { const int n = (lane >> 3) + 8 * j; const LAS float* s = scr + (8 * c) * 33 + n;
        u32x4 o; o.x = pk2(s[0 * 33], s[1 * 33]); o.y = pk2(s[2 * 33], s[3 * 33]); o.z = pk2(s[4 * 33], s[5 * 33]); o.w = pk2(s[6 * 33], s[7 * 33]);
        *(u32x4*)(d.WT + (size_t)(rbase + n) * d.ldw + k0 + 8 * c) = o; }
    LDS_WAIT(); asm volatile("" ::: "memory");
}
template <int NR> __device__ __forceinline__ void rms_rows_to_bf16(const float* const (&xrow)[NR], const float* w, bf16* const (&orow)[NR], int lane) {
    f32x4 v[NR][4]; float s[NR];
#pragma unroll
    for (int r = 0; r < NR; ++r) { const f32x4* xr = (const f32x4*)xrow[r] + lane;
#pragma unroll
        for (int j = 0; j < 4; ++j) v[r][j] = __builtin_nontemporal_load(xr + 64 * j); }
    const f32x4* wr = (const f32x4*)w + lane; f32x4 ww[4];
#pragma unroll
    for (int j = 0; j < 4; ++j) ww[j] = wr[64 * j];
#pragma unroll
    for (int r = 0; r < NR; ++r) { s[r] = 0.f;
#pragma unroll
        for (int j = 0; j < 4; ++j) s[r] += (v[r][j].x * v[r][j].x + v[r][j].y * v[r][j].y) + (v[r][j].z * v[r][j].z + v[r][j].w * v[r][j].w); }
#pragma unroll
    for (int r = 0; r < NR; ++r) { const float rstd = 1.f / sqrtf(wave_sum(s[r]) * (1.f / D) + EPS);
        unsigned long long* o8 = (unsigned long long*)orow[r] + lane;
#pragma unroll
        for (int j = 0; j < 4; ++j)
            o8[64 * j] = (unsigned long long)pk2(v[r][j].x * rstd * ww[j].x, v[r][j].y * rstd * ww[j].y) | ((unsigned long long)pk2(v[r][j].z * rstd * ww[j].z, v[r][j].w * rstd * ww[j].w) << 32); }
}
constexpr int I_IN = (D / 64) * (INC / 32), I_AO = (AW / 64) * (D / 32), I_O = (D / 64) * (D / 32), I_G = (D / 64) * (FF / 32), I_D = (FF / 64) * (D / 32);
constexpr int I_EFF = (PW / 4) * (D / 4) / 64;
__device__ __forceinline__ void weff_item(Frame& F, int o) {
    const int kb = o / (D / 4), n0 = (o % (D / 4)) * 4, k0 = kb * 4, g = k0 / 128;
    const float* gwr = F.pgw + (size_t)k0 * 128; const float* wr = F.wpo + (size_t)(g * 128) * D + n0; const float* sc = F.pscale + g * 128;
    f32x4 s0 = {0.f, 0.f, 0.f, 0.f}, s1 = s0, s2 = s0, s3 = s0;
#pragma unroll 16
    for (int d = 0; d < 128; ++d) { const f32x4 wv = *(const f32x4*)(wr + (size_t)d * D) * sc[d];
        s0 += wv * gwr[d]; s1 += wv * gwr[128 + d]; s2 += wv * gwr[256 + d]; s3 += wv * gwr[384 + d]; }
#pragma unroll
    for (int j = 0; j < 4; ++j) { u32x2 w; w.x = pk2(s0[j], s1[j]); w.y = pk2(s2[j], s3[j]); *(u32x2*)(F.Wcat_t + (size_t)(n0 + j) * KC + k0) = w; }
}
__device__ __forceinline__ TrDesc tr_desc(const Frame& F, int q, int r) {
    if (q == 2) return TrDesc{F.win, nullptr, F.Win_t, D, INC, 0, D, r};
    if (q == 1) return TrDesc{F.wd, nullptr, F.Wd_t, FF, D, 0, FF, r};
    if (r < I_AO) return TrDesc{F.wao, nullptr, F.Wcat_t + PW, AW, D, 0, KC, r};
    r -= I_AO; if (r < I_O) return TrDesc{F.wo, nullptr, F.Wo_t, D, D, 0, D, r};
    r -= I_O; if (r < I_G) return TrDesc{F.wg, F.ffnw, F.Wgu_t, D, FF, 1, D, r};
    r -= I_G; return TrDesc{F.wu, F.ffnw, F.Wgu_t, D, FF, 2, D, r};
}
__device__ __forceinline__ void tr_run(const Frame& F, int q, int first, int stride, int total, LAS float* scr) {
    if (first >= total) return;
    float va[32], vb[32];
    TrDesc da = tr_desc(F, q, first), db = da; tr_load(da, F.lane, va);
    for (int it = first; it < total; it += 2 * stride) {
        const bool hb = it + stride < total, ha = it + 2 * stride < total;
        tr_to_lds(da, F.lane, va, scr); if (hb) { db = tr_desc(F, q, it + stride); tr_load(db, F.lane, vb); } tr_store(da, F.lane, scr);
        if (!hb) break;
        tr_to_lds(db, F.lane, vb, scr); if (ha) { da = tr_desc(F, q, it + 2 * stride); tr_load(da, F.lane, va); } tr_store(db, F.lane, scr);
    }
}
__device__ __forceinline__ void p0_prologue(Frame& F) {
    LAS float* scr = (LAS float*)(F.lds + F.wave * 16384);
    const int gw = F.vcu * NWAVES + F.wave, NGW = F.G * NWAVES;
    tr_run(F, 2, gw, NGW, I_IN, scr);
    if (M % (NGW * 4) == 0) {
        const int rpw = M / NGW;
        for (int r0 = 0; r0 < rpw; r0 += 4) {
            const float* xr[4]; bf16* orw[4];
#pragma unroll
            for (int r = 0; r < 4; ++r) { const size_t m = (size_t)gw * rpw + r0 + r; xr[r] = F.x + m * D; orw[r] = F.XN + m * D; }
            rms_rows_to_bf16<4>(xr, F.mixw, orw, F.lane);
        }
    } else
    for (int gidx = gw; gidx < M / 4; gidx += NGW) {
        const float* xr[4]; bf16* orw[4];
#pragma unroll
        for (int r = 0; r < 4; ++r) { const size_t m = (size_t)gidx + (size_t)r * (M / 4); xr[r] = F.x + m * D; orw[r] = F.XN + m * D; }
        rms_rows_to_bf16<4>(xr, F.mixw, orw, F.lane);
    }
    for (int m = M + gw; m < MP; m += NGW) {
        if (m < M + NMETA) { const float* xr[1] = {F.meta + (size_t)(m - M) * D}; bf16* orw[1] = {F.XN + (size_t)m * D}; rms_rows_to_bf16<1>(xr, F.mixw, orw, F.lane); }
        else { unsigned long long* o8 = (unsigned long long*)(F.XN + (size_t)m * D) + F.lane;
#pragma unroll
            for (int j = 0; j < 4; ++j) o8[64 * j] = 0ull; }
    }
}
__device__ __forceinline__ void deferred_weights(Frame& F, int q, int ntiles) {
    LAS float* scr = (LAS float*)(F.lds + F.wave * 16384);
    const int busy = ntiles % F.G, c = (int)blockIdx.x;
    int rank, count; if (busy == 0) { rank = c; count = F.G; } else { if (c < busy) return; rank = c - busy; count = F.G - busy; }
    const int w0 = rank * NWAVES + F.wave, nw = count * NWAVES;
    if (q == 1) { tr_run(F, 1, w0, nw, I_D, scr); return; }
    constexpr int T0 = I_AO + I_O + 2 * I_G, QA = 2;
    if (nw > I_EFF && QA * I_EFF <= T0) {
        if (w0 < I_EFF) { tr_run(F, 0, QA * w0, 1, QA * w0 + QA, scr); weff_item(F, w0 * 64 + F.lane); }
        else tr_run(F, 0, QA * I_EFF + (w0 - I_EFF), nw - I_EFF, T0, scr);
    } else {
        tr_run(F, 0, w0, nw, T0, scr);
        for (int r = w0; r < I_EFF; r += nw) weff_item(F, r * 64 + F.lane);
    }
}

namespace pg8 {
#define PG8_LAS __attribute__((address_space(3)))
typedef unsigned short bf16_t;
typedef short bf16x8 __attribute__((ext_vector_type(8)));
typedef float f32x4 __attribute__((ext_vector_type(4)));
typedef unsigned u32x4 __attribute__((ext_vector_type(4)));
constexpr int BM = 256, BK = 64, HALF = 128, HTB = HALF * BK * 2  , STAGE_BYTES = 8 * HTB, NXCD = 8, WGM = 4;

__host__ __device__ __forceinline__ int lds_byte(int r, int c) { const int st = (r >> 4) * 2 + (c >> 5), rr = r & 15, cc = c & 31, ob = rr * 64 + cc * 2; return st * 1024 + (ob ^ (((ob >> 9) & 1) << 5)); }
__host__ __device__ __forceinline__ void stage_rc(int b, int& R, int& C) { const int st = b / 1024, sb = b % 1024, swz = sb ^ (((sb >> 9) & 1) << 5); R = (st >> 1) * 16 + swz / 64; C = (st & 1) * 32 + (swz % 64) / 2; }
__host__ __device__ __forceinline__ int perm32(int rho) { const int n = rho >> 4, i = rho & 15; return 8 * (i >> 2) + 4 * n + (i & 3); }

struct Unit { int pm, pn; };
struct Gemm { const bf16_t* A; const bf16_t* Bt; int M, N, K; };

struct StaticOrder {
    int nM, nN, nwg, G, c;
    __host__ __device__ void init(int M, int N, int G_, int c_) { nM = M / BM; nN = N / BM; nwg = nM * nN; G = G_; c = c_; }
    __host__ __device__ bool next(int i, Unit& u) const {
        const long L = (long)i * G + c; if (L >= nwg) return false;
        int wgid = (int)L; { const int q = nwg / NXCD, r = nwg % NXCD, xcd = wgid % NXCD, off = wgid / NXCD; wgid = (xcd < r ? xcd * (q + 1) : r * (q + 1) + (xcd - r) * q) + off; }
        const int nig = WGM * nN, gid = wgid / nig, fm = gid * WGM, gsz = (nM - fm) < WGM ? (nM - fm) : WGM;
        u.pm = fm + ((wgid % nig) % gsz); u.pn = (wgid % nig) / gsz; return true;
    }
    __device__ __forceinline__ void a_ready(const Unit&) const {}
    __device__ __forceinline__ void done(const Unit&) const {}
};

__device__ __forceinline__ unsigned cvt_pk_bf16(float lo, float hi) { unsigned r; asm volatile("v_cvt_pk_bf16_f32 %0, %1, %2" : "=v"(r) : "v"(lo), "v"(hi)); return r; }
template <class E, class = void> struct MidT { static constexpr int v = -1; };
template <class E> struct MidT<E, decltype((void)E::MID_T)> { static constexpr int v = E::MID_T; };
template <class Epi, class Sched, bool ALIGN_EPI = false, bool SP2 = false>
__device__ __forceinline__ void gemm_phase(PG8_LAS unsigned char* lds, const Gemm g, const Sched& S, const Epi& E, const int wid, const int lane) {
    const int tid = wid * 64 + lane, wr = wid >> 2, wc = wid & 3, fr = lane & 15, fq = lane >> 4;
    const int K = g.K, nt = K / BK;
    unsigned voffA[2], voffB[2];
#pragma unroll
    for (int i = 0; i < 2; ++i) { int R, C; stage_rc(tid * 16 + i * 8192, R, C); const int Rb = Epi::PERM ? ((R & ~31) + perm32(R & 31)) : R;
        voffA[i] = (unsigned)(R * K + C) * 2u; voffB[i] = (unsigned)(Rb * K + C) * 2u; }
    const size_t kstep = (size_t)(BK * 2);
    const size_t hstep = (size_t)HALF * K * 2;
    const size_t tstep = 2 * hstep;
    const unsigned ldsw = (unsigned)wid * 1024u;
    const int aoff = lds_byte(wr * 64 + fr, fq * 8), boff = lds_byte(wc * 32 + fr, fq * 8);
#define PG8_SA(b, h) (((b) * 2 + (h)) * HTB)
#define PG8_SB(b, h) ((4 + (b) * 2 + (h)) * HTB)
#define PG8_STAGE(bufoff, gbase, voff) do { _Pragma("unroll") for (int _i = 0; _i < 2; ++_i) \
        __builtin_amdgcn_global_load_lds((const unsigned*)((const char*)(gbase) + (voff)[_i]), (PG8_LAS unsigned*)(lds + (bufoff) + ldsw + _i * 8192), 16, 0, 0); } while (0)
#define PG8_LDA(dst, b, h) do { _Pragma("unroll") for (int m = 0; m < 4; ++m) _Pragma("unroll") for (int k = 0; k < 2; ++k) dst[m][k] = *(const PG8_LAS bf16x8*)(lds + PG8_SA(b, h) + aoff + m * 2048 + k * 1024); } while (0)
#define PG8_LDB(dst, b, h) do { _Pragma("unroll") for (int n = 0; n < 2; ++n) _Pragma("unroll") for (int k = 0; k < 2; ++k) dst[n][k] = *(const PG8_LAS bf16x8*)(lds + PG8_SB(b, h) + boff + n * 2048 + k * 1024); } while (0)
#define PG8_MMA(ai, bj, At, Bt) do { __builtin_amdgcn_s_setprio(1); _Pragma("unroll") for (int m = 0; m < 4; ++m) _Pragma("unroll") for (int n = 0; n < 2; ++n) _Pragma("unroll") for (int k = 0; k < 2; ++k) \
        acc[ai][bj][m][n] = __builtin_amdgcn_mfma_f32_16x16x32_bf16(Bt[n][k], At[m][k], acc[ai][bj][m][n], 0, 0, 0); __builtin_amdgcn_s_setprio(0); } while (0)
#define PG8_WAIT_V(n) asm volatile("s_waitcnt vmcnt(" #n ")" ::: "memory")
#define PG8_WAIT_L(n) asm volatile("s_waitcnt lgkmcnt(" #n ")" ::: "memory")
#define PG8_BAR __builtin_amdgcn_s_barrier()
#define PG8_SCHED __builtin_amdgcn_sched_barrier(0)
    Unit cur, nxt; int ui = 0;
    if (!S.next(0, cur)) return;
    f32x4 acc[2][2][4][2];
#pragma unroll
    for (int a = 0; a < 2; ++a)
#pragma unroll
        for (int b = 0; b < 2; ++b)
#pragma unroll
            for (int m = 0; m < 4; ++m)
#pragma unroll
                for (int n = 0; n < 2; ++n) acc[a][b][m][n] = (f32x4){0.f, 0.f, 0.f, 0.f};
    bf16x8 At[4][2], B0[2][2], B1[2][2];
    const char* cA = (const char*)g.A + (size_t)cur.pm * tstep; const char* cB = (const char*)g.Bt + (size_t)cur.pn * tstep;
    S.a_ready(cur);
    if constexpr (SP2) {
        PG8_STAGE(PG8_SB(0, 0), cB, voffB); PG8_STAGE(PG8_SB(0, 1), cB + hstep, voffB); PG8_STAGE(PG8_SA(0, 0), cA, voffA); PG8_STAGE(PG8_SA(0, 1), cA + hstep, voffA);
        if (wr == 1) PG8_BAR;
        PG8_WAIT_V(2); PG8_BAR;
        PG8_STAGE(PG8_SB(1, 0), cB + kstep, voffB); PG8_STAGE(PG8_SA(1, 0), cA + kstep, voffA); PG8_STAGE(PG8_SB(1, 1), cB + hstep + kstep, voffB);
        PG8_WAIT_V(6); PG8_BAR;
    } else {
        PG8_STAGE(PG8_SB(0, 0), cB, voffB); PG8_STAGE(PG8_SA(0, 0), cA, voffA); PG8_STAGE(PG8_SB(0, 1), cB + hstep, voffB); PG8_STAGE(PG8_SA(0, 1), cA + hstep, voffA);
        if (wr == 1) PG8_BAR;
        PG8_WAIT_V(4); PG8_BAR;
        PG8_STAGE(PG8_SB(1, 0), cB + kstep, voffB); PG8_STAGE(PG8_SA(1, 0), cA + kstep, voffA); PG8_STAGE(PG8_SB(1, 1), cB + hstep + kstep, voffB);
        PG8_WAIT_V(6); PG8_BAR;
    }
    for (;;) {
        const bool has_next = S.next(ui + 1, nxt);
        const char* nA = has_next ? (const char*)g.A + (size_t)nxt.pm * tstep : cA; const char* nB = has_next ? (const char*)g.Bt + (size_t)nxt.pn * tstep : cB;
        for (int t = 0; t < nt; t += 2) {
            if constexpr (MidT<Epi>::v >= 0) { if (t == MidT<Epi>::v) { PG8_SCHED; E.mid(acc, cur, wr, wc, fr, fq); PG8_SCHED; } }
            const bool last = (t == nt - 2);
            const char* a1 = cA + (size_t)(t + 1) * kstep;
            const char* a2 = last ? nA : cA + (size_t)(t + 2) * kstep; const char* b2 = last ? nB : cB + (size_t)(t + 2) * kstep;
            const char* a3 = a2 + kstep; const char* b3 = b2 + kstep;
            if (last && has_next) S.a_ready(nxt);
            if constexpr (SP2) {
            PG8_LDB(B0, 0, 0); PG8_LDB(B1, 0, 1); PG8_SCHED; PG8_LDA(At, 0, 0); PG8_STAGE(PG8_SA(1, 1), a1 + hstep, voffA);
            PG8_WAIT_V(8); PG8_WAIT_L(0); PG8_BAR; PG8_MMA(0, 0, At, B0); PG8_MMA(0, 1, At, B1); PG8_BAR; PG8_SCHED;
            PG8_LDA(At, 0, 1); PG8_STAGE(PG8_SB(0, 0), b2, voffB); PG8_STAGE(PG8_SB(0, 1), b2 + hstep, voffB); PG8_STAGE(PG8_SA(0, 0), a2, voffA);
            PG8_WAIT_V(8); PG8_WAIT_L(0); PG8_BAR; PG8_MMA(1, 0, At, B0); PG8_MMA(1, 1, At, B1); PG8_BAR; PG8_SCHED;
            PG8_LDB(B0, 1, 0); PG8_LDB(B1, 1, 1); PG8_SCHED; PG8_LDA(At, 1, 0); PG8_STAGE(PG8_SA(0, 1), a2 + hstep, voffA);
            PG8_WAIT_V(8); PG8_WAIT_L(0); PG8_BAR; PG8_MMA(0, 0, At, B0); PG8_MMA(0, 1, At, B1); PG8_BAR; PG8_SCHED;
            PG8_LDA(At, 1, 1); PG8_STAGE(PG8_SB(1, 0), b3, voffB); PG8_STAGE(PG8_SB(1, 1), b3 + hstep, voffB); PG8_STAGE(PG8_SA(1, 0), a3, voffA);
            PG8_WAIT_V(8); PG8_WAIT_L(0); PG8_BAR; PG8_MMA(1, 0, At, B0); PG8_MMA(1, 1, At, B1); PG8_BAR; PG8_SCHED;
            } else {
            PG8_LDB(B0, 0, 0); PG8_SCHED; PG8_LDA(At, 0, 0); PG8_STAGE(PG8_SA(1, 1), a1 + hstep, voffA);
            PG8_WAIT_L(8); PG8_BAR; PG8_WAIT_L(0); PG8_MMA(0, 0, At, B0); PG8_BAR; PG8_SCHED;
            PG8_LDB(B1, 0, 1); PG8_STAGE(PG8_SB(0, 0), b2, voffB);
            PG8_BAR; PG8_WAIT_L(0); PG8_MMA(0, 1, At, B1); PG8_BAR;
            PG8_LDA(At, 0, 1); PG8_STAGE(PG8_SA(0, 0), a2, voffA);
            PG8_BAR; PG8_WAIT_L(0); PG8_MMA(1, 0, At, B0); PG8_BAR; PG8_SCHED;
            PG8_STAGE(PG8_SB(0, 1), b2 + hstep, voffB);
            PG8_WAIT_V(6); PG8_BAR; PG8_MMA(1, 1, At, B1); PG8_BAR;
            PG8_LDB(B0, 1, 0); PG8_SCHED; PG8_LDA(At, 1, 0); PG8_STAGE(PG8_SA(0, 1), a2 + hstep, voffA);
            PG8_WAIT_L(8); PG8_BAR; PG8_WAIT_L(0); PG8_MMA(0, 0, At, B0); PG8_BAR; PG8_SCHED;
            PG8_LDB(B1, 1, 1); PG8_STAGE(PG8_SB(1, 0), b3, voffB);
            PG8_BAR; PG8_WAIT_L(0); PG8_MMA(0, 1, At, B1); PG8_BAR;
            PG8_LDA(At, 1, 1); PG8_STAGE(PG8_SA(1, 0), a3, voffA);
            PG8_BAR; PG8_WAIT_L(0); PG8_MMA(1, 0, At, B0); PG8_BAR; PG8_SCHED;
            PG8_STAGE(PG8_SB(1, 1), b3 + hstep, voffB);
            PG8_WAIT_V(6); PG8_BAR; PG8_MMA(1, 1, At, B1); PG8_BAR;
            }
        }
        if constexpr (ALIGN_EPI) { if (wr == 0) PG8_BAR; }
        if constexpr (!Epi::AFTER_DRAIN) { E(acc, cur, wr, wc, fr, fq); S.done(cur); }
        if (!has_next) break;
#pragma unroll
        for (int a = 0; a < 2; ++a)
#pragma unroll
            for (int b = 0; b < 2; ++b)
#pragma unroll
                for (int m = 0; m < 4; ++m)
#pragma unroll
                    for (int n = 0; n < 2; ++n) acc[a][b][m][n] = (f32x4){0.f, 0.f, 0.f, 0.f};
        cur = nxt; cA = nA; cB = nB; ++ui;
        if constexpr (ALIGN_EPI) { if (wr == 1) PG8_BAR; }
    }
    PG8_WAIT_V(0);
    if constexpr (!ALIGN_EPI) { if (wr == 0) PG8_BAR; }
    PG8_BAR;
    if constexpr (Epi::AFTER_DRAIN) { E.fused(acc, cur, wr, wc, fr, fq, lds, wid, lane); S.done(cur); }
#undef PG8_SA
#undef PG8_SB
#undef PG8_STAGE
#undef PG8_LDA
#undef PG8_LDB
#undef PG8_MMA
#undef PG8_WAIT_V
#undef PG8_WAIT_L
#undef PG8_BAR
#undef PG8_SCHED
}
}

struct EpiP1 {
    bf16 *UP, *Qb, *Kb, *Vb, *GP, *GA;
    __device__ __forceinline__ void store8(int row, int col, f32x4 a, f32x4 b) const {
        bf16* dst; int c;
        if (col < 512) { dst = UP + (size_t)row * PW; c = col; }
        else if (col < 1536) { if (row >= M) return; dst = Qb + (size_t)row * AW; c = col - 512; a = a * QSCALE; b = b * QSCALE; }
        else if (col < 2560) { dst = Kb + (size_t)row * AW; c = col - 1536; }
        else if (col < 3584) { dst = Vb + (size_t)row * AW; c = col - 2560; }
        else { if (row >= M) return; const bool ga = col >= 4608; dst = (ga ? GA : GP) + (size_t)row * D; c = col - (ga ? 4608 : 3584);
#pragma unroll
            for (int i = 0; i < 4; ++i) { a[i] = sigmoidf_(a[i]); b[i] = sigmoidf_(b[i]); } }
        u32x4 w; w.x = pk2(a[0], a[1]); w.y = pk2(a[2], a[3]); w.z = pk2(b[0], b[1]); w.w = pk2(b[2], b[3]);
        *(u32x4*)(dst + c) = w;
    }
};
struct EpiP3 {
    static constexpr bool PERM = true, AFTER_DRAIN = false; static constexpr int MID_T = PW / 64;
    const bf16 *GP, *GA; bf16* MERGED;
    __device__ __forceinline__ static float gsafe(float g) { return __builtin_fmaxf(g, 8.6736174e-19f); }
    __device__ __forceinline__ void mid(f32x4 (&acc)[2][2][4][2], const pg8::Unit& u, int wr, int wc, int fr, int fq) const {
        asm volatile("" : "+v"(fr), "+v"(fq));
        const int row0 = u.pm * 256 + wr * 64 + fr, col0 = u.pn * 256 + wc * 32 + 8 * fq;
#pragma unroll
        for (int ai = 0; ai < 2; ++ai)
#pragma unroll
            for (int m = 0; m < 4; ++m) { const size_t ro = (size_t)(row0 + ai * 128 + m * 16) * D + col0;
#pragma unroll
                for (int bj = 0; bj < 2; ++bj) { const u32x4 p = *(const u32x4*)(GP + ro + bj * 128), a = *(const u32x4*)(GA + ro + bj * 128);
                    f32x4& x = acc[ai][bj][m][0]; f32x4& y = acc[ai][bj][m][1];
                    x[0] *= bflo(p.x) * __builtin_amdgcn_rcpf(gsafe(bflo(a.x))); x[1] *= bfhi(p.x) * __builtin_amdgcn_rcpf(gsafe(bfhi(a.x)));
                    x[2] *= bflo(p.y) * __builtin_amdgcn_rcpf(gsafe(bflo(a.y))); x[3] *= bfhi(p.y) * __builtin_amdgcn_rcpf(gsafe(bfhi(a.y)));
                    y[0] *= bflo(p.z) * __builtin_amdgcn_rcpf(gsafe(bflo(a.z))); y[1] *= bfhi(p.z) * __builtin_amdgcn_rcpf(gsafe(bfhi(a.z)));
                    y[2] *= bflo(p.w) * __builtin_amdgcn_rcpf(gsafe(bflo(a.w))); y[3] *= bfhi(p.w) * __builtin_amdgcn_rcpf(gsafe(bfhi(a.w))); }
                asm volatile("" : "+v"(acc[ai][0][m][0]), "+v"(acc[ai][0][m][1]), "+v"(acc[ai][1][m][0]), "+v"(acc[ai][1][m][1]));
                asm volatile("" ::: "memory"); }
    }
    __device__ __forceinline__ void operator()(const f32x4 (&acc)[2][2][4][2], const pg8::Unit& u, int wr, int wc, int fr, int fq) const {
        const int row0 = u.pm * 256 + wr * 64 + fr, col0 = u.pn * 256 + wc * 32 + 8 * fq;
#pragma unroll
        for (int ai = 0; ai < 2; ++ai)
#pragma unroll
            for (int m = 0; m < 4; ++m) { const size_t ro = (size_t)(row0 + ai * 128 + m * 16) * D + col0;
#pragma unroll
                for (int bj = 0; bj < 2; ++bj) { const u32x4 a = *(const u32x4*)(GA + ro + bj * 128); const f32x4 x = acc[ai][bj][m][0], y = acc[ai][bj][m][1];
                    u32x4 w; w.x = pk2(x[0] * gsafe(bflo(a.x)), x[1] * gsafe(bfhi(a.x))); w.y = pk2(x[2] * gsafe(bflo(a.y)), x[3] * gsafe(bfhi(a.y)));
                    w.z = pk2(y[0] * gsafe(bflo(a.z)), y[1] * gsafe(bfhi(a.z))); w.w = pk2(y[2] * gsafe(bflo(a.w)), y[3] * gsafe(bfhi(a.w)));
                    *(u32x4*)(MERGED + ro + bj * 128) = w; } }
    }
};
struct EpiP4 {
    const float* x; bf16* HB;
    __device__ __forceinline__ float store8(int row, int col, f32x4 a, f32x4 b) const {
        const float* xr = x + (size_t)row * D + col; a = a + __builtin_nontemporal_load((const f32x4*)xr); b = b + __builtin_nontemporal_load((const f32x4*)(xr + 4));
        u32x4 w; w.x = pk2(a[0], a[1]); w.y = pk2(a[2], a[3]); w.z = pk2(b[0], b[1]); w.w = pk2(b[2], b[3]);
        *(u32x4*)(HB + (size_t)row * D + col) = w;
        return (a[0] * a[0] + a[1] * a[1]) + (a[2] * a[2] + a[3] * a[3]) + (b[0] * b[0] + b[1] * b[1]) + (b[2] * b[2] + b[3] * b[3]);
    }
};
struct EpiP5 {
    bf16* ACT;
    __device__ __forceinline__ void store8(int row, int ocol, float rstd, f32x4 g0, f32x4 g1, f32x4 u0, f32x4 u1) const {
        float r[8];
#pragma unroll
        for (int i = 0; i < 4; ++i) { const float ga = g0[i] * rstd, gb = g1[i] * rstd; r[i] = ga * sigmoidf_(ga) * (u0[i] * rstd); r[4 + i] = gb * sigmoidf_(gb) * (u1[i] * rstd); }
        u32x4 w; w.x = pk2(r[0], r[1]); w.y = pk2(r[2], r[3]); w.z = pk2(r[4], r[5]); w.w = pk2(r[6], r[7]);
        *(u32x4*)(ACT + (size_t)row * FF + ocol) = w;
    }
};
struct EpiP6 {
    const bf16* HB; float* H;
    __device__ __forceinline__ void store8(int row, int col, f32x4 a, f32x4 b) const {
        const u32x4 h = *(const u32x4*)(HB + (size_t)row * D + col); float* o = H + (size_t)row * D + col;
        a[0] += bflo(h.x); a[1] += bfhi(h.x); a[2] += bflo(h.y); a[3] += bfhi(h.y); b[0] += bflo(h.z); b[1] += bfhi(h.z); b[2] += bflo(h.w); b[3] += bfhi(h.w);
        *(f32x4*)o = a; *(f32x4*)(o + 4) = b;
    }
};

template <class Fn> struct Epi8 {
    static constexpr bool PERM = true, AFTER_DRAIN = false; Fn f;
    __device__ __forceinline__ void operator()(const f32x4 (&acc)[2][2][4][2], const pg8::Unit& u, int wr, int wc, int fr, int fq) const {
        const int row0 = u.pm * 256 + wr * 64 + fr, col0 = u.pn * 256 + wc * 32 + 8 * fq;
#pragma unroll
        for (int ai = 0; ai < 2; ++ai)
#pragma unroll
            for (int m = 0; m < 4; ++m) { const int row = row0 + ai * 128 + m * 16;
#pragma unroll
                for (int bj = 0; bj < 2; ++bj) f.store8(row, col0 + bj * 128, acc[ai][bj][m][0], acc[ai][bj][m][1]); }
    }
};
struct Epi8P1 {
    static constexpr bool PERM = true, AFTER_DRAIN = false; EpiP1 f;
    template <int CLS> __device__ __forceinline__ void half(const f32x4 (&acc)[2][2][4][2], int bj, int row0, int cb) const {
        bf16* base = CLS == 0 ? f.UP : CLS == 1 ? f.Qb : CLS == 2 ? f.Kb : CLS == 3 ? f.Vb : CLS == 4 ? f.GP : f.GA;
        constexpr int ldc = CLS == 0 ? PW : (CLS >= 4 ? D : AW);
#pragma unroll
        for (int ai = 0; ai < 2; ++ai)
#pragma unroll
            for (int m = 0; m < 4; ++m) { const int row = row0 + ai * 128 + m * 16; f32x4 a = bj ? acc[ai][1][m][0] : acc[ai][0][m][0], b = bj ? acc[ai][1][m][1] : acc[ai][0][m][1];
                if (CLS == 1) { a = a * QSCALE; b = b * QSCALE; }
                if (CLS >= 4) {
#pragma unroll
                    for (int i = 0; i < 4; ++i) { a[i] = sigmoidf_(a[i]); b[i] = sigmoidf_(b[i]); } }
                u32x4 w; w.x = pk2(a[0], a[1]); w.y = pk2(a[2], a[3]); w.z = pk2(b[0], b[1]); w.w = pk2(b[2], b[3]);
                *(u32x4*)(base + (size_t)row * ldc + cb) = w; }
    }
    __device__ __forceinline__ void operator()(const f32x4 (&acc)[2][2][4][2], const pg8::Unit& u, int wr, int wc, int fr, int fq) const {
        asm volatile("" : "+v"(fr), "+v"(fq));
        const int row0 = u.pm * 256 + wr * 64 + fr, lc = wc * 32 + 8 * fq;
        const bool meta_panel = u.pm >= M / 256;
#pragma unroll
        for (int bj = 0; bj < 2; ++bj) {
            const int colt = u.pn * 256 + bj * 128;
            if (colt < 512) half<0>(acc, bj, row0, colt + lc);
            else if (colt < 1536) { if (!meta_panel) half<1>(acc, bj, row0, colt - 512 + lc); }
            else if (colt < 2560) half<2>(acc, bj, row0, colt - 1536 + lc);
            else if (colt < 3584) half<3>(acc, bj, row0, colt - 2560 + lc);
            else if (colt < 4608) { if (!meta_panel) half<4>(acc, bj, row0, colt - 3584 + lc); }
            else { if (!meta_panel) half<5>(acc, bj, row0, colt - 4608 + lc); }
        }
    }
};
struct Epi8P4 {
    static constexpr bool PERM = true, AFTER_DRAIN = false; EpiP4 f; float* PART;
    __device__ __forceinline__ void operator()(const f32x4 (&acc)[2][2][4][2], const pg8::Unit& u, int wr, int wc, int fr, int fq) const {
        const int row0 = u.pm * 256 + wr * 64 + fr, col0 = u.pn * 256 + wc * 32 + 8 * fq;
#pragma unroll
        for (int ai = 0; ai < 2; ++ai)
#pragma unroll
            for (int m = 0; m < 4; ++m) { const int row = row0 + ai * 128 + m * 16;
                float s = f.store8(row, col0, acc[ai][0][m][0], acc[ai][0][m][1]) + f.store8(row, col0 + 128, acc[ai][1][m][0], acc[ai][1][m][1]);
                s += __shfl_xor(s, 16); s += __shfl_xor(s, 32);
                if (fq == 0) PART[(size_t)row * 16 + u.pn * 4 + wc] = s; }
    }
};
struct Epi8P5 {
    static constexpr bool PERM = true, AFTER_DRAIN = false; EpiP5 f; const float* PART;
    __device__ __forceinline__ void operator()(const f32x4 (&acc)[2][2][4][2], const pg8::Unit& u, int wr, int wc, int fr, int fq) const {
        const int row0 = u.pm * 256 + wr * 64 + fr, ocol = u.pn * 128 + wc * 32 + 8 * fq;
#pragma unroll
        for (int ai = 0; ai < 2; ++ai)
#pragma unroll
            for (int m = 0; m < 4; ++m) { const int row = row0 + ai * 128 + m * 16;
                const f32x4 p = *(const f32x4*)(PART + (size_t)row * 16 + 4 * fq); float s = (p.x + p.y) + (p.z + p.w);
                s += __shfl_xor(s, 16); s += __shfl_xor(s, 32);
                const float rstd = __builtin_amdgcn_rsqf(s * (1.f / D) + EPS);
                f.store8(row, ocol, rstd, acc[ai][0][m][0], acc[ai][0][m][1], acc[ai][1][m][0], acc[ai][1][m][1]); }
    }
};
struct EpiFinal {
    static constexpr bool PERM = true, AFTER_DRAIN = true;
    const bf16* HB; float* H; const float* finw; unsigned* xbuf; unsigned* cnt;
    __device__ __forceinline__ void fused(f32x4 (&acc)[2][2][4][2], const pg8::Unit& u, int wr, int wc, int fr, int fq, LAS unsigned char* lds, int wid, int lane) const {
        LAS float* P = (LAS float*)lds;
        LAS float* S = (LAS float*)(lds + 4096);
        const int row0 = u.pm * 256 + wr * 64 + fr, col0 = u.pn * 256 + wc * 32 + 8 * fq;
#pragma unroll
        for (int ai = 0; ai < 2; ++ai)
#pragma unroll
            for (int m = 0; m < 4; ++m) { const int row = row0 + ai * 128 + m * 16; float s = 0.f;
#pragma unroll
                for (int bj = 0; bj < 2; ++bj) { const u32x4 h = *(const u32x4*)(HB + (size_t)row * D + col0 + bj * 128);
                    const f32x4 a = acc[ai][bj][m][0] + (f32x4){bflo(h.x), bfhi(h.x), bflo(h.y), bfhi(h.y)}, b = acc[ai][bj][m][1] + (f32x4){bflo(h.z), bfhi(h.z), bflo(h.w), bfhi(h.w)}; acc[ai][bj][m][0] = a; acc[ai][bj][m][1] = b;
                    s += (a[0] * a[0] + a[1] * a[1]) + (a[2] * a[2] + a[3] * a[3]) + (b[0] * b[0] + b[1] * b[1]) + (b[2] * b[2] + b[3] * b[3]); }
                s += __shfl_xor(s, 16); s += __shfl_xor(s, 32);
                if (fq == 0) P[(ai * 128 + wr * 64 + m * 16 + fr) * 4 + wc] = s;
                if (m & 1) asm volatile("" ::: "memory"); }
        asm volatile("s_waitcnt lgkmcnt(0)" ::: "memory"); __builtin_amdgcn_s_barrier(); asm volatile("" ::: "memory");
        const int row = wid * 32 + (lane & 31);
        if (lane < 32) { const f32x4 p = *(const LAS f32x4*)(P + row * 4); const float t = (p.x + p.y) + (p.z + p.w);
            __hip_atomic_store(xbuf + ((size_t)(u.pm * 256 + row) * 4 + u.pn), __float_as_uint(t), __ATOMIC_RELAXED, __HIP_MEMORY_SCOPE_AGENT); }
        asm volatile("s_waitcnt vmcnt(0)" ::: "memory");
        if (lane == 0) __hip_atomic_fetch_add(cnt + 64 * u.pm, 1u, __ATOMIC_RELAXED, __HIP_MEMORY_SCOPE_AGENT);
        if (wid == 0) {
            for (unsigned sp = 0; sp < (1u << 22); ++sp) {
                if ((unsigned)__builtin_amdgcn_readfirstlane(__hip_atomic_load(cnt + 64 * u.pm, __ATOMIC_RELAXED, __HIP_MEMORY_SCOPE_AGENT)) >= 32u) break;
                __builtin_amdgcn_s_sleep(2); }
            __builtin_amdgcn_fence(__ATOMIC_ACQUIRE, "agent");
        }
        asm volatile("s_waitcnt vmcnt(0) lgkmcnt(0)" ::: "memory"); __builtin_amdgcn_s_barrier(); asm volatile("" ::: "memory");
        if (lane < 32) { const unsigned* slot = xbuf + (size_t)(u.pm * 256 + row) * 4; float t = 0.f;
#pragma unroll
            for (int k = 0; k < 4; ++k) t += __uint_as_float(__hip_atomic_load(slot + k, __ATOMIC_RELAXED, __HIP_MEMORY_SCOPE_AGENT));
            S[row] = 1.f / sqrtf(t * (1.f / D) + EPS); }
        asm volatile("s_waitcnt lgkmcnt(0)" ::: "memory"); __builtin_amdgcn_s_barrier(); asm volatile("" ::: "memory");
        f32x4 wv[2][2];
#pragma unroll
        for (int bj = 0; bj < 2; ++bj) { wv[bj][0] = *(const f32x4*)(finw + col0 + bj * 128); wv[bj][1] = *(const f32x4*)(finw + col0 + bj * 128 + 4); }
#pragma unroll
        for (int ai = 0; ai < 2; ++ai)
#pragma unroll
            for (int m = 0; m < 4; ++m) { const int r = ai * 128 + wr * 64 + m * 16 + fr; const float rs = S[r]; float* h = H + (size_t)(u.pm * 256 + r) * D + col0;
#pragma unroll
                for (int bj = 0; bj < 2; ++bj) { *(f32x4*)(h + bj * 128) = acc[ai][bj][m][0] * rs * wv[bj][0]; *(f32x4*)(h + bj * 128 + 4) = acc[ai][bj][m][1] * rs * wv[bj][1]; } }
    }
};
struct OrderP1 {
    pg8::StaticOrder so;
    __device__ void init(int G, int c) { so.init(M, INC, G, c); }
    __device__ bool next(int i, pg8::Unit& u) const {
        if (so.next(i, u)) {
            const int s = u.pn;
            u.pn = ((u.pm >> 2) & 1) ? (s < 6 ? s : s < 10 ? s + 8 : s < 14 ? s - 4 : s < 18 ? s + 4 : s - 8) : (s < 4 ? s : s < 8 ? s + 10 : s < 12 ? s - 4 : s < 16 ? s + 6 : s - 8);
            return true; }
        const long e = (long)i * so.G + so.c - so.nwg; if (e < 0 || e >= 10) return false;
        u.pm = M / 256; u.pn = (e < 2) ? (int)e : (int)e + 4; return true;
    }
    __device__ __forceinline__ void a_ready(const pg8::Unit&) const {}
    __device__ __forceinline__ void done(const pg8::Unit&) const {}
};

__device__ __forceinline__ void bf8_add(float (&s)[8], const u32x4 v, float sg) {
    s[0] += sg * bflo(v.x); s[1] += sg * bfhi(v.x); s[2] += sg * bflo(v.y); s[3] += sg * bfhi(v.y); s[4] += sg * bflo(v.z); s[5] += sg * bfhi(v.z); s[6] += sg * bflo(v.w); s[7] += sg * bfhi(v.w);
}
__device__ __forceinline__ void pool_phase(Frame& F) {
    constexpr int RUN = 8;
    const long total = (long)(M / RUN) * (PW / 8);
    for (long it = (long)blockIdx.x * NTHR + F.tid; it < total; it += (long)F.G * NTHR) {
        const int m0 = (int)(it / (PW / 8)) * RUN, c0 = (int)(it % (PW / 8)) * 8, b = m0 / SEQ, t0 = m0 % SEQ, g = c0 / 128, w = 2 << g;
        const float iw = 1.f / (float)w;
        auto urow = [&](int tt) -> const bf16* { return F.UP + ((tt >= 0) ? (size_t)(b * SEQ + tt) : (size_t)(M + NMETA + tt)) * PW + c0; };
        float s[8];
#pragma unroll
        for (int j = 0; j < 8; ++j) s[j] = 0.f;
        for (int i = 1; i < w; ++i) bf8_add(s, *(const u32x4*)urow(t0 - i), 1.f);
#pragma unroll
        for (int r = 0; r < RUN; ++r) { const int t = t0 + r;
            const u32x4 self = *(const u32x4*)urow(t); bf8_add(s, self, 1.f);
            u32x4 o; o.x = pk2(s[0] * iw - bflo(self.x), s[1] * iw - bfhi(self.x)); o.y = pk2(s[2] * iw - bflo(self.y), s[3] * iw - bfhi(self.y));
            o.z = pk2(s[4] * iw - bflo(self.z), s[5] * iw - bfhi(self.z)); o.w = pk2(s[6] * iw - bflo(self.w), s[7] * iw - bfhi(self.w));
            *(u32x4*)(F.ACAT + (size_t)(m0 + r) * KC + c0) = o;
            if (r + 1 < RUN) bf8_add(s, *(const u32x4*)urow(t - w + 1), -1.f); }
    }
}

__device__ __forceinline__ int t5_bucket(int rel) {
    const int n = rel < 0 ? -rel : rel; int r = rel > 0 ? 16 : 0;
    int v;
    if (n < 8) v = n; else if (n < 12) v = 8; else if (n < 16) v = 9; else if (n < 23) v = 10; else if (n < 32) v = 11; else if (n < 46) v = 12; else if (n < 64) v = 13; else if (n < 91) v = 14; else v = 15;
    return r + v;
}
__device__ __forceinline__ float compute_lambda(const Frame& F) {
    float a = 0.f, b = 0.f;
    for (int i = 0; i < HD; ++i) { a += F.lq1[i] * F.lk1[i]; b += F.lq2[i] * F.lk2[i]; }
    return __expf(a) - __expf(b) + 0.2f;
}
namespace attn {
typedef short bf16x8 __attribute__((ext_vector_type(8)));
typedef short s16x4 __attribute__((ext_vector_type(4)));
typedef float f32x16 __attribute__((ext_vector_type(16)));
typedef short v4i16_t __attribute__((ext_vector_type(4)));
typedef LAS const char* lds_cptr;
constexpr int RSLOT = 16384, LDS_KR = 0, LDS_VR = 3 * RSLOT;
constexpr int STG_PITCH = 132;
constexpr int LDS_WS = 6 * RSLOT, LDS_BIAS = LDS_WS + 2048, NBIAS = 320;
constexpr int THR = 8;
static_assert(128 * STG_PITCH * 4 <= LDS_WS && LDS_BIAS + NBIAS * 4 <= RING_BYTES, "attention LDS map");
__device__ __forceinline__ int crow(int r, int hi) { return (r & 3) + 8 * (r >> 2) + 4 * hi; }
__device__ __forceinline__ void glds16s(const void* sbase, unsigned voff, unsigned lds_dst) { unsigned keep;
    asm volatile("s_nop 4\n\ts_mov_b32 %0, m0\n\ts_mov_b32 m0, %3\n\ts_nop 0\n\tglobal_load_lds_dwordx4 %1, %2\n\ts_mov_b32 m0, %0" : "=&s"(keep) : "v"(voff), "s"(sbase), "s"(lds_dst) : "memory"); }
typedef float f32x2_t __attribute__((ext_vector_type(2))); typedef __bf16 bf16x2_t __attribute__((ext_vector_type(2)));
__device__ __forceinline__ unsigned cvtpk(float lo, float hi) { f32x2_t v = {lo, hi}; bf16x2_t b = __builtin_convertvector(v, bf16x2_t); return __builtin_bit_cast(unsigned, b); }
__device__ __forceinline__ s16x4 vtr(lds_cptr p) { return __builtin_bit_cast(s16x4, __builtin_amdgcn_ds_read_tr16_b64_v4i16((LAS v4i16_t*)p)); }
#define ATT_WAIT_BAR() asm volatile("s_waitcnt vmcnt(0) lgkmcnt(0)\n\ts_barrier" ::: "memory")
#define ATT_MX3(a, b, c) __builtin_fmaxf(__builtin_fmaxf((a), (b)), (c))
__device__ __forceinline__ float rowmax(const f32x16& p0, const f32x16& p1) {
    float a = ATT_MX3(p0[0], p0[1], p1[0]), b = ATT_MX3(p0[2], p0[3], p1[1]); a = ATT_MX3(a, p1[2], p1[3]);
#pragma unroll
    for (int r = 4; r < 16; r += 4) { a = ATT_MX3(a, p0[r], p0[r + 1]); b = ATT_MX3(b, p0[r + 2], p0[r + 3]); a = ATT_MX3(a, p1[r], p1[r + 1]); b = ATT_MX3(b, p1[r + 2], p1[r + 3]); }
    float m = __builtin_fmaxf(a, b); auto rr = __builtin_amdgcn_permlane32_swap(__float_as_uint(m), __float_as_uint(m), false, false);
    return __builtin_fmaxf(__uint_as_float(rr[0]), __uint_as_float(rr[1]));
}

__device__ __forceinline__ void pv_tile(f32x16 (&o)[4], const u32x4 (&pw)[4], const lds_cptr vp) {
#pragma unroll
    for (int db = 0; db < 4; ++db)
#pragma unroll
        for (int ks = 0; ks < 4; ++ks) {
            const s16x4 lo = vtr(vp + db * 4096 + ks * 1024), hh = vtr(vp + db * 4096 + ks * 1024 + 512);
            const bf16x8 vf = (bf16x8){lo[0], lo[1], lo[2], lo[3], hh[0], hh[1], hh[2], hh[3]};
            o[db] = __builtin_amdgcn_mfma_f32_32x32x16_bf16(__builtin_bit_cast(bf16x8, pw[ks]), vf, o[db], 0, 0, 0);
        }
}
#define ATT_SBAR() __builtin_amdgcn_sched_barrier(0)
#define ATT_PIN(x) asm volatile("" : "+v"(x))
#define ATT_MFMA(a, b, c) __builtin_amdgcn_mfma_f32_32x32x16_bf16(a, b, c, 0, 0, 0)

__device__ __forceinline__ void attn_unit(const Frame& F, int b, int h, int qb, float lam) {
    int lane = F.lane; asm volatile("" : "+v"(lane));
    const int r32 = lane & 31, hi = lane >> 5, wid = F.wave, rg = wid & 3, map = wid >> 2;
    const int q0w = qb * 128 + rg * 32;
    const size_t rowbase = (size_t)b * SEQ;
    const LAS unsigned char* lds = F.lds;
    const unsigned lds0 = (unsigned)(uintptr_t)lds;
    LAS float* wsf = (LAS float*)(lds + LDS_WS) + wid * 64;
    const LAS float* tb = (const LAS float*)(lds + LDS_BIAS);
    const int NT = 2 * qb + 3;
    const unsigned kvoff = (unsigned)(lane * AW + wid * 8) * 2u;
    const unsigned vvoff = (unsigned)((16 * (wid & 3) + (lane >> 2)) * AW + (wid >> 2) * 32 + (lane & 3) * 8) * 2u;
    const unsigned pdst = lds0 + wid * 1024;
#define ATT_TROW(t) ((t) == 0 ? (size_t)M : rowbase + (size_t)64 * ((t) - 1))
#define ATT_DMA_K(t, slot) do { const bf16* kb_ = F.Kb + ATT_TROW(t) * AW + h * 128; const unsigned d_ = (unsigned)__builtin_amdgcn_readfirstlane(pdst + LDS_KR + (slot)); \
        glds16s(kb_, kvoff, d_); glds16s(kb_ + 64, kvoff, d_ + 8192); } while (0)
#define ATT_DMA_V(t, slot) do { const bf16* vb_ = F.Vb + ATT_TROW(t) * AW + h * 128; const unsigned d_ = (unsigned)__builtin_amdgcn_readfirstlane(pdst + LDS_VR + (slot)); \
        glds16s(vb_, vvoff, d_); glds16s(vb_ + 64, vvoff, d_ + 8192); } while (0)
    ATT_DMA_K(0, 0); ATT_DMA_V(0, 0); ATT_DMA_K(1, RSLOT);
    bf16x8 qr[4];
    { const bf16* Qw = F.Qb + (rowbase + q0w + r32) * AW + h * 128 + map * 64 + hi * 8;
#pragma unroll
      for (int d0 = 0; d0 < 4; ++d0) qr[d0] = *(const bf16x8*)(Qw + d0 * 16); }
    float mhat = 0.f, l_reg = 0.f; f32x16 o[4]; f32x16 negm = f32x16{};
#pragma unroll
    for (int i = 0; i < 4; ++i) o[i] = f32x16{};
    const lds_cptr kp0 = (lds_cptr)lds + LDS_KR + map * 8192 + hi * 1024 + r32 * 16;
    const lds_cptr vp0 = (lds_cptr)lds + LDS_VR + ((lane >> 4) & 1) * 32 + (lane & 3) * 8 + (4 * hi + ((lane & 15) >> 2)) * 64;
    const bool last_active = rg >= 2;
    bf16x8 kf[8];
#define ATT_KLOAD(kp_, j) do { kf[2 * (j)] = *(const LAS bf16x8*)((kp_) + (j) * 2048); kf[2 * (j) + 1] = *(const LAS bf16x8*)((kp_) + (j) * 2048 + 512); } while (0)
    ATT_WAIT_BAR();
    f32x16 pA0, pA1, pB0, pB1;
    ATT_DMA_K(2, 2 * RSLOT); ATT_DMA_V(1, RSLOT);
    { ATT_KLOAD(kp0, 0); ATT_KLOAD(kp0, 1); ATT_KLOAD(kp0, 2); ATT_KLOAD(kp0, 3);
      pA0 = ATT_MFMA(kf[0], qr[0], f32x16{}); pA1 = ATT_MFMA(kf[1], qr[0], f32x16{});
#pragma unroll
      for (int d0 = 1; d0 < 4; ++d0) { pA0 = ATT_MFMA(kf[2 * d0], qr[d0], pA0); pA1 = ATT_MFMA(kf[2 * d0 + 1], qr[d0], pA1); }
      if ((NMETA + q0w) - 63 < 91) {
          const LAS float* tbl = tb + ((NMETA + q0w + r32) + 128 - 4 * hi - 12);
#pragma unroll
          for (int r = 0; r < 8; ++r) pA0[r] += tbl[12 - ((r & 3) + 8 * (r >> 2))];
      }
#pragma unroll
      for (int r = 0; r < 16; ++r) { if (r >= 8) pA0[r] = -1e30f; pA1[r] = -1e30f; }
      mhat = rowmax(pA0, pA1);
#pragma unroll
      for (int r = 0; r < 16; ++r) negm[r] = -mhat;
      asm volatile("" : "+v"(negm));
#pragma unroll
      for (int r = 0; r < 16; ++r) { pA0[r] = __builtin_amdgcn_exp2f(pA0[r] - mhat); pA1[r] = __builtin_amdgcn_exp2f(pA1[r] - mhat); }
      const lds_cptr kn = kp0 + RSLOT; ATT_KLOAD(kn, 0); ATT_KLOAD(kn, 1); ATT_KLOAD(kn, 2); ATT_KLOAD(kn, 3); }
    asm volatile("s_waitcnt vmcnt(2) lgkmcnt(0)\n\ts_barrier" ::: "memory");
    s16x4 vlo[8], vhi[8]; u32x4 pw0, pw1, pw2, pw3; bool resc;
    int s_prev = 0, s_cur = RSLOT, s_next = 2 * RSLOT;
#define ATT_ROT() do { const int n_ = s_prev; s_prev = s_cur; s_cur = s_next; s_next = n_; } while (0)
#define ATT_VRD(i, f) do { vlo[i] = vtr(vp_ + (((f) >> 2) * 4096 + ((f) & 3) * 1024)); vhi[i] = vtr(vp_ + (((f) >> 2) * 4096 + ((f) & 3) * 1024 + 512)); } while (0)
#define ATT_VFR(i) (bf16x8){vlo[i][0], vlo[i][1], vlo[i][2], vlo[i][3], vhi[i][0], vhi[i][1], vhi[i][2], vhi[i][3]}
#define ATT_PAF(k) __builtin_bit_cast(bf16x8, pw##k)
#define ATT_GAPA(MF, A0, A1, A2, A3, W0, W1, PW) do { MF; sacc += A0; sacc += A1; sacc += A2; sacc += A3; ATT_PIN(sacc); W0; W1; ATT_PIN(PW); ATT_SBAR(); } while (0)
#define ATT_EX(v) __builtin_amdgcn_exp2f(v)
#define ATT_PV(i) o[(i) >> 2] = ATT_MFMA(__builtin_bit_cast(bf16x8, (((i) & 3) == 0) ? pw0 : (((i) & 3) == 1) ? pw1 : (((i) & 3) == 2) ? pw2 : pw3), ATT_VFR((i) & 7), o[(i) >> 2])
#define ATT_KRD(j) kf[j] = *(const LAS bf16x8*)(kn_ + ((j) >> 1) * 2048 + ((j) & 1) * 512)
#define ATT_EXP1(C0, C1, e) do { if ((e) < 16) C0[(e) & 15] = ATT_EX(C0[(e) & 15]); else C1[(e) & 15] = ATT_EX(C1[(e) & 15]); } while (0)
#define ATT_STEP(C0, C1, P0, P1, t) do { \
        if ((t) + 2 < NT) ATT_DMA_K((t) + 2, s_prev); \
        if ((t) + 1 < NT) ATT_DMA_V((t) + 1, s_next); \
        const lds_cptr vp_ = vp0 + s_prev; const lds_cptr kn_ = kp0 + s_next; \
        ATT_SBAR(); \
        float sacc = 0.f; \
        ATT_VRD(0, 0); ATT_VRD(1, 1); ATT_SBAR(); \
        ATT_GAPA(C0 = ATT_MFMA(kf[0], qr[0], negm), P0[0], P0[1], P0[2], P0[3],     pw0[0] = cvtpk(P0[0], P0[1]),   pw0[1] = cvtpk(P0[2], P0[3]),   pw0); \
        ATT_VRD(2, 2); ATT_SBAR(); \
        ATT_GAPA(C1 = ATT_MFMA(kf[1], qr[0], negm), P0[4], P0[5], P0[6], P0[7],     pw0[2] = cvtpk(P0[4], P0[5]),   pw0[3] = cvtpk(P0[6], P0[7]),   pw0); \
        ATT_VRD(3, 3); ATT_SBAR(); \
        ATT_GAPA(C0 = ATT_MFMA(kf[2], qr[1], C0),       P0[8], P0[9], P0[10], P0[11],   pw1[0] = cvtpk(P0[8], P0[9]),   pw1[1] = cvtpk(P0[10], P0[11]), pw1); \
        ATT_VRD(4, 4); ATT_SBAR(); \
        ATT_GAPA(C1 = ATT_MFMA(kf[3], qr[1], C1),       P0[12], P0[13], P0[14], P0[15], pw1[2] = cvtpk(P0[12], P0[13]), pw1[3] = cvtpk(P0[14], P0[15]), pw1); \
        ATT_VRD(5, 5); ATT_SBAR(); \
        ATT_GAPA(C0 = ATT_MFMA(kf[4], qr[2], C0),       P1[0], P1[1], P1[2], P1[3],     pw2[0] = cvtpk(P1[0], P1[1]),   pw2[1] = cvtpk(P1[2], P1[3]),   pw2); \
        ATT_VRD(6, 6); ATT_SBAR(); \
        ATT_GAPA(C1 = ATT_MFMA(kf[5], qr[2], C1),       P1[4], P1[5], P1[6], P1[7],     pw2[2] = cvtpk(P1[4], P1[5]),   pw2[3] = cvtpk(P1[6], P1[7]),   pw2); \
        ATT_VRD(7, 7); ATT_SBAR(); \
        ATT_GAPA(C0 = ATT_MFMA(kf[6], qr[3], C0),       P1[8], P1[9], P1[10], P1[11],   pw3[0] = cvtpk(P1[8], P1[9]),   pw3[1] = cvtpk(P1[10], P1[11]), pw3); \
        ATT_GAPA(C1 = ATT_MFMA(kf[7], qr[3], C1),       P1[12], P1[13], P1[14], P1[15], pw3[2] = cvtpk(P1[12], P1[13]), pw3[3] = cvtpk(P1[14], P1[15]), pw3); \
        l_reg += sacc; \
        { const int kpos0_ = NMETA + 64 * ((t) - 1); \
          if ((NMETA + q0w) - (kpos0_ + 63) < 91) {                                     \
              const LAS float* tbl_ = tb + ((NMETA + q0w + r32) - kpos0_ + 128 - 4 * hi - 60);     \
              _Pragma("unroll") for (int r = 0; r < 16; ++r) { const int c_ = (r & 3) + 8 * (r >> 2); C0[r] += tbl_[60 - c_]; C1[r] += tbl_[28 - c_]; } } \
          if ((t) == NT - 1 && !last_active) { _Pragma("unroll") for (int r = 0; r < 16; ++r) { C0[r] = -1e30f; C1[r] = -1e30f; } } } \
          \
        float ma_, mb_; resc = false; \
        ATT_SBAR(); \
        ATT_PV(0); ma_ = ATT_MX3(C0[0], C0[1], C1[0]); mb_ = ATT_MX3(C0[2], C0[3], C1[1]); ma_ = ATT_MX3(ma_, C1[2], C1[3]); ma_ = ATT_MX3(ma_, C0[4], C0[5]); ATT_PIN(ma_); ATT_PIN(mb_); ATT_VRD(0, 8); ATT_SBAR(); \
        ATT_PV(1); mb_ = ATT_MX3(mb_, C0[6], C0[7]); ma_ = ATT_MX3(ma_, C1[4], C1[5]); mb_ = ATT_MX3(mb_, C1[6], C1[7]); ma_ = ATT_MX3(ma_, C0[8], C0[9]); ATT_PIN(ma_); ATT_PIN(mb_); ATT_VRD(1, 9); ATT_SBAR(); \
        ATT_PV(2); mb_ = ATT_MX3(mb_, C0[10], C0[11]); ma_ = ATT_MX3(ma_, C1[8], C1[9]); mb_ = ATT_MX3(mb_, C1[10], C1[11]); ma_ = ATT_MX3(ma_, C0[12], C0[13]); ATT_PIN(ma_); ATT_PIN(mb_); ATT_VRD(2, 10); ATT_SBAR(); \
        ATT_PV(3); mb_ = ATT_MX3(mb_, C0[14], C0[15]); ma_ = ATT_MX3(ma_, C1[12], C1[13]); mb_ = ATT_MX3(mb_, C1[14], C1[15]); ATT_VRD(3, 11); \
        float rm_ = __builtin_fmaxf(ma_, mb_); { auto rr_ = __builtin_amdgcn_permlane32_swap(__float_as_uint(rm_), __float_as_uint(rm_), false, false); rm_ = __builtin_fmaxf(__uint_as_float(rr_[0]), __uint_as_float(rr_[1])); } \
        const bool grow_ = __any(rm_ > (float)THR); \
        ATT_SBAR(); \
          \
        ATT_PV(4); ATT_VRD(4, 12); ATT_KRD(0); ATT_SBAR(); \
        ATT_PV(5); ATT_VRD(5, 13); ATT_KRD(1); ATT_SBAR(); \
        if (grow_) {                                                                    \
            const float dl_ = __builtin_fmaxf(rm_, 0.f); mhat += dl_; const float f_ = __builtin_amdgcn_exp2f(-dl_); l_reg *= f_; if (hi == 0) wsf[r32] = f_; resc = true; \
            _Pragma("unroll") for (int r = 0; r < 16; ++r) { C0[r] -= dl_; C1[r] -= dl_; negm[r] = -mhat; } asm volatile("" : "+v"(negm)); } \
        ATT_SBAR(); \
          \
        ATT_PV(6);  ATT_EXP1(C0, C1, 0);  ATT_EXP1(C0, C1, 1);  ATT_EXP1(C0, C1, 2);  ATT_PIN(C0); ATT_VRD(6, 14); ATT_KRD(2); ATT_SBAR(); \
        ATT_PV(7);  ATT_EXP1(C0, C1, 3);  ATT_EXP1(C0, C1, 4);  ATT_EXP1(C0, C1, 5);  ATT_PIN(C0); ATT_VRD(7, 15); ATT_KRD(3); ATT_SBAR(); \
        ATT_PV(8);  ATT_EXP1(C0, C1, 6);  ATT_EXP1(C0, C1, 7);  ATT_EXP1(C0, C1, 8);  ATT_PIN(C0); ATT_KRD(4); ATT_SBAR(); \
        ATT_PV(9);  ATT_EXP1(C0, C1, 9);  ATT_EXP1(C0, C1, 10); ATT_EXP1(C0, C1, 11); ATT_PIN(C0); ATT_KRD(5); ATT_SBAR(); \
        ATT_PV(10); ATT_EXP1(C0, C1, 12); ATT_EXP1(C0, C1, 13); ATT_EXP1(C0, C1, 14); ATT_PIN(C0); ATT_KRD(6); ATT_SBAR(); \
        ATT_PV(11); ATT_EXP1(C0, C1, 15); ATT_EXP1(C0, C1, 16); ATT_EXP1(C0, C1, 17); ATT_PIN(C0); ATT_PIN(C1); ATT_KRD(7); ATT_SBAR(); \
        ATT_PV(12); ATT_EXP1(C0, C1, 18); ATT_EXP1(C0, C1, 19); ATT_EXP1(C0, C1, 20); ATT_EXP1(C0, C1, 21); ATT_PIN(C1); ATT_SBAR(); \
        ATT_PV(13); ATT_EXP1(C0, C1, 22); ATT_EXP1(C0, C1, 23); ATT_EXP1(C0, C1, 24); ATT_EXP1(C0, C1, 25); ATT_PIN(C1); ATT_SBAR(); \
        ATT_PV(14); ATT_EXP1(C0, C1, 26); ATT_EXP1(C0, C1, 27); ATT_EXP1(C0, C1, 28); ATT_PIN(C1); ATT_SBAR(); \
        ATT_PV(15); ATT_EXP1(C0, C1, 29); ATT_EXP1(C0, C1, 30); ATT_EXP1(C0, C1, 31); ATT_PIN(C1); ATT_SBAR(); \
        if (resc) { LDS_WAIT(); \
            _Pragma("unroll") for (int r = 0; r < 16; ++r) { const float fr_ = wsf[crow(r, hi)]; _Pragma("unroll") for (int i = 0; i < 4; ++i) o[i][r] *= fr_; } } \
        if ((t) + 1 < NT) asm volatile("s_waitcnt vmcnt(2) lgkmcnt(0)\n\ts_barrier" ::: "memory"); else asm volatile("s_waitcnt vmcnt(0) lgkmcnt(0)\n\ts_barrier" ::: "memory"); \
        ATT_ROT(); \
    } while (0)
#pragma unroll 1
    for (int t = 1; t < NT; t += 2) {
        ATT_STEP(pB0, pB1, pA0, pA1, t);
        ATT_STEP(pA0, pA1, pB0, pB1, t + 1);
    }
    { float sacc = 0.f;
#pragma unroll
      for (int r = 0; r < 16; ++r) sacc += pA0[r] + pA1[r];
      l_reg += sacc;
      u32x4 pw[4];
      pw[0] = (u32x4){cvtpk(pA0[0], pA0[1]), cvtpk(pA0[2], pA0[3]), cvtpk(pA0[4], pA0[5]), cvtpk(pA0[6], pA0[7])};
      pw[1] = (u32x4){cvtpk(pA0[8], pA0[9]), cvtpk(pA0[10], pA0[11]), cvtpk(pA0[12], pA0[13]), cvtpk(pA0[14], pA0[15])};
      pw[2] = (u32x4){cvtpk(pA1[0], pA1[1]), cvtpk(pA1[2], pA1[3]), cvtpk(pA1[4], pA1[5]), cvtpk(pA1[6], pA1[7])};
      pw[3] = (u32x4){cvtpk(pA1[8], pA1[9]), cvtpk(pA1[10], pA1[11]), cvtpk(pA1[12], pA1[13]), cvtpk(pA1[14], pA1[15])};
      pv_tile(o, pw, vp0 + s_prev); }
    ATT_WAIT_BAR();
#undef ATT_STEP
#undef ATT_GAPA
#undef ATT_PV
#undef ATT_KRD
#undef ATT_EXP1
#undef ATT_VRD
#undef ATT_KLOAD
    { auto rr = __builtin_amdgcn_permlane32_swap(__float_as_uint(l_reg), __float_as_uint(l_reg), false, false); l_reg = __uint_as_float(rr[0]) + __uint_as_float(rr[1]); }
    if (hi == 0) wsf[32 + r32] = l_reg;
    LDS_WAIT();
    float rli[16];
#pragma unroll
    for (int r = 0; r < 16; ++r) rli[r] = 1.f / wsf[32 + crow(r, hi)];
    LAS float* stg = (LAS float*)lds;
    if (map == 1) {
#pragma unroll
        for (int r = 0; r < 16; ++r) { LAS float* sp = stg + (32 * rg + crow(r, hi)) * STG_PITCH + r32;
#pragma unroll
            for (int i = 0; i < 4; ++i) sp[32 * i] = o[i][r] * rli[r]; }
    }
    ATT_WAIT_BAR();
    if (map == 0) {
#pragma unroll
        for (int r = 0; r < 16; ++r) { LAS float* sp = stg + (32 * rg + crow(r, hi)) * STG_PITCH + r32;
#pragma unroll
            for (int i = 0; i < 4; ++i) sp[32 * i] = o[i][r] * rli[r] - lam * sp[32 * i]; }
    }
    ATT_WAIT_BAR();
    { int lane2 = F.lane; asm volatile("" : "+v"(lane2)); const int row = wid * 16 + (lane2 >> 2), c0 = (lane2 & 3) * 32;
      const LAS float* sp = stg + row * STG_PITCH + c0; f32x4 v[8]; float ss = 0.f;
#pragma unroll
      for (int i = 0; i < 8; ++i) { v[i] = *(const LAS f32x4*)(sp + 4 * i); ss += (v[i].x * v[i].x + v[i].y * v[i].y) + (v[i].z * v[i].z + v[i].w * v[i].w); }
      ss += __shfl_xor(ss, 1); ss += __shfl_xor(ss, 2);
      const float rs = 0.8f / sqrtf(ss * (1.f / 128.f) + EPS);
      bf16* ao = F.ACAT + (rowbase + (size_t)qb * 128 + row) * KC + PW + h * 128 + c0; const f32x4* sw = (const f32x4*)(F.sublnw + c0);
#pragma unroll
      for (int i = 0; i < 4; ++i) { const f32x4 a = v[2 * i] * rs * sw[2 * i], c = v[2 * i + 1] * rs * sw[2 * i + 1];
          u32x4 w; w.x = pk2(a.x, a.y); w.y = pk2(a.z, a.w); w.z = pk2(c.x, c.y); w.w = pk2(c.z, c.w); *(u32x4*)(ao + 8 * i) = w; } }
    ATT_WAIT_BAR();
#undef ATT_TROW
#undef ATT_DMA_K
#undef ATT_DMA_V
#undef ATT_ROT
#undef ATT_VFR
#undef ATT_PAF
#undef ATT_EX
}
__device__ __forceinline__ void attn_phase(const Frame& F) {
    const float lam = compute_lambda(F);
    for (int v = F.vcu; v < 256; v += F.G) {
        const int xg = v >> 5, j = v & 31;
#pragma unroll 1
        for (int r = 0; r < 4; ++r) {
            const int bh = 4 * xg + r, b = bh / NH, h = bh % NH, j2 = (j + 16) & 31;
            const int qb = (r == 0) ? j : (r == 1) ? 31 - j : (r == 2) ? j2 : 31 - j2;
            __syncthreads();
            int tid_ = F.wave * 64 + (int)__builtin_amdgcn_mbcnt_hi(~0u, __builtin_amdgcn_mbcnt_lo(~0u, 0u)); asm volatile("" : "+v"(tid_));
            if (tid_ < NBIAS) { const int d = min(max(tid_ - 128, -127), 91);
                ((LAS float*)(F.lds + LDS_BIAS))[tid_] = (F.btab[t5_bucket(-d) * NH + h] - F.btab[15 * NH + h]) * LOG2E; }
            __syncthreads();
            attn_unit(F, b, h, qb, lam);
        }
    }
}
}

__device__ __forceinline__ void final_norm_phase(Frame& F) {
    const int gw = F.vcu * NWAVES + F.wave, NGW = F.G * NWAVES;
    for (int m = gw; m < M; m += NGW) {
        f32x4* xr = (f32x4*)(F.out + (size_t)m * D) + F.lane; const f32x4* wr = (const f32x4*)F.finw + F.lane;
        f32x4 v[4]; float s = 0.f;
#pragma unroll
        for (int j = 0; j < 4; ++j) { v[j] = xr[64 * j]; s += (v[j].x * v[j].x + v[j].y * v[j].y) + (v[j].z * v[j].z + v[j].w * v[j].w); }
        const float rstd = 1.f / sqrtf(wave_sum(s) * (1.f / D) + EPS);
#pragma unroll
        for (int j = 0; j < 4; ++j) xr[64 * j] = v[j] * rstd * wr[64 * j];
    }
}

typedef GAS unsigned gu32;
typedef GAS unsigned long long gu64;
#define RLX_AGENT __ATOMIC_RELAXED, __HIP_MEMORY_SCOPE_AGENT
#define XB_TMO      128
#define XB_XCNT(j)  (256  + 64 * (j))
#define XB_XSUB(j)  (1280 + 64 * (j))
#define XB_XGEN(j)  (2304 + 64 * (j))
#define XB_TOP      3328
#define XB_TOPGEN   3392
#define XCD_BAR_WORDS 3456
#define XB_SPIN_CAP (1u << 18)

__device__ __forceinline__ unsigned xb_ld(unsigned* p)              { return __hip_atomic_load(p, __ATOMIC_RELAXED, __HIP_MEMORY_SCOPE_AGENT); }
__device__ __forceinline__ unsigned xb_add(unsigned* p, unsigned v) { return __hip_atomic_fetch_add(p, v, __ATOMIC_RELAXED, __HIP_MEMORY_SCOPE_AGENT); }
__device__ __forceinline__ unsigned xb_xcc_id() { return (unsigned)__builtin_amdgcn_s_getreg((3 << 11) | 20) & 0xFu; }
#define XB_SPIN(cond, bar) do { unsigned _sp = 0; while (cond) { __builtin_amdgcn_s_sleep(1); \
    if ((++_sp & 255u) == 0u) { if (xb_ld(&(bar)[XB_TMO])) break; if (_sp > XB_SPIN_CAP) { atomicAdd(&(bar)[XB_TMO], 1u); break; } } } } while (0)

struct XcdBarrier {
    unsigned* bar; unsigned x;
    volatile LAS unsigned* st;
};

__device__ __forceinline__ XcdBarrier xcd_barrier_post(unsigned* bar, volatile LAS unsigned* st) {
    XcdBarrier b; b.bar = bar; b.x = xb_xcc_id(); b.st = st;
    if (threadIdx.x == 0) (void)xb_add(&bar[XB_XCNT(b.x)], 1u);
    return b;
}
__device__ __forceinline__ void xcd_barrier_complete(unsigned* bar, unsigned x, unsigned& nloc, unsigned& nx) {
    const unsigned G = gridDim.x * gridDim.y * gridDim.z;
    unsigned sum, cnt, mine, sp = 0u;
    for (;;) {
        sum = 0u; cnt = 0u; mine = 0u;
#pragma unroll
        for (unsigned j = 0; j < 16; ++j) { const unsigned c = xb_ld(&bar[XB_XCNT(j)]); sum += c; cnt += (c > 0u) ? 1u : 0u; mine = (j == x) ? c : mine; }
        if (sum == G) break;
        __builtin_amdgcn_s_sleep(1);
        if ((++sp & 255u) == 0u) { if (xb_ld(&bar[XB_TMO])) break; if (sp > XB_SPIN_CAP) { atomicAdd(&bar[XB_TMO], 1u); break; } }
    }
    nloc = mine > 0u ? mine : 1u; nx = cnt > 0u ? cnt : 1u;
}

__device__ __forceinline__ void xcd_barrier(const XcdBarrier& b) {
    asm volatile("s_waitcnt vmcnt(0)" ::: "memory");
    __syncthreads();
    if (threadIdx.x == 0) {
        unsigned* bar = b.bar;
        __builtin_amdgcn_s_waitcnt(0);
        unsigned nloc = b.st[0], nx = b.st[1];
        if (nloc == 0u) { xcd_barrier_complete(bar, b.x, nloc, nx); b.st[0] = nloc; b.st[1] = nx; }
        const unsigned old = xb_add(&bar[XB_XSUB(b.x)], 1u);
        const unsigned gen = old / nloc;
        if (old + 1u == (gen + 1u) * nloc) {
            __builtin_amdgcn_fence(__ATOMIC_RELEASE, "agent");
            asm volatile("s_waitcnt vmcnt(0)" ::: "memory");
            const unsigned og = xb_add(&bar[XB_TOP], 1u);
            const unsigned tg = og / nx;
            if (og + 1u == (tg + 1u) * nx) xb_add(&bar[XB_TOPGEN], 1u);
            else XB_SPIN(xb_ld(&bar[XB_TOPGEN]) == tg, bar);
            __builtin_amdgcn_fence(__ATOMIC_ACQUIRE, "agent");
            xb_add(&bar[XB_XGEN(b.x)], 1u);
            asm volatile("s_waitcnt vmcnt(0)" ::: "memory");
        } else {
            XB_SPIN(xb_ld(&bar[XB_XGEN(b.x)]) == gen, bar);
            __builtin_amdgcn_fence(__ATOMIC_ACQUIRE, "agent");
            asm volatile("s_waitcnt vmcnt(0)" ::: "memory");
        }
    }
    __syncthreads();
}

struct Args { const float* in[20]; float* out; unsigned char* ws; int ph_lo, ph_hi; };
constexpr int NPHASE = 8;

__global__ void __launch_bounds__(NTHR, 2) mk_fwd(Args args) {
    extern __shared__ __attribute__((aligned(16))) unsigned char lds[];
    Frame F;
    F.lds = (LAS unsigned char*)lds;
    F.wave = __builtin_amdgcn_readfirstlane((int)threadIdx.x >> 6); F.lane = (int)__builtin_amdgcn_mbcnt_hi(~0u, __builtin_amdgcn_mbcnt_lo(~0u, 0u)); F.tid = F.wave * 64 + F.lane;
    F.G = gridDim.x; { const int bx = blockIdx.x; F.vcu = (F.G % 8 == 0) ? (bx % 8) * (F.G / 8) + bx / 8 : bx; }
    F.x = args.in[0]; F.meta = args.in[1]; F.btab = args.in[2]; F.mixw = args.in[3]; F.win = args.in[4]; F.pgw = args.in[5]; F.pscale = args.in[6];
    F.lq1 = args.in[7]; F.lk1 = args.in[8]; F.lq2 = args.in[9]; F.lk2 = args.in[10]; F.sublnw = args.in[11]; F.wpo = args.in[12]; F.wao = args.in[13];
    F.wo = args.in[14]; F.ffnw = args.in[15]; F.wg = args.in[16]; F.wu = args.in[17]; F.wd = args.in[18]; F.finw = args.in[19];
    F.out = args.out; F.ws = args.ws; unsigned char* ws = args.ws;
    F.Win_t = (bf16*)(ws + WS_WIN); F.Wcat_t = (bf16*)(ws + WS_WCAT); F.Wo_t = (bf16*)(ws + WS_WO); F.Wgu_t = (bf16*)(ws + WS_WGU); F.Wd_t = (bf16*)(ws + WS_WD);
    F.XN = (bf16*)(ws + WS_XN); F.UP = (bf16*)(ws + WS_UP); F.Kb = (bf16*)(ws + WS_K); F.Vb = (bf16*)(ws + WS_V); F.Qb = (bf16*)(ws + WS_Q); F.GP = (bf16*)(ws + WS_GP); F.GA = (bf16*)(ws + WS_GA);
    F.MERGED = (bf16*)(ws + WS_MERGED); F.HB = (bf16*)(ws + WS_HB); F.ACT = (bf16*)(ws + WS_ACT); F.PART = (float*)(ws + WS_PART); F.ACAT = (bf16*)args.out;
    const int lo = args.ph_lo, hi = args.ph_hi;
    for (int u = F.tid; u < (LDS_BYTES - RING_BYTES) / 4; u += NTHR) ((LAS unsigned*)(F.lds + RING_BYTES))[u] = 0u;
    __syncthreads();
    XcdBarrier bar; bar.bar = (unsigned*)(ws + WS_CTL) + CW_BAR; bar.x = 0; bar.st = nullptr;
    if (hi - lo > 1) bar = xcd_barrier_post((unsigned*)(ws + WS_CTL) + CW_BAR, (volatile LAS unsigned*)(F.lds + MISC_OFF) + 8);
#define IN(k) (lo <= (k) && (k) < hi)
#define SEAM(k) do { if (IN(k) && IN((k) + 1)) xcd_barrier(bar); } while (0)
    if (IN(0)) { p0_prologue(F); }
    SEAM(0);
    if (IN(1)) {
        pg8::Gemm g{F.XN, F.Win_t, MP, INC, D}; OrderP1 S; S.init(F.G, (int)blockIdx.x);
        Epi8P1 E{{F.UP, F.Qb, F.Kb, F.Vb, F.GP, F.GA}};
        deferred_weights(F, 0, (M / 256) * (INC / 256) + 10); __syncthreads();
        pg8::gemm_phase<Epi8P1, OrderP1, true, true>(F.lds, g, S, E, F.wave, F.lane);
    }
    SEAM(1);
    if (IN(2)) { pool_phase(F); __syncthreads(); attn::attn_phase(F); }
    SEAM(2);
    if (IN(3)) {
        pg8::Gemm g{F.ACAT, F.Wcat_t, M, D, KC}; pg8::StaticOrder S; S.init(M, D, F.G, (int)blockIdx.x);
        EpiP3 E{F.GP, F.GA, F.MERGED}; pg8::gemm_phase<EpiP3, pg8::StaticOrder, true, true>(F.lds, g, S, E, F.wave, F.lane);
    }
    SEAM(3);
    if (IN(4)) {
        pg8::Gemm g{F.MERGED, F.Wo_t, M, D, D}; pg8::StaticOrder S; S.init(M, D, F.G, (int)blockIdx.x);
        Epi8P4 E{{F.x, F.HB}, F.PART}; pg8::gemm_phase<Epi8P4, pg8::StaticOrder, true, true>(F.lds, g, S, E, F.wave, F.lane);
    }
    SEAM(4);
    if (IN(5)) {
        pg8::Gemm g{F.HB, F.Wgu_t, M, 2 * FF, D}; pg8::StaticOrder S; S.init(M, 2 * FF, F.G, (int)blockIdx.x);
        deferred_weights(F, 1, (M / 256) * (2 * FF / 256)); __syncthreads();
        Epi8P5 E{{F.ACT}, F.PART}; pg8::gemm_phase<Epi8P5, pg8::StaticOrder, true, true>(F.lds, g, S, E, F.wave, F.lane);
    }
    SEAM(5);
    if (IN(6)) {
        pg8::Gemm g{F.ACT, F.Wd_t, M, D, FF}; pg8::StaticOrder S; S.init(M, D, F.G, (int)blockIdx.x);
        if (F.G == 256) { EpiFinal E{F.HB, F.out, F.finw, (unsigned*)(ws + WS_XSLOT), (unsigned*)(ws + WS_CTL) + CW_CNT}; pg8::gemm_phase<EpiFinal, pg8::StaticOrder, false, true>(F.lds, g, S, E, F.wave, F.lane); }
        else { Epi8<EpiP6> E{{F.HB, F.out}}; pg8::gemm_phase<Epi8<EpiP6>, pg8::StaticOrder, true, true>(F.lds, g, S, E, F.wave, F.lane); }
    }
    if (F.G != 256) { SEAM(6); if (IN(7)) final_norm_phase(F); }
#undef IN
#undef SEAM
}

extern "C" void kernel_launch(void* const* d_in, const int* in_sizes, int n_in, void* d_out, int out_size, void* d_ws, size_t ws_size, hipStream_t stream) {
    static int grid = 0;
    if (grid == 0) {
        if (n_in != 20 || out_size != M * D || ws_size < WS_END) { fprintf(stderr, "kernel_launch: unexpected shapes (n_in %d out %d ws %zu)\n", n_in, out_size, ws_size); grid = -1; return; }
        int dev = 0, cus = 0, per_cu = 0;
        if (hipGetDevice(&dev) != hipSuccess || hipDeviceGetAttribute(&cus, hipDeviceAttributeMultiprocessorCount, dev) != hipSuccess) { grid = -1; return; }
        if (hipFuncSetAttribute((const void*)mk_fwd, hipFuncAttributeMaxDynamicSharedMemorySize, LDS_BYTES) != hipSuccess) { fprintf(stderr, "kernel_launch: hipFuncSetAttribute failed\n"); grid = -1; return; }
        if (hipOccupancyMaxActiveBlocksPerMultiprocessor(&per_cu, (const void*)mk_fwd, NTHR, LDS_BYTES) != hipSuccess || per_cu < 1) { fprintf(stderr, "kernel_launch: occupancy query says %d\n", per_cu); }
        (void)hipGetLastError();
        grid = cus;
    }
    if (grid < 0) return;
    (void)hipMemsetAsync((char*)d_ws + WS_CTL, 0, CTL_ZERO_BYTES, stream);
    Args a{};
    for (int i = 0; i < 20; ++i) a.in[i] = (const float*)d_in[i];
    a.out = (float*)d_out; a.ws = (unsigned char*)d_ws;
#ifdef PROBE_DUP
    if (true) { a.ph_lo = 0; a.ph_hi = PROBE_DUP + 1; hipLaunchKernelGGL(mk_fwd, dim3(grid), dim3(NTHR), LDS_BYTES, stream, a);
        (void)hipMemsetAsync((char*)d_ws + WS_CTL, 0, 65536, stream);
        a.ph_lo = PROBE_DUP; a.ph_hi = NPHASE; hipLaunchKernelGGL(mk_fwd, dim3(grid), dim3(NTHR), LDS_BYTES, stream, a); }
#else
    if (MK_N_LAUNCHES == 1) { a.ph_lo = 0; a.ph_hi = NPHASE; hipLaunchKernelGGL(mk_fwd, dim3(grid), dim3(NTHR), LDS_BYTES, stream, a); }
#endif
    else for (int p = 0; p < NPHASE; ++p) { a.ph_lo = p; a.ph_hi = p + 1; hipLaunchKernelGGL(mk_fwd, dim3(grid), dim3(NTHR), LDS_BYTES, stream, a); }
}
```
